# Optimizing an MI355X kernel written in HIP

```python
import math
import jax, jax.numpy as jnp
from jax import lax
import numpy as np

D_MODEL = 2048
BATCH = 4
SEQ = 4096
DEPTH = 1

CHUNK = 64
NORM_EPS = 1e-6
NEG_INF = -1e30
MAX_STREAM_OFFSET = 8192

GDN_HEADS = 16
GDN_DK = 128
GDN_DV = 128
GDN_KEY = GDN_HEADS * GDN_DK
GDN_VAL = GDN_HEADS * GDN_DV
GDN_CONV_DIM = 2 * GDN_KEY + GDN_VAL
CONV_K = 4

DIFF_HEADS = 8
DIFF_D = 128
DIFF_QK = 2 * DIFF_HEADS * DIFF_D
DIFF_V = DIFF_HEADS * 2 * DIFF_D
ROT_DIM = DIFF_D // 4
ROPE_THETA = 500000.0
Q_BLOCK = 128

N_BRANCH = 2
OFF_QKV_A = 0
OFF_Z_A = OFF_QKV_A + GDN_CONV_DIM
OFF_BETA_A = OFF_Z_A + GDN_VAL
OFF_ALPHA_A = OFF_BETA_A + GDN_HEADS
OFF_Q_B = OFF_ALPHA_A + GDN_HEADS
OFF_K_B = OFF_Q_B + DIFF_QK
OFF_V_B = OFF_K_B + DIFF_QK
OFF_GATE = OFF_V_B + DIFF_V
IN_COLS = OFF_GATE + N_BRANCH * D_MODEL

N_EXPERTS = 32
TOP_K = 4
D_FF = D_MODEL
SWIGLU_ALPHA = 1.702
SWIGLU_LIMIT = 7.0
EXPERT_BLOCK = 512

kernel_name = 'streaming_hybrid_gdn_diffattn_moe'


def rms_norm(x, g):
    xf = x.astype(jnp.float32)
    y = xf * lax.rsqrt(jnp.mean(xf * xf, axis=-1, keepdims=True) + NORM_EPS)
    return y.astype(x.dtype) * g


def l2_norm(x):
    return x * lax.rsqrt(jnp.sum(x * x, axis=-1, keepdims=True) + NORM_EPS)


def lambda_init(layer_idx):
    return 0.8 - 0.6 * math.exp(-0.3 * layer_idx)


def causal_conv(u, w):
    S = u.shape[1]
    K = w.shape[0]
    up = jnp.pad(u, ((0, 0), (K - 1, 0), (0, 0)))
    return sum(up[:, j:j + S] * w[j] for j in range(K))


def gated_delta_rule(q, k, v, g, beta):
    B, S, H, DK = q.shape
    DV = v.shape[-1]
    NC = S // CHUNK
    q = q * DK ** -0.5

    def chunks(t):
        return t.reshape(B, NC, CHUNK, H, t.shape[-1]).transpose(0, 1, 3, 2, 4)

    qc, kc, vc = chunks(q), chunks(k), chunks(v)
    gc = g.reshape(B, NC, CHUNK, H).transpose(0, 1, 3, 2)
    bc = beta.reshape(B, NC, CHUNK, H).transpose(0, 1, 3, 2)
    gcum = jnp.cumsum(gc, axis=-1)
    tril = jnp.tril(jnp.ones((CHUNK, CHUNK), bool))
    strict = jnp.tril(jnp.ones((CHUNK, CHUNK), bool), -1)
    diff = gcum[..., :, None] - gcum[..., None, :]
    decay = jnp.where(tril, jnp.exp(jnp.where(tril, diff, 0.0)), 0.0)
    kb = kc * bc[..., None]
    eye = jnp.eye(CHUNK, dtype=jnp.float32)
    a_mat = jnp.where(strict, jnp.einsum('bnhik,bnhjk->bnhij', kb, kc) * decay, 0.0) + eye
    t_mat = lax.linalg.triangular_solve(a_mat, jnp.broadcast_to(eye, a_mat.shape),
                                        left_side=True, lower=True, unit_diagonal=True)
    u = jnp.einsum('bnhij,bnhjv->bnhiv', t_mat, vc * bc[..., None])
    w = jnp.einsum('bnhij,bnhjk->bnhik', t_mat, kb * jnp.exp(gcum)[..., None])
    qk = jnp.einsum('bnhik,bnhjk->bnhij', qc, kc) * decay
    qg = qc * jnp.exp(gcum)[..., None]
    kdec = kc * jnp.exp(gcum[..., -1:] - gcum)[..., None]
    glast = jnp.exp(gcum[..., -1])

    def step(state, xs):
        qk_i, qg_i, w_i, u_i, kd_i, gl_i = xs
        v_new = u_i - jnp.einsum('bhck,bhkv->bhcv', w_i, state)
        o = jnp.einsum('bhck,bhkv->bhcv', qg_i, state) + jnp.einsum('bhij,bhjv->bhiv', qk_i, v_new)
        state = state * gl_i[..., None, None] + jnp.einsum('bhck,bhcv->bhkv', kd_i, v_new)
        return state, o

    xs = tuple(jnp.moveaxis(t, 1, 0) for t in (qk, qg, w, u, kdec, glast))
    state0 = jnp.zeros((B, H, DK, DV), jnp.float32)
    _, o = lax.scan(step, state0, xs)
    return o.transpose(1, 0, 3, 2, 4).reshape(B, S, H, DV)


def partial_rope(t, positions):
    half = ROT_DIM // 2
    inv_freq = jnp.power(ROPE_THETA, -jnp.arange(half, dtype=jnp.float32) * 2.0 / ROT_DIM)
    ang = positions.astype(jnp.float32)[..., None] * inv_freq
    cos = jnp.cos(ang)[:, :, None, None, :]
    sin = jnp.sin(ang)[:, :, None, None, :]
    x1 = t[..., :half].astype(jnp.float32)
    x2 = t[..., half:ROT_DIM].astype(jnp.float32)
    rot = jnp.concatenate([x1 * cos - x2 * sin, x2 * cos + x1 * sin], axis=-1).astype(t.dtype)
    return jnp.concatenate([rot, t[..., ROT_DIM:]], axis=-1)


def diff_attention(q, k, v, lam):
    S = q.shape[1]
    scale = DIFF_D ** -0.5
    chunk_id = jnp.arange(S) // CHUNK
    outs = []
    for start in range(0, S, Q_BLOCK):
        end = start + Q_BLOCK
        s = jnp.einsum('bqhcd,bkhcd->bchqk', q[:, start:end], k[:, :end]).astype(jnp.float32) * scale
        mask = chunk_id[start:end, None] >= chunk_id[None, :end]
        p = jax.nn.softmax(jnp.where(mask, s, NEG_INF), axis=-1)
        p = p[:, 0] - lam * p[:, 1]
        outs.append(jnp.einsum('bhqk,bkhv->bqhv', p.astype(v.dtype), v[:, :end]))
    return jnp.concatenate(outs, axis=1)


def mixer_block(h, positions, layer_idx, w_in, b_gate, conv_w, a_log, dt_bias, gdn_norm_g,
                q_norm_g, k_norm_g, lambda_q1, lambda_k1, lambda_q2, lambda_k2, subln_g,
                w_branch_a, w_branch_b, w_out):
    B, S, D = h.shape
    proj = h @ w_in

    qkv = jax.nn.silu(causal_conv(proj[..., OFF_QKV_A:OFF_Z_A], conv_w)).astype(jnp.float32)
    qa = l2_norm(qkv[..., :GDN_KEY].reshape(B, S, GDN_HEADS, GDN_DK))
    ka = l2_norm(qkv[..., GDN_KEY:2 * GDN_KEY].reshape(B, S, GDN_HEADS, GDN_DK))
    va = qkv[..., 2 * GDN_KEY:].reshape(B, S, GDN_HEADS, GDN_DV)
    z = proj[..., OFF_Z_A:OFF_BETA_A].reshape(B, S, GDN_HEADS, GDN_DV).astype(jnp.float32)
    beta = jax.nn.sigmoid(proj[..., OFF_BETA_A:OFF_ALPHA_A].astype(jnp.float32))
    g = -jnp.exp(a_log.astype(jnp.float32)) * jax.nn.softplus(
        proj[..., OFF_ALPHA_A:OFF_Q_B].astype(jnp.float32) + dt_bias.astype(jnp.float32))
    oa = gated_delta_rule(qa, ka, va, g, beta)
    oa = rms_norm(oa, gdn_norm_g.astype(jnp.float32)) * jax.nn.silu(z)
    ya = oa.astype(h.dtype).reshape(B, S, GDN_VAL) @ w_branch_a

    qb = proj[..., OFF_Q_B:OFF_K_B].reshape(B, S, DIFF_HEADS, 2, DIFF_D)
    kb = proj[..., OFF_K_B:OFF_V_B].reshape(B, S, DIFF_HEADS, 2, DIFF_D)
    vb = proj[..., OFF_V_B:OFF_GATE].reshape(B, S, DIFF_HEADS, 2 * DIFF_D)
    qb = partial_rope(rms_norm(qb, q_norm_g), positions)
    kb = partial_rope(rms_norm(kb, k_norm_g), positions)
    lam_init = lambda_init(layer_idx)
    lam = (jnp.exp(jnp.sum(lambda_q1.astype(jnp.float32) * lambda_k1.astype(jnp.float32)))
           - jnp.exp(jnp.sum(lambda_q2.astype(jnp.float32) * lambda_k2.astype(jnp.float32))) + lam_init)
    ob = diff_attention(qb, kb, vb, lam)
    ob = rms_norm(ob, subln_g) * (1.0 - lam_init)
    yb = ob.reshape(B, S, DIFF_V) @ w_branch_b

    gates = jax.nn.sigmoid(proj[..., OFF_GATE:] + b_gate)
    merged = gates[..., :D] * ya + gates[..., D:] * yb
    return merged @ w_out


def moe_ffn(h, w_router, b_router, w_gate_up, b_gate_up, w_down, b_down):
    B, S, D = h.shape
    N = B * S
    ht = h.reshape(N, D)
    logits = (ht @ w_router + b_router).astype(jnp.float32)
    top_vals, top_idx = lax.top_k(logits, TOP_K)
    top_w = jax.nn.softmax(top_vals, axis=-1)
    A = N * TOP_K
    flat_e = top_idx.reshape(A).astype(jnp.int32)
    flat_w = top_w.reshape(A)
    order = jnp.argsort(flat_e, stable=True)
    sorted_e = flat_e[order]
    counts = jnp.zeros((N_EXPERTS,), jnp.int32).at[flat_e].add(1)
    padded = (counts + EXPERT_BLOCK - 1) // EXPERT_BLOCK * EXPERT_BLOCK
    pad_end = jnp.cumsum(padded)
    pad_start = pad_end - padded
    start = jnp.cumsum(counts) - counts
    dest = pad_start[sorted_e] + jnp.arange(A, dtype=jnp.int32) - start[sorted_e]
    P = A + N_EXPERTS * EXPERT_BLOCK
    NB = P // EXPERT_BLOCK
    slot_token = jnp.zeros((P,), jnp.int32).at[dest].set((order // TOP_K).astype(jnp.int32))
    slot_gate = jnp.zeros((P,), jnp.float32).at[dest].set(flat_w[order])
    block_expert = jnp.minimum(
        jnp.searchsorted(pad_end, jnp.arange(NB, dtype=jnp.int32) * EXPERT_BLOCK, side='right'),
        N_EXPERTS - 1)

    def expert_block(args):
        e, tok = args
        xb = ht[tok]
        gu = xb @ w_gate_up[e] + b_gate_up[e]
        gate = jnp.minimum(gu[:, :D_FF], SWIGLU_LIMIT)
        up = jnp.clip(gu[:, D_FF:], -SWIGLU_LIMIT, SWIGLU_LIMIT)
        act = (up + 1.0) * gate * jax.nn.sigmoid(SWIGLU_ALPHA * gate)
        return act @ w_down[e] + b_down[e]

    out = lax.map(expert_block, (block_expert, slot_token.reshape(NB, EXPERT_BLOCK)))
    y = jnp.zeros((N, D), jnp.float32).at[slot_token].add(
        out.reshape(P, D).astype(jnp.float32) * slot_gate[:, None])
    return y.astype(h.dtype).reshape(B, S, D)


def setup_inputs(seed: int = 0) -> dict:
    key = jax.random.key(seed)
    ks = jax.random.split(key, 32)
    f32 = jnp.float32
    L, D = DEPTH, D_MODEL

    def nrm(k, shape, scale):
        return jax.random.normal(k, shape, f32) * scale

    x = nrm(ks[0], (BATCH, SEQ, D), 1.0)
    positions = (jnp.arange(SEQ, dtype=jnp.int32)[None, :]
                 + jax.random.randint(ks[1], (BATCH, 1), 0, MAX_STREAM_OFFSET, dtype=jnp.int32))
    return {
        'x': x,
        'positions': positions,
        'norm1_g': 1.0 + nrm(ks[2], (L, D), 0.02),
        'w_in': nrm(ks[3], (L, D, IN_COLS), D ** -0.5),
        'b_gate': nrm(ks[4], (L, N_BRANCH * D), 0.02),
        'conv_w': nrm(ks[5], (L, CONV_K, GDN_CONV_DIM), CONV_K ** -0.5),
        'a_log': jnp.log(jax.random.uniform(ks[6], (L, GDN_HEADS), f32, 1.0, 16.0)),
        'dt_bias': 1.0 + nrm(ks[7], (L, GDN_HEADS), 0.1),
        'gdn_norm_g': 1.0 + nrm(ks[8], (L, GDN_DV), 0.02),
        'q_norm_g': 1.0 + nrm(ks[9], (L, DIFF_D), 0.02),
        'k_norm_g': 1.0 + nrm(ks[10], (L, DIFF_D), 0.02),
        'lambda_q1': nrm(ks[11], (L, DIFF_D), 0.1),
        'lambda_k1': nrm(ks[12], (L, DIFF_D), 0.1),
        'lambda_q2': nrm(ks[13], (L, DIFF_D), 0.1),
        'lambda_k2': nrm(ks[14], (L, DIFF_D), 0.1),
        'subln_g': 1.0 + nrm(ks[15], (L, 2 * DIFF_D), 0.02),
        'w_branch_a': nrm(ks[16], (L, GDN_VAL, D), GDN_VAL ** -0.5),
        'w_branch_b': nrm(ks[17], (L, DIFF_V, D), DIFF_V ** -0.5),
        'w_out': nrm(ks[18], (L, D, D), D ** -0.5),
        'norm2_g': 1.0 + nrm(ks[19], (L, D), 0.02),
        'w_router': nrm(ks[20], (L, D, N_EXPERTS), D ** -0.5),
        'b_router': nrm(ks[21], (L, N_EXPERTS), 0.01),
        'w_gate_up': nrm(ks[22], (L, N_EXPERTS, D, 2 * D_FF), D ** -0.5),
        'b_gate_up': nrm(ks[23], (L, N_EXPERTS, 2 * D_FF), 0.01),
        'w_down': nrm(ks[24], (L, N_EXPERTS, D_FF, D), D_FF ** -0.5),
        'b_down': nrm(ks[25], (L, N_EXPERTS, D), 0.01),
    }


def reference(x, positions, norm1_g, w_in, b_gate, conv_w, a_log, dt_bias, gdn_norm_g,
              q_norm_g, k_norm_g, lambda_q1, lambda_k1, lambda_q2, lambda_k2, subln_g,
              w_branch_a, w_branch_b, w_out, norm2_g, w_router, b_router,
              w_gate_up, b_gate_up, w_down, b_down):
    for l in range(DEPTH):
        h = rms_norm(x, norm1_g[l])
        x = x + mixer_block(h, positions, l, w_in[l], b_gate[l], conv_w[l], a_log[l], dt_bias[l],
                            gdn_norm_g[l], q_norm_g[l], k_norm_g[l], lambda_q1[l], lambda_k1[l],
                            lambda_q2[l], lambda_k2[l], subln_g[l], w_branch_a[l], w_branch_b[l],
                            w_out[l])
        h2 = rms_norm(x, norm2_g[l])
        x = x + moe_ffn(h2, w_router[l], b_router[l], w_gate_up[l], b_gate_up[l],
                        w_down[l], b_down[l])
    return x
```

```cpp
#include <hip/hip_runtime.h>
#include <stdint.h>
#include <stdio.h>

#define DI __device__ __forceinline__
#define LAS __attribute__((address_space(3)))

typedef unsigned short bf16_t;
typedef short bf16x8 __attribute__((ext_vector_type(8)));
typedef short s16x4 __attribute__((ext_vector_type(4)));
typedef float f32x2 __attribute__((ext_vector_type(2)));
typedef float f32x4 __attribute__((ext_vector_type(4)));
typedef float f32x16 __attribute__((ext_vector_type(16)));
typedef unsigned u32x2 __attribute__((ext_vector_type(2)));
typedef unsigned u32x4 __attribute__((ext_vector_type(4)));

constexpr int NTOK = 16384, DM = 2048, SEQ = 4096, NBATCH = 4;
constexpr int IN_COLS = 18464;
constexpr int PROJ_LD = 18432;
constexpr int PC_QKV = 0, PC_Z = 6144, PC_QB = 8192, PC_KB = 10240, PC_VB = 12288, PC_GATE = 14336;
constexpr int NEXP = 32, TOPK = 4;
constexpr float NORM_EPS = 1e-6f;
constexpr int MAX_SLOTS = 73728;

constexpr size_t MiB = (size_t)1 << 20;
constexpr size_t WS_CTL = 0;
constexpr size_t CTL_ZERO_BYTES = 64 * 1024;
constexpr size_t WS_H = 1 * MiB;
constexpr size_t WS_WIN = 65 * MiB;
constexpr size_t WS_WA = 137 * MiB, WS_WB = 145 * MiB, WS_WO = 153 * MiB;
constexpr size_t WS_WS = 161 * MiB;
constexpr size_t WS_BA = 162 * MiB;
constexpr size_t WS_WGU = 164 * MiB;
constexpr size_t WS_WD = 676 * MiB;
constexpr size_t WS_PROJ = 932 * MiB;
constexpr size_t WS_NEGW = 1508 * MiB;
constexpr size_t WS_QG = 1572 * MiB;
constexpr size_t WS_KDT = 1636 * MiB;
constexpr size_t WS_UT = 1700 * MiB;
constexpr size_t WS_QK = 1764 * MiB;
constexpr size_t WS_GL = 1796 * MiB;
constexpr size_t WS_QN = 1797 * MiB;
constexpr size_t WS_KN = 1861 * MiB;
constexpr size_t WS_OA = 1925 * MiB;
constexpr size_t WS_OB = 1989 * MiB;
constexpr size_t WS_TMP = 2053 * MiB;
constexpr size_t WS_MRG = 2181 * MiB;
constexpr size_t WS_LIST = 2245 * MiB;
constexpr size_t WS_WLIST = 2247 * MiB;
constexpr size_t WS_TINFO = 2249 * MiB;
constexpr size_t WS_ACT = 2250 * MiB;
constexpr size_t WS_YS = 2538 * MiB;
constexpr size_t WS_H8 = 2826 * MiB;
constexpr size_t WS_WIN8 = 2858 * MiB;
constexpr size_t WS_GVBT = 2866 * MiB, WS_GKBGT = 2930 * MiB;
constexpr size_t WS_VBUF = 2994 * MiB;
constexpr size_t WS_END = 3058 * MiB;

#define XB_TMO      128
#define XB_XCNT(j)  (256  + 64 * (j))
#define XB_XSUB(j)  (1280 + 64 * (j))
#define XB_XGEN(j)  (2304 + 64 * (j))
#define XB_TOP      3328
#define XB_TOPGEN   3392
#define XCD_BAR_WORDS 3456
#define XB_SPIN_CAP (1u << 19)
constexpr int CW_QUEUE = 4096;
constexpr int CW_CNT = 8192;

typedef __bf16 bf16v2_t __attribute__((ext_vector_type(2)));
DI unsigned cvt_pk_bf16(float lo, float hi) { f32x2 v = {lo, hi}; bf16v2_t r = __builtin_convertvector(v, bf16v2_t); return __builtin_bit_cast(unsigned, r); }
DI float bf2f(unsigned short v) { return __uint_as_float(((unsigned)v) << 16); }
DI float bflo(unsigned w) { return __uint_as_float(w << 16); }
DI float bfhi(unsigned w) { return __uint_as_float(w & 0xffff0000u); }
DI float sigmoidf_(float x) { return __builtin_amdgcn_rcpf(1.f + __expf(-x)); }
DI float siluf_(float x) { return x * __builtin_amdgcn_rcpf(1.f + __expf(-x)); }
DI unsigned cvt4_fp8(float a, float b, float c, float d) { int w = __builtin_amdgcn_cvt_pk_fp8_f32(a, b, 0, false); w = __builtin_amdgcn_cvt_pk_fp8_f32(c, d, w, true); return (unsigned)w; }
constexpr float Y8_SCALE = 16.f;
constexpr float W8_SCALE = 64.f, H8_SCALE = 2.f, A8_SCALE = 4.f;
#define MFMA16(a, b, c) __builtin_amdgcn_mfma_f32_16x16x32_bf16((a), (b), (c), 0, 0, 0)
#define MFMA32(a, b, c) __builtin_amdgcn_mfma_f32_32x32x16_bf16((a), (b), (c), 0, 0, 0)
#define WAIT_V(n) asm volatile("s_waitcnt vmcnt(" #n ")" ::: "memory")
#define WAIT_L(n) asm volatile("s_waitcnt lgkmcnt(" #n ")" ::: "memory")
#define BAR() __builtin_amdgcn_s_barrier()
#define SCHED() __builtin_amdgcn_sched_barrier(0)
#define LDS_BAR() do { asm volatile("s_waitcnt lgkmcnt(0)" ::: "memory"); __builtin_amdgcn_s_barrier(); asm volatile("" ::: "memory"); } while (0)

DI unsigned xb_ld(unsigned* p)              { return __hip_atomic_load(p, __ATOMIC_RELAXED, __HIP_MEMORY_SCOPE_AGENT); }
DI unsigned xb_add(unsigned* p, unsigned v) { return __hip_atomic_fetch_add(p, v, __ATOMIC_RELAXED, __HIP_MEMORY_SCOPE_AGENT); }
DI unsigned xb_xcc_id() { return (unsigned)__builtin_amdgcn_s_getreg((3 << 11) | 20) & 0xFu; }
#define XB_SPIN(cond, bar) do { unsigned _sp = 0; while (cond) { __builtin_amdgcn_s_sleep(1); \
    if ((++_sp & 255u) == 0u) { if (xb_ld(&(bar)[XB_TMO])) break; if (_sp > XB_SPIN_CAP) { atomicAdd(&(bar)[XB_TMO], 1u); break; } } } } while (0)
struct XcdBarrier { unsigned* bar; unsigned x; volatile LAS unsigned* st; };
DI XcdBarrier xcd_barrier_post(unsigned* bar, volatile LAS unsigned* st) {
    XcdBarrier b; b.bar = bar; b.x = xb_xcc_id(); b.st = st;
    if (threadIdx.x == 0) (void)xb_add(&bar[XB_XCNT(b.x)], 1u);
    return b;
}
DI void xcd_barrier_complete(unsigned* bar, unsigned x, unsigned& nloc, unsigned& nx) {
    const unsigned G = gridDim.x * gridDim.y * gridDim.z;
    unsigned sum, cnt, mine, sp = 0u;
    for (;;) {
        sum = 0u; cnt = 0u; mine = 0u;
#pragma unroll
        for (unsigned j = 0; j < 16; ++j) { const unsigned c = xb_ld(&bar[XB_XCNT(j)]); sum += c; cnt += (c > 0u) ? 1u : 0u; mine = (j == x) ? c : mine; }
        if (sum == G) break;
        __builtin_amdgcn_s_sleep(1);
        if ((++sp & 255u) == 0u) { if (xb_ld(&bar[XB_TMO])) break; if (sp > XB_SPIN_CAP) { atomicAdd(&bar[XB_TMO], 1u); break; } }
    }
    nloc = mine > 0u ? mine : 1u; nx = cnt > 0u ? cnt : 1u;
}
DI void xcd_barrier(const XcdBarrier& b) {
    asm volatile("s_waitcnt vmcnt(0)" ::: "memory");
    __syncthreads();
    if (threadIdx.x == 0) {
        unsigned* bar = b.bar;
        __builtin_amdgcn_s_waitcnt(0);
        unsigned nloc = b.st[0], nx = b.st[1];
        if (nloc == 0u) { xcd_barrier_complete(bar, b.x, nloc, nx); b.st[0] = nloc; b.st[1] = nx; }
        const unsigned old = xb_add(&bar[XB_XSUB(b.x)], 1u);
        const unsigned gen = old / nloc;
        if (old + 1u == (gen + 1u) * nloc) {
            __builtin_amdgcn_fence(__ATOMIC_RELEASE, "agent");
            asm volatile("s_waitcnt vmcnt(0)" ::: "memory");
            const unsigned og = xb_add(&bar[XB_TOP], 1u);
            const unsigned tg = og / nx;
            if (og + 1u == (tg + 1u) * nx) xb_add(&bar[XB_TOPGEN], 1u);
            else XB_SPIN(xb_ld(&bar[XB_TOPGEN]) == tg, bar);
            __builtin_amdgcn_fence(__ATOMIC_ACQUIRE, "agent");
            xb_add(&bar[XB_XGEN(b.x)], 1u);
            asm volatile("s_waitcnt vmcnt(0)" ::: "memory");
        } else {
            XB_SPIN(xb_ld(&bar[XB_XGEN(b.x)]) == gen, bar);
            __builtin_amdgcn_fence(__ATOMIC_ACQUIRE, "agent");
            asm volatile("s_waitcnt vmcnt(0)" ::: "memory");
        }
    }
    __syncthreads();
}

struct Params {
    const float* x; const int* positions; const float* norm1_g; const float* w_in; const float* b_gate; const float* conv_w;
    const float* a_log; const float* dt_bias; const float* gdn_norm_g; const float* q_norm_g; const float* k_norm_g;
    const float* lq1; const float* lk1; const float* lq2; const float* lk2; const float* subln_g;
    const float* w_a; const float* w_b; const float* w_out; const float* norm2_g; const float* w_router; const float* b_router;
    const float* w_gu; const float* b_gu; const float* w_down; const float* b_down;
    float* out; unsigned char* ws;
    int ph_lo, ph_hi;
};

constexpr int LDS_MISC = 3072;
constexpr int LDS_BYTES = 160 * 1024 - 1024;

struct CvtTile { const float* src; int ld; unsigned char* dst; int ldd; int f8; };
constexpr int CVT_NT = 2304 + 768 + 16384 + 8192;

DI CvtTile cvt_tile_of(const Params& p, int t) {
    CvtTile c;
    if (t < 2304) {
        const int kb = t / 144, nb = t % 144, n1 = nb * 128, sc = n1 < 8192 ? n1 : n1 + 32;
        c.src = p.w_in + (size_t)kb * 128 * IN_COLS + sc; c.ld = IN_COLS;
        if (n1 >= PC_GATE) { c.dst = p.ws + WS_WIN8 + (size_t)(n1 - PC_GATE) * 2048 + kb * 128; c.ldd = 2048; c.f8 = 1; }
        else if (n1 >= PC_Z && n1 < PC_QB) { c.dst = p.ws + WS_WIN8 + (size_t)(4096 + n1 - PC_Z) * 2048 + kb * 128; c.ldd = 2048; c.f8 = 1; }
        else { c.dst = p.ws + WS_WIN + ((size_t)n1 * 2048 + kb * 128) * 2; c.ldd = 4096; c.f8 = 0; }
    } else if (t < 3072) {
        const int m = (t - 2304) >> 8, r = (t - 2304) & 255, kb = r >> 4, nb = r & 15;
        const float* s = m == 0 ? p.w_a : (m == 1 ? p.w_b : p.w_out);
        const size_t d = m == 0 ? WS_WA : (m == 1 ? WS_WB : WS_WO);
        c.src = s + (size_t)kb * 128 * 2048 + nb * 128; c.ld = 2048;
        c.dst = p.ws + d + ((size_t)nb * 128 * 2048 + kb * 128) * 2; c.ldd = 4096; c.f8 = 0;
    } else if (t < 3072 + 16384) {
        const int r = t - 3072, e = r >> 9, r2 = r & 511, kb = r2 >> 5, nb = r2 & 31;
        const int drow = nb < 16 ? nb * 256 : (nb - 16) * 256 + 128;
        c.src = p.w_gu + (size_t)e * 2048 * 4096 + (size_t)kb * 128 * 4096 + nb * 128; c.ld = 4096;
        c.dst = p.ws + WS_WGU + ((size_t)e * 4096 + drow) * 2048 + kb * 128; c.ldd = 2048; c.f8 = 1;
    } else {
        const int r = t - 19456, e = r >> 8, r2 = r & 255, kb = r2 >> 4, nb = r2 & 15;
        c.src = p.w_down + (size_t)e * 2048 * 2048 + (size_t)kb * 128 * 2048 + nb * 128; c.ld = 2048;
        c.dst = p.ws + WS_WD + ((size_t)e * 2048 + nb * 128) * 2048 + kb * 128; c.ldd = 2048; c.f8 = 1;
    }
    return c;
}

DI void cvt_store(const CvtTile& cur, const LAS float* tile, int tid) {
    const int n = tid & 127, kseg = (tid >> 7) * 32;
    if (cur.f8) {
        u32x4 w[2];
#pragma unroll
        for (int g = 0; g < 8; ++g) {
            float e[4];
#pragma unroll
            for (int j = 0; j < 4; ++j) e[j] = tile[(kseg + g * 4 + j) * 132 + n] * W8_SCALE;
            w[g >> 2][g & 3] = cvt4_fp8(e[0], e[1], e[2], e[3]);
        }
        *(u32x4*)(cur.dst + (size_t)n * cur.ldd + kseg) = w[0]; *(u32x4*)(cur.dst + (size_t)n * cur.ldd + kseg + 16) = w[1];
    } else {
#pragma unroll
        for (int g = 0; g < 4; ++g) {
            float e[8];
#pragma unroll
            for (int j = 0; j < 8; ++j) e[j] = tile[(kseg + g * 8 + j) * 132 + n];
            u32x4 w = {cvt_pk_bf16(e[0], e[1]), cvt_pk_bf16(e[2], e[3]), cvt_pk_bf16(e[4], e[5]), cvt_pk_bf16(e[6], e[7])};
            *(u32x4*)(cur.dst + (size_t)n * cur.ldd + (kseg + g * 8) * 2) = w;
        }
    }
}
template <int NT>
DI void cvt_tiles(const Params& p, LAS char* lds, int t0, int step) {
    int tid_ = threadIdx.x; asm volatile("" : "+v"(tid_));
    const int tid = tid_;
    LAS float* tile = (LAS float*)(lds + LDS_MISC);
    f32x4 v[4][8]; CvtTile c[4];
#define CV_LOAD(s_, t) do { const int sl_ = (s_); c[sl_] = cvt_tile_of(p, t); _Pragma("unroll") for (int i_ = 0; i_ < 8; ++i_) { const int idx = tid + 512 * i_; \
        const float* a_ = c[sl_].src + (size_t)(idx >> 5) * c[sl_].ld + (idx & 31) * 4; asm volatile("global_load_dwordx4 %0, %1, off nt" : "=v"(v[sl_][i_]) : "v"(a_) : "memory"); } } while (0)
#define CV_BAR() do { asm volatile("s_waitcnt lgkmcnt(0)" ::: "memory"); __builtin_amdgcn_s_barrier(); asm volatile("" ::: "memory"); } while (0)
#pragma unroll
    for (int i = 0; i < 4; ++i) if (i < NT) CV_LOAD(i, t0 + i * step);
#pragma unroll
    for (int i = 0; i < NT; ++i) {
        const int younger = (NT - 1 - i) < 3 ? (NT - 1 - i) : 3;
        if (younger == 3) asm volatile("s_waitcnt vmcnt(24)" ::: "memory");
        else if (younger == 2) asm volatile("s_waitcnt vmcnt(16)" ::: "memory");
        else if (younger == 1) asm volatile("s_waitcnt vmcnt(8)" ::: "memory");
        else asm volatile("s_waitcnt vmcnt(0)" ::: "memory");
#pragma unroll
        for (int q = 0; q < 8; ++q) { const int idx = tid + 512 * q; *(LAS f32x4*)(tile + (idx >> 5) * 132 + (idx & 31) * 4) = v[i & 3][q]; }
        CV_BAR();
        const CvtTile cur = c[i & 3];
        if (i + 4 < NT) CV_LOAD(i & 3, t0 + (i + 4) * step);
        cvt_store(cur, tile, tid);
        CV_BAR();
    }
#undef CV_LOAD
#undef CV_BAR
}

DI void p0_prologue(const Params& p, LAS char* lds) {
    const int tid = threadIdx.x, lane = tid & 63, wave = tid >> 6;
    {
        bf16_t* h = (bf16_t*)(p.ws + WS_H);
        for (int row = blockIdx.x * 8 + wave; row < NTOK; row += gridDim.x * 8) {
            const float* xr = p.x + (size_t)row * DM;
            f32x4 v[8]; float ss = 0.f;
#pragma unroll
            for (int i = 0; i < 8; ++i) { v[i] = *(const f32x4*)(xr + (i * 64 + lane) * 4); ss += v[i][0] * v[i][0] + v[i][1] * v[i][1] + v[i][2] * v[i][2] + v[i][3] * v[i][3]; }
#pragma unroll
            for (int o = 32; o >= 1; o >>= 1) ss += __shfl_xor(ss, o);
            const float rs = rsqrtf(ss * (1.f / DM) + NORM_EPS);
#pragma unroll
            for (int i = 0; i < 8; ++i) {
                const f32x4 g = *(const f32x4*)(p.norm1_g + (i * 64 + lane) * 4);
                u32x2 w; w[0] = cvt_pk_bf16(v[i][0] * rs * g[0], v[i][1] * rs * g[1]); w[1] = cvt_pk_bf16(v[i][2] * rs * g[2], v[i][3] * rs * g[3]);
                *(u32x2*)(h + (size_t)row * DM + (i * 64 + lane) * 4) = w;
                const float rs2 = rs * H8_SCALE;
                *(unsigned*)(p.ws + WS_H8 + (size_t)row * DM + (i * 64 + lane) * 4) = cvt4_fp8(v[i][0] * rs2 * g[0], v[i][1] * rs2 * g[1], v[i][2] * rs2 * g[2], v[i][3] * rs2 * g[3]);
            }
        }
    }
    {
        bf16_t* wsl = (bf16_t*)(p.ws + WS_WS); bf16_t* rhi = wsl + 32 * 2048; bf16_t* rlo = rhi + 32 * 2048;
        for (int idx = blockIdx.x * 512 + tid; idx < 32 * 2048; idx += gridDim.x * 512) {
            const int n = idx >> 11, k = idx & 2047;
            const float a = p.w_in[(size_t)k * IN_COLS + 8192 + n];
            wsl[idx] = (bf16_t)(cvt_pk_bf16(a, 0.f) & 0xffff);
            const float r = p.w_router[k * 32 + n];
            const unsigned hi = cvt_pk_bf16(r, 0.f) & 0xffff; const float rem = r - bflo(hi);
            rhi[idx] = (bf16_t)hi; rlo[idx] = (bf16_t)(cvt_pk_bf16(rem, 0.f) & 0xffff);
        }
    }
    if (gridDim.x == 256) cvt_tiles<12>(p, lds, blockIdx.x, 256);
    else for (int t = blockIdx.x; t < 3072; t += gridDim.x) cvt_tiles<1>(p, lds, t, 0);
    __syncthreads();
}

constexpr int G_HT = 128 * 64;
DI int lds_byte(int r, int c) { const int st = (r >> 4) * 2 + (c >> 5), rr = r & 15, cc = c & 31, ob = rr * 64 + cc * 2; return st * 1024 + (ob ^ (((ob >> 9) & 1) << 5)); }
DI int perm32(int rho) { const int n = rho >> 4, i = rho & 15; return 8 * (i >> 2) + 4 * n + (i & 3); }
DI void stage_rc(int b, int& R, int& C) { const int st = b / 1024, sb = b % 1024, swz = sb ^ (((sb >> 9) & 1) << 5); R = (st >> 1) * 16 + swz / 64; C = (st & 1) * 32 + (swz % 64) / 2; }

typedef int i32x8 __attribute__((ext_vector_type(8)));
typedef int i32x4 __attribute__((ext_vector_type(4)));
DI i32x8 cat8(bf16x8 a, bf16x8 b) { const i32x4 x = __builtin_bit_cast(i32x4, a), y = __builtin_bit_cast(i32x4, b); return __builtin_shufflevector(x, y, 0, 1, 2, 3, 4, 5, 6, 7); }
DI void mfma_f8(f32x4& acc, i32x8 a, i32x8 b, int one8) {
    asm volatile("s_nop 1\n\tv_mfma_scale_f32_16x16x128_f8f6f4 %0, %1, %2, %0, %3, %3 op_sel_hi:[0,0,0]" : "+v"(acc) : "v"(a), "v"(b), "v"(one8));
}
template <bool GATHER, bool PERM>
DI void gemm_issue(const bf16_t* A, int lda, int brow, const LAS int* rowidx, const bf16_t* Bt, int K, LAS char* stage) {
    LAS bf16_t* shm = (LAS bf16_t*)stage;
    int tid = threadIdx.x; asm volatile("" : "+v"(tid));
    const int wv = __builtin_amdgcn_readfirstlane(tid >> 6);
    int R0, C0; stage_rc(tid * 16, R0, C0);
    const __amdgpu_buffer_rsrc_t rsA = __builtin_amdgcn_make_buffer_rsrc((void*)A, 0, 0x7fffffff, 0x00020000);
    const __amdgpu_buffer_rsrc_t rsB = __builtin_amdgcn_make_buffer_rsrc((void*)Bt, 0, 0x7fffffff, 0x00020000);
    const int Rb = PERM ? ((R0 & ~31) + perm32(R0 & 31)) : R0;
    const unsigned bgb = ((unsigned)Rb * (unsigned)K + C0) * 2u;
#define GI_A(b, h, kt) do { _Pragma("unroll") for (int _i = 0; _i < 2; ++_i) { const int r_ = (h) * 128 + _i * 64 + R0; \
        const unsigned o_ = ((GATHER ? (unsigned)rowidx[r_] : (unsigned)(brow + r_)) * (unsigned)lda + C0) * 2u; \
        __builtin_amdgcn_raw_ptr_buffer_load_lds(rsA, (LAS unsigned*)((LAS char*)(shm + ((b) * 2 + (h)) * G_HT) + wv * 1024 + _i * 8192), 16, o_, (kt) * 128, 0, 0); } } while (0)
#define GI_B(b, h, kt) do { _Pragma("unroll") for (int _i = 0; _i < 2; ++_i) \
        __builtin_amdgcn_raw_ptr_buffer_load_lds(rsB, (LAS unsigned*)((LAS char*)(shm + (4 + (b) * 2 + (h)) * G_HT) + wv * 1024 + _i * 8192), 16, bgb, (((h) * 128 + _i * 64) * K + (kt) * 64) * 2, 0, 0); } while (0)
    GI_B(0, 0, 0); GI_A(0, 0, 0); GI_B(0, 1, 0); GI_A(0, 1, 0); GI_B(1, 0, 1); GI_A(1, 0, 1); GI_B(1, 1, 1);
#undef GI_A
#undef GI_B
}
struct NoNext { DI void operator()() const {} };

template <bool GATHER, bool FP8, bool ZERO, class Epi, class Next>
DI void gemm_tile_acc(const bf16_t* A, int lda, int brow, const LAS int* rowidx, const bf16_t* Bt, int K, LAS char* stage, const Epi& epi, bool pre, const Next& next, f32x4 (&acc)[2][2][4][2]) {
    LAS bf16_t* shm = (LAS bf16_t*)stage;
#define SA(b, h) (shm + ((b) * 2 + (h)) * G_HT)
#define SB(b, h) (shm + (4 + (b) * 2 + (h)) * G_HT)
    int tid = threadIdx.x;
    const int wv = __builtin_amdgcn_readfirstlane(tid >> 6);
    int R0, C0; stage_rc(tid * 16, R0, C0);
    unsigned agb[2][2];
    if (GATHER) {
#pragma unroll
        for (int h = 0; h < 2; ++h)
#pragma unroll
            for (int i = 0; i < 2; ++i) agb[h][i] = ((unsigned)rowidx[h * 128 + i * 64 + R0] * (unsigned)lda + C0) * 2u;
    } else {
#pragma unroll
        for (int h = 0; h < 2; ++h)
#pragma unroll
            for (int i = 0; i < 2; ++i) agb[h][i] = ((unsigned)(brow + h * 128 + i * 64 + R0) * (unsigned)lda + C0) * 2u;
    }
    const int Rb = Epi::PERM ? ((R0 & ~31) + perm32(R0 & 31)) : R0;
    const unsigned bgb = ((unsigned)Rb * (unsigned)K + C0) * 2u;
    const __amdgpu_buffer_rsrc_t rsA = __builtin_amdgcn_make_buffer_rsrc((void*)A, 0, 0x7fffffff, 0x00020000);
    const __amdgpu_buffer_rsrc_t rsB = __builtin_amdgcn_make_buffer_rsrc((void*)Bt, 0, 0x7fffffff, 0x00020000);
#define STAGE_A(P, h, kt) do { _Pragma("unroll") for (int _i = 0; _i < 2; ++_i) \
        __builtin_amdgcn_raw_ptr_buffer_load_lds(rsA, (LAS unsigned*)((LAS char*)(P) + wv * 1024 + _i * 8192), 16, agb[h][_i], (kt) * 128, 0, 0); } while (0)
#define STAGE_B(P, h, kt) do { _Pragma("unroll") for (int _i = 0; _i < 2; ++_i) \
        __builtin_amdgcn_raw_ptr_buffer_load_lds(rsB, (LAS unsigned*)((LAS char*)(P) + wv * 1024 + _i * 8192), 16, bgb, (((h) * 128 + _i * 64) * K + (kt) * 64) * 2, 0, 0); } while (0)
#define LDA(dst, b, h) _Pragma("unroll") for (int m = 0; m < 4; ++m) _Pragma("unroll") for (int k = 0; k < 2; ++k) \
        dst[m][k] = *(const LAS bf16x8*)((LAS char*)SA(b, h) + lds_byte(wr * 64 + m * 16 + fr, k * 32 + fq * 8))
#define LDB(dst, b, h) _Pragma("unroll") for (int n = 0; n < 2; ++n) _Pragma("unroll") for (int k = 0; k < 2; ++k) \
        dst[n][k] = *(const LAS bf16x8*)((LAS char*)SB(b, h) + lds_byte(wc * 32 + n * 16 + fr, k * 32 + fq * 8))
#define MMA(ai, bj, At_, Bt_) do { __builtin_amdgcn_s_setprio(1); \
        if (!FP8) { _Pragma("unroll") for (int m = 0; m < 4; ++m) _Pragma("unroll") for (int n = 0; n < 2; ++n) _Pragma("unroll") for (int k = 0; k < 2; ++k) \
            acc[ai][bj][m][n] = MFMA16(Bt_[n][k], At_[m][k], acc[ai][bj][m][n]); } \
        else { _Pragma("unroll") for (int m = 0; m < 4; ++m) _Pragma("unroll") for (int n = 0; n < 2; ++n) \
            mfma_f8(acc[ai][bj][m][n], cat8(Bt_[n][0], Bt_[n][1]), cat8(At_[m][0], At_[m][1]), one8); } \
        __builtin_amdgcn_s_setprio(0); } while (0)

    int wid = tid >> 6, lane = tid & 63, wr = wid >> 2, wc = wid & 3, fr = lane & 15, fq = lane >> 4;
    if (ZERO) {
#pragma unroll
    for (int a = 0; a < 2; ++a)
#pragma unroll
        for (int b = 0; b < 2; ++b)
#pragma unroll
            for (int m = 0; m < 4; ++m)
#pragma unroll
                for (int n = 0; n < 2; ++n) acc[a][b][m][n] = (f32x4){0.f, 0.f, 0.f, 0.f};
    }
    bf16x8 At[4][2], B0[2][2], B1[2][2];
    const int one8 = 0x7f7f7f7f;
    const int nt = K / 64;
    if (!pre) {
        WAIT_V(0);
        STAGE_B(SB(0, 0), 0, 0); STAGE_A(SA(0, 0), 0, 0);
        STAGE_B(SB(0, 1), 1, 0); STAGE_A(SA(0, 1), 1, 0);
        if (wr == 1) BAR();
        WAIT_V(4); BAR();
        STAGE_B(SB(1, 0), 0, 1); STAGE_A(SA(1, 0), 0, 1); STAGE_B(SB(1, 1), 1, 1);
        WAIT_V(6); BAR();
    } else {
        if (wr == 1) BAR();
        WAIT_V(0); BAR();
        BAR();
    }
    for (int t = 0; t < nt - 2; t += 2) {
        LDB(B0, 0, 0); SCHED(); LDA(At, 0, 0); STAGE_A(SA(1, 1), 1, t + 1);
        WAIT_L(8); BAR(); WAIT_L(0); MMA(0, 0, At, B0); BAR(); SCHED();
        LDB(B1, 0, 1); STAGE_B(SB(0, 0), 0, t + 2);
        BAR(); WAIT_L(0); MMA(0, 1, At, B1); BAR();
        LDA(At, 0, 1); STAGE_A(SA(0, 0), 0, t + 2);
        BAR(); WAIT_L(0); MMA(1, 0, At, B0); BAR(); SCHED();
        STAGE_B(SB(0, 1), 1, t + 2);
        WAIT_V(6); BAR(); MMA(1, 1, At, B1); BAR();
        LDB(B0, 1, 0); SCHED(); LDA(At, 1, 0); STAGE_A(SA(0, 1), 1, t + 2);
        WAIT_L(8); BAR(); WAIT_L(0); MMA(0, 0, At, B0); BAR(); SCHED();
        LDB(B1, 1, 1); STAGE_B(SB(1, 0), 0, t + 3);
        BAR(); WAIT_L(0); MMA(0, 1, At, B1); BAR();
        LDA(At, 1, 1); STAGE_A(SA(1, 0), 0, t + 3);
        BAR(); WAIT_L(0); MMA(1, 0, At, B0); BAR(); SCHED();
        STAGE_B(SB(1, 1), 1, t + 3);
        WAIT_V(6); BAR(); MMA(1, 1, At, B1); BAR();
    }
    { LDB(B0, 0, 0); WAIT_V(0); LDA(At, 0, 0); STAGE_A(SA(1, 1), 1, nt - 1);
      BAR(); WAIT_L(0); MMA(0, 0, At, B0); BAR();
      LDB(B1, 0, 1); BAR(); WAIT_L(0); MMA(0, 1, At, B1); BAR();
      LDA(At, 0, 1); WAIT_V(4); BAR(); WAIT_L(0); MMA(1, 0, At, B0); MMA(1, 1, At, B1); BAR(); }
    { LDB(B0, 1, 0); LDA(At, 1, 0); WAIT_V(2); BAR(); WAIT_L(0); MMA(0, 0, At, B0); BAR();
      LDB(B1, 1, 1); WAIT_V(0); BAR(); WAIT_L(0); MMA(0, 1, At, B1); BAR();
      LDA(At, 1, 1); BAR(); WAIT_L(0); MMA(1, 0, At, B0); MMA(1, 1, At, B1); BAR(); }
    if (wr == 0) BAR();
    if (FP8) asm volatile("s_nop 15\n\ts_nop 15" ::: "memory");
    int tz = threadIdx.x; asm volatile("" : "+v"(tz)); wid = tz >> 6; lane = tz & 63; wr = wid >> 2; wc = wid & 3; fr = lane & 15; fq = lane >> 4;
    next();
    epi(acc, wr, wc, fr, fq);
#undef SA
#undef SB
#undef STAGE_A
#undef STAGE_B
#undef LDA
#undef LDB
#undef MMA
}
template <class Epi, class Mid, class Next>
DI void gemm_tile_dual(const bf16_t* A, const bf16_t* A2, int lda, int brow, const bf16_t* Bt, const bf16_t* Bt2, int K, LAS char* stage, const Epi& epi, const Mid& mid, bool pre, const Next& next) {
    constexpr bool GATHER = false, FP8 = false, ZERO = true; const LAS int* rowidx = nullptr; (void)rowidx;
    f32x4 acc[2][2][4][2];
    LAS bf16_t* shm = (LAS bf16_t*)stage;
#define SA(b, h) (shm + ((b) * 2 + (h)) * G_HT)
#define SB(b, h) (shm + (4 + (b) * 2 + (h)) * G_HT)
    int tid = threadIdx.x;
    const int wv = __builtin_amdgcn_readfirstlane(tid >> 6);
    int R0, C0; stage_rc(tid * 16, R0, C0);
    unsigned agb[2][2];
    if (GATHER) {
#pragma unroll
        for (int h = 0; h < 2; ++h)
#pragma unroll
            for (int i = 0; i < 2; ++i) agb[h][i] = ((unsigned)rowidx[h * 128 + i * 64 + R0] * (unsigned)lda + C0) * 2u;
    } else {
#pragma unroll
        for (int h = 0; h < 2; ++h)
#pragma unroll
            for (int i = 0; i < 2; ++i) agb[h][i] = ((unsigned)(brow + h * 128 + i * 64 + R0) * (unsigned)lda + C0) * 2u;
    }
    const int Rb = Epi::PERM ? ((R0 & ~31) + perm32(R0 & 31)) : R0;
    const unsigned bgb = ((unsigned)Rb * (unsigned)K + C0) * 2u;
    const __amdgpu_buffer_rsrc_t rsA = __builtin_amdgcn_make_buffer_rsrc((void*)A, 0, 0x7fffffff, 0x00020000);
    const __amdgpu_buffer_rsrc_t rsB = __builtin_amdgcn_make_buffer_rsrc((void*)Bt, 0, 0x7fffffff, 0x00020000);
    const __amdgpu_buffer_rsrc_t rsA2 = __builtin_amdgcn_make_buffer_rsrc((void*)A2, 0, 0x7fffffff, 0x00020000);
    const __amdgpu_buffer_rsrc_t rsB2 = __builtin_amdgcn_make_buffer_rsrc((void*)Bt2, 0, 0x7fffffff, 0x00020000);
    const int nt1 = K / 64;
#define STAGE_A(P, h, kt) do { const int kt_ = (kt); _Pragma("unroll") for (int _i = 0; _i < 2; ++_i) { \
        if (kt_ < nt1) __builtin_amdgcn_raw_ptr_buffer_load_lds(rsA, (LAS unsigned*)((LAS char*)(P) + wv * 1024 + _i * 8192), 16, agb[h][_i], kt_ * 128, 0, 0); \
        else __builtin_amdgcn_raw_ptr_buffer_load_lds(rsA2, (LAS unsigned*)((LAS char*)(P) + wv * 1024 + _i * 8192), 16, agb[h][_i], (kt_ - nt1) * 128, 0, 0); } } while (0)
#define STAGE_B(P, h, kt) do { const int kt_ = (kt); _Pragma("unroll") for (int _i = 0; _i < 2; ++_i) { \
        if (kt_ < nt1) __builtin_amdgcn_raw_ptr_buffer_load_lds(rsB, (LAS unsigned*)((LAS char*)(P) + wv * 1024 + _i * 8192), 16, bgb, (((h) * 128 + _i * 64) * K + kt_ * 64) * 2, 0, 0); \
        else __builtin_amdgcn_raw_ptr_buffer_load_lds(rsB2, (LAS unsigned*)((LAS char*)(P) + wv * 1024 + _i * 8192), 16, bgb, (((h) * 128 + _i * 64) * K + (kt_ - nt1) * 64) * 2, 0, 0); } } while (0)
#define LDA(dst, b, h) _Pragma("unroll") for (int m = 0; m < 4; ++m) _Pragma("unroll") for (int k = 0; k < 2; ++k) \
        dst[m][k] = *(const LAS bf16x8*)((LAS char*)SA(b, h) + lds_byte(wr * 64 + m * 16 + fr, k * 32 + fq * 8))
#define LDB(dst, b, h) _Pragma("unroll") for (int n = 0; n < 2; ++n) _Pragma("unroll") for (int k = 0; k < 2; ++k) \
        dst[n][k] = *(const LAS bf16x8*)((LAS char*)SB(b, h) + lds_byte(wc * 32 + n * 16 + fr, k * 32 + fq * 8))
#define MMA(ai, bj, At_, Bt_) do { __builtin_amdgcn_s_setprio(1); \
        if (!FP8) { _Pragma("unroll") for (int m = 0; m < 4; ++m) _Pragma("unroll") for (int n = 0; n < 2; ++n) _Pragma("unroll") for (int k = 0; k < 2; ++k) \
            acc[ai][bj][m][n] = MFMA16(Bt_[n][k], At_[m][k], acc[ai][bj][m][n]); } \
        else { _Pragma("unroll") for (int m = 0; m < 4; ++m) _Pragma("unroll") for (int n = 0; n < 2; ++n) \
            mfma_f8(acc[ai][bj][m][n], cat8(Bt_[n][0], Bt_[n][1]), cat8(At_[m][0], At_[m][1]), one8); } \
        __builtin_amdgcn_s_setprio(0); } while (0)

    int wid = tid >> 6, lane = tid & 63, wr = wid >> 2, wc = wid & 3, fr = lane & 15, fq = lane >> 4;
    if (ZERO) {
#pragma unroll
    for (int a = 0; a < 2; ++a)
#pragma unroll
        for (int b = 0; b < 2; ++b)
#pragma unroll
            for (int m = 0; m < 4; ++m)
#pragma unroll
                for (int n = 0; n < 2; ++n) acc[a][b][m][n] = (f32x4){0.f, 0.f, 0.f, 0.f};
    }
    bf16x8 At[4][2], B0[2][2], B1[2][2];
    const int one8 = 0x7f7f7f7f;
    const int nt = 2 * nt1;
    if (!pre) {
        WAIT_V(0);
        STAGE_B(SB(0, 0), 0, 0); STAGE_A(SA(0, 0), 0, 0);
        STAGE_B(SB(0, 1), 1, 0); STAGE_A(SA(0, 1), 1, 0);
        if (wr == 1) BAR();
        WAIT_V(4); BAR();
        STAGE_B(SB(1, 0), 0, 1); STAGE_A(SA(1, 0), 0, 1); STAGE_B(SB(1, 1), 1, 1);
        WAIT_V(6); BAR();
    } else {
        if (wr == 1) BAR();
        WAIT_V(0); BAR();
        BAR();
    }
    for (int t = 0; t < nt - 2; t += 2) {
        if (t == nt1) {
            int t2 = threadIdx.x; asm volatile("" : "+v"(t2));
            mid(acc, (t2 >> 6) >> 2, (t2 >> 6) & 3, (t2 & 63) & 15, (t2 & 63) >> 4);
        }
        LDB(B0, 0, 0); SCHED(); LDA(At, 0, 0); STAGE_A(SA(1, 1), 1, t + 1);
        WAIT_L(8); BAR(); WAIT_L(0); MMA(0, 0, At, B0); BAR(); SCHED();
        LDB(B1, 0, 1); STAGE_B(SB(0, 0), 0, t + 2);
        BAR(); WAIT_L(0); MMA(0, 1, At, B1); BAR();
        LDA(At, 0, 1); STAGE_A(SA(0, 0), 0, t + 2);
        BAR(); WAIT_L(0); MMA(1, 0, At, B0); BAR(); SCHED();
        STAGE_B(SB(0, 1), 1, t + 2);
        WAIT_V(6); BAR(); MMA(1, 1, At, B1); BAR();
        LDB(B0, 1, 0); SCHED(); LDA(At, 1, 0); STAGE_A(SA(0, 1), 1, t + 2);
        WAIT_L(8); BAR(); WAIT_L(0); MMA(0, 0, At, B0); BAR(); SCHED();
        LDB(B1, 1, 1); STAGE_B(SB(1, 0), 0, t + 3);
        BAR(); WAIT_L(0); MMA(0, 1, At, B1); BAR();
        LDA(At, 1, 1); STAGE_A(SA(1, 0), 0, t + 3);
        BAR(); WAIT_L(0); MMA(1, 0, At, B0); BAR(); SCHED();
        STAGE_B(SB(1, 1), 1, t + 3);
        WAIT_V(6); BAR(); MMA(1, 1, At, B1); BAR();
    }
    { LDB(B0, 0, 0); WAIT_V(0); LDA(At, 0, 0); STAGE_A(SA(1, 1), 1, nt - 1);
      BAR(); WAIT_L(0); MMA(0, 0, At, B0); BAR();
      LDB(B1, 0, 1); BAR(); WAIT_L(0); MMA(0, 1, At, B1); BAR();
      LDA(At, 0, 1); WAIT_V(4); BAR(); WAIT_L(0); MMA(1, 0, At, B0); MMA(1, 1, At, B1); BAR(); }
    { LDB(B0, 1, 0); LDA(At, 1, 0); WAIT_V(2); BAR(); WAIT_L(0); MMA(0, 0, At, B0); BAR();
      LDB(B1, 1, 1); WAIT_V(0); BAR(); WAIT_L(0); MMA(0, 1, At, B1); BAR();
      LDA(At, 1, 1); BAR(); WAIT_L(0); MMA(1, 0, At, B0); MMA(1, 1, At, B1); BAR(); }
    if (wr == 0) BAR();
    if (FP8) asm volatile("s_nop 15\n\ts_nop 15" ::: "memory");
    int tz = threadIdx.x; asm volatile("" : "+v"(tz)); wid = tz >> 6; lane = tz & 63; wr = wid >> 2; wc = wid & 3; fr = lane & 15; fq = lane >> 4;
    next();
    epi(acc, wr, wc, fr, fq);
#undef SA
#undef SB
#undef STAGE_A
#undef STAGE_B
#undef LDA
#undef LDB
#undef MMA
}
template <bool GATHER, bool FP8, class Epi, class Next>
DI void gemm_tile(const bf16_t* A, int lda, int brow, const LAS int* rowidx, const bf16_t* Bt, int K, LAS char* stage, const Epi& epi, bool pre, const Next& next) {
    f32x4 acc[2][2][4][2];
    gemm_tile_acc<GATHER, FP8, true>(A, lda, brow, rowidx, Bt, K, stage, epi, pre, next, acc);
}

DI bool unit_order(int i, int G, int c, int nM, int nN, int& pm, int& pn) {
    const int nwg = nM * nN; const long L = (long)i * G + c; if (L >= nwg) return false;
    int wgid = (int)L; { const int q = nwg / 8, r = nwg % 8, xcd = wgid % 8, off = wgid / 8; wgid = (xcd < r ? xcd * (q + 1) : r * (q + 1) + (xcd - r) * q) + off; }
    const int nig = 8 * nN, gid = wgid / nig, fm = gid * 8, gsz = (nM - fm) < 8 ? (nM - fm) : 8;
    pm = fm + ((wgid % nig) % gsz); pn = (wgid % nig) / gsz; return true;
}

#define EPI_LOOP(BODY) _Pragma("unroll") for (int ai = 0; ai < 2; ++ai) _Pragma("unroll") for (int m = 0; m < 4; ++m) { const int row = row0 + ai * 128 + m * 16; \
    _Pragma("unroll") for (int bj = 0; bj < 2; ++bj) _Pragma("unroll") for (int n = 0; n < 2; ++n) { const int col = col0 + bj * 128 + n * 16; f32x4 v = acc[ai][bj][m][n]; BODY } }

#define EPI_LOOP8(...) _Pragma("unroll") for (int ai = 0; ai < 2; ++ai) _Pragma("unroll") for (int m = 0; m < 4; ++m) { const int row = row0 + ai * 128 + m * 16; \
    _Pragma("unroll") for (int bj = 0; bj < 2; ++bj) { const int col = col0 + bj * 128; const f32x4 va = acc[ai][bj][m][0], vb = acc[ai][bj][m][1]; \
        float v[8] = {va[0], va[1], va[2], va[3], vb[0], vb[1], vb[2], vb[3]}; __VA_ARGS__ } }
struct EpiProj {
    static constexpr bool PERM = true;
    bf16_t* proj; const float* b_gate; int pm, pn; float sc; int ld, colsub;
    DI void operator()(f32x4 (&acc)[2][2][4][2], int wr, int wc, int fr, int fq) const {
        const int row0 = pm * 256 + wr * 64 + fr, col0 = pn * 256 + wc * 32 + fq * 8;
        const int kind = pn < 24 ? 0 : (pn < 32 ? 1 : (pn < 56 ? 0 : 2));
        EPI_LOOP8(
            v[0] *= sc; v[1] *= sc; v[2] *= sc; v[3] *= sc; v[4] *= sc; v[5] *= sc; v[6] *= sc; v[7] *= sc;
            if (kind == 1) { v[0] = siluf_(v[0]); v[1] = siluf_(v[1]); v[2] = siluf_(v[2]); v[3] = siluf_(v[3]); v[4] = siluf_(v[4]); v[5] = siluf_(v[5]); v[6] = siluf_(v[6]); v[7] = siluf_(v[7]); }
            if (kind == 2) { const f32x4 b0 = *(const f32x4*)(b_gate + (col - PC_GATE)), b1 = *(const f32x4*)(b_gate + (col - PC_GATE) + 4);
                v[0] = sigmoidf_(v[0] + b0[0]); v[1] = sigmoidf_(v[1] + b0[1]); v[2] = sigmoidf_(v[2] + b0[2]); v[3] = sigmoidf_(v[3] + b0[3]);
                v[4] = sigmoidf_(v[4] + b1[0]); v[5] = sigmoidf_(v[5] + b1[1]); v[6] = sigmoidf_(v[6] + b1[2]); v[7] = sigmoidf_(v[7] + b1[3]); }
            u32x4 w = {cvt_pk_bf16(v[0], v[1]), cvt_pk_bf16(v[2], v[3]), cvt_pk_bf16(v[4], v[5]), cvt_pk_bf16(v[6], v[7])};
            *(u32x4*)(proj + (size_t)row * ld + (col - colsub)) = w;
        )
    }
};
struct EpiScaleA {
    static constexpr bool PERM = true;
    const bf16_t* proj; int pm, pn;
    DI void operator()(f32x4 (&acc)[2][2][4][2], int wr, int wc, int fr, int fq) const {
        const int row0 = pm * 256 + wr * 64 + fr, col0 = pn * 256 + wc * 32 + fq * 8;
#pragma unroll
        for (int ai = 0; ai < 2; ++ai)
#pragma unroll
            for (int m = 0; m < 4; ++m) { const int row = row0 + ai * 128 + m * 16;
#pragma unroll
                for (int bj = 0; bj < 2; ++bj) { const int col = col0 + bj * 128;
                    const u32x4 ga = *(const u32x4*)(proj + (size_t)row * PROJ_LD + PC_GATE + col), gb = *(const u32x4*)(proj + (size_t)row * PROJ_LD + PC_GATE + 2048 + col);
                    f32x4 v0 = acc[ai][bj][m][0], v1 = acc[ai][bj][m][1];
                    v0[0] *= bflo(ga[0]) * __builtin_amdgcn_rcpf(fmaxf(bflo(gb[0]), 1e-18f)); v0[1] *= bfhi(ga[0]) * __builtin_amdgcn_rcpf(fmaxf(bfhi(gb[0]), 1e-18f));
                    v0[2] *= bflo(ga[1]) * __builtin_amdgcn_rcpf(fmaxf(bflo(gb[1]), 1e-18f)); v0[3] *= bfhi(ga[1]) * __builtin_amdgcn_rcpf(fmaxf(bfhi(gb[1]), 1e-18f));
                    v1[0] *= bflo(ga[2]) * __builtin_amdgcn_rcpf(fmaxf(bflo(gb[2]), 1e-18f)); v1[1] *= bfhi(ga[2]) * __builtin_amdgcn_rcpf(fmaxf(bfhi(gb[2]), 1e-18f));
                    v1[2] *= bflo(ga[3]) * __builtin_amdgcn_rcpf(fmaxf(bflo(gb[3]), 1e-18f)); v1[3] *= bfhi(ga[3]) * __builtin_amdgcn_rcpf(fmaxf(bfhi(gb[3]), 1e-18f));
                    acc[ai][bj][m][0] = v0; acc[ai][bj][m][1] = v1;
                } }
    }
};
struct EpiBranchB {
    static constexpr bool PERM = true;
    const bf16_t* proj; bf16_t* mrg; int pm, pn;
    DI void operator()(f32x4 (&acc)[2][2][4][2], int wr, int wc, int fr, int fq) const {
        const int row0 = pm * 256 + wr * 64 + fr, col0 = pn * 256 + wc * 32 + fq * 8;
        EPI_LOOP8(
            const u32x4 g = *(const u32x4*)(proj + (size_t)row * PROJ_LD + PC_GATE + 2048 + col);
            v[0] *= bflo(g[0]); v[1] *= bfhi(g[0]); v[2] *= bflo(g[1]); v[3] *= bfhi(g[1]); v[4] *= bflo(g[2]); v[5] *= bfhi(g[2]); v[6] *= bflo(g[3]); v[7] *= bfhi(g[3]);
            u32x4 w = {cvt_pk_bf16(v[0], v[1]), cvt_pk_bf16(v[2], v[3]), cvt_pk_bf16(v[4], v[5]), cvt_pk_bf16(v[6], v[7])};
            *(u32x4*)(mrg + (size_t)row * DM + col) = w;
        )
    }
};
struct EpiOut {
    static constexpr bool PERM = false;
    const float* x; float* out; int pm, pn;
    DI void operator()(f32x4 (&acc)[2][2][4][2], int wr, int wc, int fr, int fq) const {
        const int row0 = pm * 256 + wr * 64 + fr, col0 = pn * 256 + wc * 32 + fq * 4;
        EPI_LOOP(
            const f32x4 t = *(const f32x4*)(x + (size_t)row * DM + col);
            v += t;
            *(f32x4*)(out + (size_t)row * DM + col) = v;
        )
    }
};
struct EpiGateUp {
    static constexpr bool PERM = true;
    unsigned char* act; const float* bias; int slot0, nt;
    DI void operator()(f32x4 (&acc)[2][2][4][2], int wr, int wc, int fr, int fq) const {
        const int row0 = slot0 + wr * 64 + fr, col = nt * 128 + wc * 32 + fq * 8;
        constexpr float isc = 1.f / (W8_SCALE * H8_SCALE);
        const f32x4 bg0 = *(const f32x4*)(bias + col), bg1 = *(const f32x4*)(bias + col + 4), bu0 = *(const f32x4*)(bias + 2048 + col), bu1 = *(const f32x4*)(bias + 2048 + col + 4);
#pragma unroll
        for (int ai = 0; ai < 2; ++ai)
#pragma unroll
            for (int m = 0; m < 4; ++m) {
                const int row = row0 + ai * 128 + m * 16;
                const f32x4 g0 = acc[ai][0][m][0] * isc + bg0, g1 = acc[ai][0][m][1] * isc + bg1, u0 = acc[ai][1][m][0] * isc + bu0, u1 = acc[ai][1][m][1] * isc + bu1;
                float r[8];
#pragma unroll
                for (int j = 0; j < 4; ++j) {
                    const float ga = fminf(g0[j], 7.f), ua = fminf(fmaxf(u0[j], -7.f), 7.f); r[j] = (ua + 1.f) * ga * sigmoidf_(1.702f * ga) * A8_SCALE;
                    const float gb = fminf(g1[j], 7.f), ub = fminf(fmaxf(u1[j], -7.f), 7.f); r[4 + j] = (ub + 1.f) * gb * sigmoidf_(1.702f * gb) * A8_SCALE;
                }
                u32x2 w; w[0] = cvt4_fp8(r[0], r[1], r[2], r[3]); w[1] = cvt4_fp8(r[4], r[5], r[6], r[7]);
                *(u32x2*)(act + (size_t)row * DM + col) = w;
            }
    }
};
struct EpiDown {
    static constexpr bool PERM = true;
    unsigned char* ys; const float* bias; const float* wrow; int slot0, pn;
    DI void operator()(f32x4 (&acc)[2][2][4][2], int wr, int wc, int fr, int fq) const {
        const int r0 = wr * 64 + fr, col0 = pn * 256 + wc * 32 + fq * 8;
        constexpr float isc = 1.f / (W8_SCALE * A8_SCALE);
#pragma unroll
        for (int bj = 0; bj < 2; ++bj) {
            const int col = col0 + bj * 128;
            const f32x4 b0 = *(const f32x4*)(bias + col), b1 = *(const f32x4*)(bias + col + 4);
#pragma unroll
            for (int ai = 0; ai < 2; ++ai)
#pragma unroll
                for (int m = 0; m < 4; ++m) {
                    const int r = r0 + ai * 128 + m * 16; const float w8 = wrow[r] * Y8_SCALE;
                    const f32x4 v0 = (acc[ai][bj][m][0] * isc + b0) * w8, v1 = (acc[ai][bj][m][1] * isc + b1) * w8;
                    u32x2 w = {cvt4_fp8(v0[0], v0[1], v0[2], v0[3]), cvt4_fp8(v1[0], v1[1], v1[2], v1[3])};
                    *(u32x2*)(ys + (size_t)(slot0 + r) * DM + col) = w;
                }
        }
    }
};

DI void p1_inproj(const Params& p, LAS char* lds) {
    const int tid = threadIdx.x, lane = tid & 63, wave = tid >> 6;
    const bf16_t* h = (const bf16_t*)(p.ws + WS_H);
    {
        const bf16_t* wsl = (const bf16_t*)(p.ws + WS_WS); float* ba = (float*)(p.ws + WS_BA);
        const int l15 = lane & 15, l4 = lane >> 4;
        for (int task = blockIdx.x * 8 + wave; task < NTOK / 16; task += gridDim.x * 8) {
            f32x4 a0 = {0.f, 0.f, 0.f, 0.f}, a1 = {0.f, 0.f, 0.f, 0.f};
            const bf16_t* ar = h + (size_t)(task * 16 + l15) * DM + l4 * 8;
            const bf16_t* b0 = wsl + (size_t)l15 * DM + l4 * 8; const bf16_t* b1 = b0 + 16 * DM;
#pragma unroll 8
            for (int k0 = 0; k0 < DM; k0 += 32) {
                const bf16x8 a = *(const bf16x8*)(ar + k0);
                a0 = MFMA16(a, *(const bf16x8*)(b0 + k0), a0); a1 = MFMA16(a, *(const bf16x8*)(b1 + k0), a1);
            }
#pragma unroll
            for (int r = 0; r < 4; ++r) { float* o = ba + (size_t)(task * 16 + l4 * 4 + r) * 32 + l15; o[0] = a0[r]; o[16] = a1[r]; }
        }
    }
    const bf16_t* win = (const bf16_t*)(p.ws + WS_WIN);
    const bf16_t* h8 = (const bf16_t*)(p.ws + WS_H8); const unsigned char* win8 = p.ws + WS_WIN8;
    int pm, pn; bool have = unit_order(0, gridDim.x, blockIdx.x, 64, 72, pm, pn), pre = false;
    for (int i = 0; have; ++i) {
        int pm2, pn2; const bool have2 = unit_order(i + 1, gridDim.x, blockIdx.x, 64, 72, pm2, pn2);
        const bool f8 = pn >= 56 || (pn >= 24 && pn < 32), f82 = pn2 >= 56 || (pn2 >= 24 && pn2 < 32);
        const int r8 = pn >= 56 ? (pn - 56) * 256 : 4096 + (pn - 24) * 256, r82 = pn2 >= 56 ? (pn2 - 56) * 256 : 4096 + (pn2 - 24) * 256;
        const bool isv = pn >= 48 && pn < 56;
        EpiProj e{(bf16_t*)(p.ws + (isv ? WS_VBUF : WS_PROJ)), p.b_gate, pm, pn, f8 ? 1.f / (W8_SCALE * H8_SCALE) : 1.f, isv ? DM : PROJ_LD, isv ? PC_VB : 0};
        auto next = [&]() { if (have2) { if (f82) gemm_issue<false, true>(h8, DM / 2, pm2 * 256, (const LAS int*)nullptr, (const bf16_t*)(win8 + (size_t)r82 * DM), DM / 2, lds + LDS_MISC);
                                         else gemm_issue<false, true>(h, DM, pm2 * 256, (const LAS int*)nullptr, win + (size_t)pn2 * 256 * DM, DM, lds + LDS_MISC); } };
        if (f8) gemm_tile<false, true>(h8, DM / 2, pm * 256, (const LAS int*)nullptr, (const bf16_t*)(win8 + (size_t)r8 * DM), DM / 2, lds + LDS_MISC, e, pre, next);
        else gemm_tile<false, false>(h, DM, pm * 256, (const LAS int*)nullptr, win + (size_t)pn * 256 * DM, DM, lds + LDS_MISC, e, pre, next);
        pre = have2; have = have2; pm = pm2; pn = pn2;
    }
}

DI void p4_branches(const Params& p, LAS char* lds) {
    const bf16_t* oa = (const bf16_t*)(p.ws + WS_OA); const bf16_t* ob = (const bf16_t*)(p.ws + WS_OB);
    const bf16_t* wa = (const bf16_t*)(p.ws + WS_WA); const bf16_t* wb = (const bf16_t*)(p.ws + WS_WB);
    int pm, pn; bool have = unit_order(0, gridDim.x, blockIdx.x, 64, 8, pm, pn), pre = false;
    for (int i = 0; have; ++i) {
        int pm2, pn2; const bool have2 = unit_order(i + 1, gridDim.x, blockIdx.x, 64, 8, pm2, pn2);
        EpiScaleA ea{(const bf16_t*)(p.ws + WS_PROJ), pm, pn};
        EpiBranchB eb{(const bf16_t*)(p.ws + WS_PROJ), (bf16_t*)(p.ws + WS_MRG), pm, pn};
        auto next = [&]() { if (have2) gemm_issue<false, true>(oa, DM, pm2 * 256, (const LAS int*)nullptr, wa + (size_t)pn2 * 256 * DM, DM, lds + LDS_MISC); };
        gemm_tile_dual(oa, ob, DM, pm * 256, wa + (size_t)pn * 256 * DM, wb + (size_t)pn * 256 * DM, DM, lds + LDS_MISC, eb, ea, pre, next);
        pre = have2; have = have2; pm = pm2; pn = pn2;
    }
}
DI void p5_outproj(const Params& p, LAS char* lds) {
    const bf16_t* mg = (const bf16_t*)(p.ws + WS_MRG); const bf16_t* wo = (const bf16_t*)(p.ws + WS_WO);
    int pm, pn; bool have = unit_order(0, gridDim.x, blockIdx.x, 64, 8, pm, pn), pre = false;
    for (int i = 0; have; ++i) {
        int pm2, pn2; const bool have2 = unit_order(i + 1, gridDim.x, blockIdx.x, 64, 8, pm2, pn2);
        EpiOut e{p.x, p.out, pm, pn};
        auto next = [&]() { if (have2) gemm_issue<false, false>(mg, DM, pm2 * 256, (const LAS int*)nullptr, wo + (size_t)pn2 * 256 * DM, DM, lds + LDS_MISC); };
        gemm_tile<false, false>(mg, DM, pm * 256, (const LAS int*)nullptr, wo + (size_t)pn * 256 * DM, DM, lds + LDS_MISC, e, pre, next);
        pre = have2; have = have2; pm = pm2; pn = pn2;
    }
}

constexpr int GP_SC = 0, GP_Q = 1024, GP_K = GP_Q + 17408, GP_VBT = GP_K + 17408, GP_KBGT = GP_VBT + 18432, GP_L = GP_KBGT + 18432, GP_T = GP_L + 17408;
DI bf16x8 ld_frag(const LAS char* p) { return *(const LAS bf16x8*)p; }

DI void gdn_prep_unit(const Params& p, LAS char* st, int u) {
    const int tid = threadIdx.x, lane = tid & 63, wave = tid >> 6, l15 = lane & 15, l4 = lane >> 4;
    const int bh = u >> 6, n = u & 63, b = bh >> 4, hh = bh & 15;
    const int row_base = b * SEQ + n * 64;
    LAS float* sc = (LAS float*)(st + GP_SC);
    const bf16_t* proj = (const bf16_t*)(p.ws + WS_PROJ);
    if (wave == 0) {
        const float* ba = (const float*)(p.ws + WS_BA) + (size_t)(row_base + lane) * 32;
        const float braw = ba[hh], araw = ba[16 + hh] + p.dt_bias[hh];
        const float sp = fmaxf(araw, 0.f) + log1pf(__expf(-fabsf(araw)));
        const float g = -__expf(p.a_log[hh]) * sp;
        float c = g;
#pragma unroll
        for (int o = 1; o < 64; o <<= 1) { const float t = __shfl_up(c, o); if (lane >= o) c += t; }
        const float gl = __shfl(c, 63);
        sc[lane] = c; sc[64 + lane] = sigmoidf_(braw); sc[128 + lane] = __expf(c); sc[192 + lane] = __expf(gl - c);
        if (lane == 0) ((float*)(p.ws + WS_GL))[u] = __expf(gl);
    }
    float o[8][8]; int seg = 0, part = 0, ch0 = 0;
    if (tid < 384) {
        seg = tid / 48; const int rem = tid % 48; part = rem >> 4; ch0 = (rem & 15) * 8;
        const int colb = PC_QKV + part * 2048 + hh * 128 + ch0;
        const bf16_t* src = proj + (size_t)(row_base + seg * 8) * PROJ_LD + colb;
        bf16x8 raw[11];
#pragma unroll
        for (int r = 0; r < 11; ++r) {
            raw[r] = (bf16x8){0, 0, 0, 0, 0, 0, 0, 0};
            if (!(n == 0 && seg == 0 && r < 3)) raw[r] = *(const bf16x8*)(src + (ptrdiff_t)(r - 3) * PROJ_LD);
        }
        float w[4][8];
#pragma unroll
        for (int j = 0; j < 4; ++j) {
            const f32x4 w0 = *(const f32x4*)(p.conv_w + j * 6144 + colb), w1 = *(const f32x4*)(p.conv_w + j * 6144 + colb + 4);
            w[j][0] = w0[0]; w[j][1] = w0[1]; w[j][2] = w0[2]; w[j][3] = w0[3]; w[j][4] = w1[0]; w[j][5] = w1[1]; w[j][6] = w1[2]; w[j][7] = w1[3];
        }
#pragma unroll
        for (int t = 0; t < 8; ++t)
#pragma unroll
            for (int c = 0; c < 8; ++c) {
                float a = 0.f;
#pragma unroll
                for (int j = 0; j < 4; ++j) a += bf2f((unsigned short)raw[t + j][c]) * w[j][c];
                o[t][c] = siluf_(a);
            }
    }
    __syncthreads();
    if (tid < 384) {
        const bf16_t* dummy = nullptr; (void)dummy;
        float rinv[8];
        if (part < 2) {
#pragma unroll
            for (int t = 0; t < 8; ++t) {
                float ss = 0.f;
#pragma unroll
                for (int c = 0; c < 8; ++c) ss += o[t][c] * o[t][c];
                ss += __shfl_xor(ss, 1); ss += __shfl_xor(ss, 2); ss += __shfl_xor(ss, 4); ss += __shfl_xor(ss, 8);
                rinv[t] = rsqrtf(ss + NORM_EPS);
            }
        }
        if (part == 0) {
            bf16_t* qg = (bf16_t*)(p.ws + WS_QG) + (size_t)u * 8192;
#pragma unroll
            for (int t = 0; t < 8; ++t) {
                const int tok = seg * 8 + t; const float s = rinv[t] * 0.08838834764831845f, eg = sc[128 + tok];
                float q[8];
#pragma unroll
                for (int c = 0; c < 8; ++c) q[c] = o[t][c] * s;
                u32x4 w = {cvt_pk_bf16(q[0], q[1]), cvt_pk_bf16(q[2], q[3]), cvt_pk_bf16(q[4], q[5]), cvt_pk_bf16(q[6], q[7])};
                *(LAS u32x4*)(st + GP_Q + tok * 272 + ch0 * 2) = w;
                u32x4 w2 = {cvt_pk_bf16(q[0] * eg, q[1] * eg), cvt_pk_bf16(q[2] * eg, q[3] * eg), cvt_pk_bf16(q[4] * eg, q[5] * eg), cvt_pk_bf16(q[6] * eg, q[7] * eg)};
                *(u32x4*)(qg + tok * 128 + ch0) = w2;
            }
        } else if (part == 1) {
            bf16_t* kdt = (bf16_t*)(p.ws + WS_KDT) + (size_t)u * 8192;
            float be[8], ed[8];
#pragma unroll
            for (int t = 0; t < 8; ++t) { const int tok = seg * 8 + t; be[t] = sc[64 + tok] * sc[128 + tok]; ed[t] = sc[192 + tok]; }
#pragma unroll
            for (int t = 0; t < 8; ++t) {
                const int tok = seg * 8 + t;
#pragma unroll
                for (int c = 0; c < 8; ++c) o[t][c] *= rinv[t];
                u32x4 w = {cvt_pk_bf16(o[t][0], o[t][1]), cvt_pk_bf16(o[t][2], o[t][3]), cvt_pk_bf16(o[t][4], o[t][5]), cvt_pk_bf16(o[t][6], o[t][7])};
                *(LAS u32x4*)(st + GP_K + tok * 272 + ch0 * 2) = w;
            }
#pragma unroll
            for (int c = 0; c < 8; ++c) {
                u32x4 w = {cvt_pk_bf16(o[0][c] * be[0], o[1][c] * be[1]), cvt_pk_bf16(o[2][c] * be[2], o[3][c] * be[3]), cvt_pk_bf16(o[4][c] * be[4], o[5][c] * be[5]), cvt_pk_bf16(o[6][c] * be[6], o[7][c] * be[7])};
                *(LAS u32x4*)(st + GP_KBGT + (ch0 + c) * 144 + seg * 16) = w;
                u32x4 w2 = {cvt_pk_bf16(o[0][c] * ed[0], o[1][c] * ed[1]), cvt_pk_bf16(o[2][c] * ed[2], o[3][c] * ed[3]), cvt_pk_bf16(o[4][c] * ed[4], o[5][c] * ed[5]), cvt_pk_bf16(o[6][c] * ed[6], o[7][c] * ed[7])};
                *(u32x4*)(kdt + (ch0 + c) * 64 + seg * 8) = w2;
            }
        } else {
            float be[8];
#pragma unroll
            for (int t = 0; t < 8; ++t) be[t] = sc[64 + seg * 8 + t];
#pragma unroll
            for (int c = 0; c < 8; ++c) {
                u32x4 w = {cvt_pk_bf16(o[0][c] * be[0], o[1][c] * be[1]), cvt_pk_bf16(o[2][c] * be[2], o[3][c] * be[3]), cvt_pk_bf16(o[4][c] * be[4], o[5][c] * be[5]), cvt_pk_bf16(o[6][c] * be[6], o[7][c] * be[7])};
                *(LAS u32x4*)(st + GP_VBT + (ch0 + c) * 144 + seg * 16) = w;
            }
        }
    }
    __syncthreads();
    {
        const int mi = wave >> 1; bf16_t* qkg = (bf16_t*)(p.ws + WS_QK) + (size_t)u * 4096;
#pragma unroll
        for (int jj = 0; jj < 2; ++jj) {
            const int nj = (wave & 1) * 2 + jj;
            const int i = mi * 16 + l15, j0 = nj * 16 + l4 * 4;
            if (nj > mi) { *(u32x2*)(qkg + i * 64 + j0) = (u32x2){0u, 0u}; continue; }
            f32x4 aK = {0.f, 0.f, 0.f, 0.f}, aQ = {0.f, 0.f, 0.f, 0.f};
#pragma unroll
            for (int ks = 0; ks < 4; ++ks) {
                const int kb = (ks * 32 + l4 * 8) * 2;
                const bf16x8 kfj = ld_frag(st + GP_K + (nj * 16 + l15) * 272 + kb), kfi = ld_frag(st + GP_K + (mi * 16 + l15) * 272 + kb), qfi = ld_frag(st + GP_Q + (mi * 16 + l15) * 272 + kb);
                aK = MFMA16(kfj, kfi, aK); aQ = MFMA16(kfj, qfi, aQ);
            }
            const float gi = sc[i], bi = sc[64 + i]; f32x4 lv; float qv[4];
#pragma unroll
            for (int r = 0; r < 4; ++r) {
                const int j = j0 + r; const float d = gi - sc[j];
                const float dec = (i >= j) ? __expf(d) : 0.f;
                lv[r] = (i > j) ? bi * aK[r] * dec : 0.f; qv[r] = aQ[r] * dec;
            }
            *(LAS f32x4*)(st + GP_L + (i * 68 + j0) * 4) = lv;
            u32x2 w; w[0] = cvt_pk_bf16(qv[0], qv[1]); w[1] = cvt_pk_bf16(qv[2], qv[3]);
            *(u32x2*)(qkg + i * 64 + j0) = w;
        }
    }
    __syncthreads();
    if (wave == 0) {
        int ln = lane, lz = 0; asm volatile("" : "+v"(ln), "+v"(lz));
        const LAS char* Lb = st + GP_L + (lz & ~15);
        float t[64];
#pragma unroll
        for (int i = 0; i < 64; ++i) t[i] = 0.f;
        t[0] = (ln == 0) ? 1.f : 0.f;
        f32x4 row[2][16];
        row[1][0] = *(const LAS f32x4*)(Lb + 1 * 272);
#pragma unroll
        for (int i = 1; i < 64; ++i) {
            if (i + 1 < 64) {
#pragma unroll
                for (int q = 0; q < (i + 4) / 4; ++q) row[(i + 1) & 1][q] = *(const LAS f32x4*)(Lb + (i + 1) * 272 + q * 16);
            }
            f32x2 s0 = {0.f, 0.f}, s1 = {0.f, 0.f};
#pragma unroll
            for (int q = 0; q < (i + 3) / 4; ++q) {
                const f32x4 l = row[i & 1][q];
                s0 += (f32x2){l[0], l[1]} * (f32x2){t[4 * q], t[4 * q + 1]};
                s1 += (f32x2){l[2], l[3]} * (f32x2){t[4 * q + 2], t[4 * q + 3]};
            }
            t[i] = ((ln == i) ? 1.f : 0.f) - ((s0[0] + s0[1]) + (s1[0] + s1[1]));
        }
        LAS bf16_t* T = (LAS bf16_t*)(st + GP_T);
#pragma unroll
        for (int i = 0; i < 64; ++i) T[i * 72 + lane] = (bf16_t)(cvt_pk_bf16(t[i], 0.f) & 0xffffu);
    }
    __syncthreads();
    {
        bf16x8 tf[4][2];
#pragma unroll
        for (int mi = 0; mi < 4; ++mi)
#pragma unroll
            for (int ks = 0; ks < 2; ++ks) tf[mi][ks] = ld_frag(st + GP_T + (mi * 16 + l15) * 144 + (ks * 32 + l4 * 8) * 2);
        bf16x8 vf[2], kf[2];
#pragma unroll
        for (int ks = 0; ks < 2; ++ks) { vf[ks] = ld_frag(st + GP_VBT + (wave * 16 + l15) * 144 + (ks * 32 + l4 * 8) * 2); kf[ks] = ld_frag(st + GP_KBGT + (wave * 16 + l15) * 144 + (ks * 32 + l4 * 8) * 2); }
        bf16_t* ut = (bf16_t*)(p.ws + WS_UT) + (size_t)u * 8192; bf16_t* nw = (bf16_t*)(p.ws + WS_NEGW) + (size_t)u * 8192;
#pragma unroll
        for (int mi = 0; mi < 4; ++mi) {
            f32x4 au = {0.f, 0.f, 0.f, 0.f}, aw = {0.f, 0.f, 0.f, 0.f};
#pragma unroll
            for (int ks = 0; ks < 2; ++ks) { au = MFMA16(tf[mi][ks], vf[ks], au); aw = MFMA16(kf[ks], tf[mi][ks], aw); }
            u32x2 w; w[0] = cvt_pk_bf16(au[0], au[1]); w[1] = cvt_pk_bf16(au[2], au[3]);
            *(u32x2*)(ut + (wave * 16 + l15) * 64 + mi * 16 + l4 * 4) = w;
            u32x2 w2; w2[0] = cvt_pk_bf16(-aw[0], -aw[1]); w2[1] = cvt_pk_bf16(-aw[2], -aw[3]);
            *(u32x2*)(nw + (mi * 16 + l15) * 128 + wave * 16 + l4 * 4) = w2;
        }
    }
    __syncthreads();
}

constexpr int GH_SC = 0, GH_Q = 1024, GH_K = GH_Q + 18432, GH_L = GH_K + 17408, GH_X = GH_L + 17408, GH_T = GH_K, GH_VBT = GH_Q, GH_BYTES = GH_X + 18432;

DI void gdn_prep_pair(const Params& p, LAS char* st0, int pair) {
    int tid_ = threadIdx.x; asm volatile("" : "+v"(tid_));
    const int tid = tid_, lane = tid & 63, wave = __builtin_amdgcn_readfirstlane(tid >> 6), l15 = lane & 15, l4 = lane >> 4;
    const int hs = wave >> 2, hw = wave & 3, htid = tid & 255;
    LAS char* st = st0 + hs * GH_BYTES;
    const int u = pair * 2 + hs;
    const int bh = u >> 6, n = u & 63, b = bh >> 4, hh = bh & 15;
    const int row_base = b * SEQ + n * 64;
    LAS float* sc = (LAS float*)(st + GH_SC);
    const bf16_t* proj = (const bf16_t*)(p.ws + WS_PROJ);
#define GP_LOAD(raw, w, seg, part, ch0) do { const int colb_ = PC_QKV + (part) * 2048 + hh * 128 + (ch0); \
        const bf16_t* src_ = proj + (size_t)(row_base + (seg) * 8) * PROJ_LD + colb_; \
        _Pragma("unroll") for (int r = 0; r < 11; ++r) { raw[r] = (bf16x8){0, 0, 0, 0, 0, 0, 0, 0}; if (!(n == 0 && (seg) == 0 && r < 3)) raw[r] = *(const bf16x8*)(src_ + (ptrdiff_t)(r - 3) * PROJ_LD); } \
        _Pragma("unroll") for (int j = 0; j < 4; ++j) { const f32x4 a_ = *(const f32x4*)(p.conv_w + j * 6144 + colb_), b_ = *(const f32x4*)(p.conv_w + j * 6144 + colb_ + 4); \
            w[j][0] = a_[0]; w[j][1] = a_[1]; w[j][2] = a_[2]; w[j][3] = a_[3]; w[j][4] = b_[0]; w[j][5] = b_[1]; w[j][6] = b_[2]; w[j][7] = b_[3]; } } while (0)
#define GP_CONV(raw, w, o) do { _Pragma("unroll") for (int t = 0; t < 8; ++t) _Pragma("unroll") for (int c = 0; c < 8; ++c) { float a = 0.f; \
            _Pragma("unroll") for (int j = 0; j < 4; ++j) a += bf2f((unsigned short)raw[t + j][c]) * w[j][c]; o[t][c] = siluf_(a); } } while (0)
    const int seg0 = htid >> 5, part0 = (htid >> 4) & 1, ch00 = (htid & 15) * 8;
    bf16x8 raw0[11]; float w0[4][8];
    GP_LOAD(raw0, w0, seg0, part0, ch00);
    if (hw == 0) {
        const float* ba = (const float*)(p.ws + WS_BA) + (size_t)(row_base + lane) * 32;
        const float braw = ba[hh], araw = ba[16 + hh] + p.dt_bias[hh];
        const float sp = fmaxf(araw, 0.f) + log1pf(__expf(-fabsf(araw)));
        const float g = -__expf(p.a_log[hh]) * sp;
        float c = g;
#pragma unroll
        for (int o = 1; o < 64; o <<= 1) { const float t = __shfl_up(c, o); if (lane >= o) c += t; }
        const float gl = __shfl(c, 63);
        sc[lane] = c; sc[64 + lane] = sigmoidf_(braw); sc[128 + lane] = __expf(c); sc[192 + lane] = __expf(gl - c);
        if (lane == 0) ((float*)(p.ws + WS_GL))[u] = __expf(gl);
    }
    LDS_BAR();
    {
        float o[8][8]; GP_CONV(raw0, w0, o);
        float rinv[8];
#pragma unroll
        for (int t = 0; t < 8; ++t) { float ss = 0.f;
#pragma unroll
            for (int c = 0; c < 8; ++c) ss += o[t][c] * o[t][c];
            ss += __shfl_xor(ss, 1); ss += __shfl_xor(ss, 2); ss += __shfl_xor(ss, 4); ss += __shfl_xor(ss, 8); rinv[t] = rsqrtf(ss + NORM_EPS); }
        if (part0 == 0) { bf16_t* qg = (bf16_t*)(p.ws + WS_QG) + (size_t)u * 8192;
#pragma unroll
            for (int t = 0; t < 8; ++t) { const int tok = seg0 * 8 + t; const float s_ = rinv[t] * 0.08838834764831845f, eg = sc[128 + tok]; float q[8];
#pragma unroll
                for (int c = 0; c < 8; ++c) q[c] = o[t][c] * s_;
                u32x4 x1 = {cvt_pk_bf16(q[0], q[1]), cvt_pk_bf16(q[2], q[3]), cvt_pk_bf16(q[4], q[5]), cvt_pk_bf16(q[6], q[7])};
                *(LAS u32x4*)(st + GH_Q + tok * 272 + ch00 * 2) = x1;
                u32x4 x2 = {cvt_pk_bf16(q[0] * eg, q[1] * eg), cvt_pk_bf16(q[2] * eg, q[3] * eg), cvt_pk_bf16(q[4] * eg, q[5] * eg), cvt_pk_bf16(q[6] * eg, q[7] * eg)};
                *(u32x4*)(qg + tok * 128 + ch00) = x2; }
        } else { bf16_t* kdt = (bf16_t*)(p.ws + WS_KDT) + (size_t)u * 8192; float be[8], ed[8];
#pragma unroll
            for (int t = 0; t < 8; ++t) { const int tok = seg0 * 8 + t; be[t] = sc[64 + tok] * sc[128 + tok]; ed[t] = sc[192 + tok]; }
#pragma unroll
            for (int t = 0; t < 8; ++t) { const int tok = seg0 * 8 + t;
#pragma unroll
                for (int c = 0; c < 8; ++c) o[t][c] *= rinv[t];
                u32x4 x1 = {cvt_pk_bf16(o[t][0], o[t][1]), cvt_pk_bf16(o[t][2], o[t][3]), cvt_pk_bf16(o[t][4], o[t][5]), cvt_pk_bf16(o[t][6], o[t][7])};
                *(LAS u32x4*)(st + GH_K + tok * 272 + ch00 * 2) = x1; }
#pragma unroll
            for (int c = 0; c < 8; ++c) {
                u32x4 x1 = {cvt_pk_bf16(o[0][c] * be[0], o[1][c] * be[1]), cvt_pk_bf16(o[2][c] * be[2], o[3][c] * be[3]), cvt_pk_bf16(o[4][c] * be[4], o[5][c] * be[5]), cvt_pk_bf16(o[6][c] * be[6], o[7][c] * be[7])};
                *(LAS u32x4*)(st + GH_X + (ch00 + c) * 144 + seg0 * 16) = x1;
                u32x4 x2 = {cvt_pk_bf16(o[0][c] * ed[0], o[1][c] * ed[1]), cvt_pk_bf16(o[2][c] * ed[2], o[3][c] * ed[3]), cvt_pk_bf16(o[4][c] * ed[4], o[5][c] * ed[5]), cvt_pk_bf16(o[6][c] * ed[6], o[7][c] * ed[7])};
                *(u32x4*)(kdt + (ch00 + c) * 64 + seg0 * 8) = x2; }
        }
    }
    LDS_BAR();
    {
        bf16_t* qkg = (bf16_t*)(p.ws + WS_QK) + (size_t)u * 4096;
#pragma unroll
        for (int mi = 0; mi < 4; ++mi)
#pragma unroll
            for (int nj = 0; nj < 4; ++nj) {
                if (((mi + nj) & 3) != hw) continue;
                const int i = mi * 16 + l15, j0 = nj * 16 + l4 * 4;
                if (nj > mi) { *(u32x2*)(qkg + i * 64 + j0) = (u32x2){0u, 0u}; continue; }
                f32x4 aK = {0.f, 0.f, 0.f, 0.f}, aQ = {0.f, 0.f, 0.f, 0.f};
#pragma unroll
                for (int ks = 0; ks < 4; ++ks) {
                    const int kb = (ks * 32 + l4 * 8) * 2;
                    const bf16x8 kfj = ld_frag(st + GH_K + (nj * 16 + l15) * 272 + kb), kfi = ld_frag(st + GH_K + (mi * 16 + l15) * 272 + kb), qfi = ld_frag(st + GH_Q + (mi * 16 + l15) * 272 + kb);
                    aK = MFMA16(kfj, kfi, aK); aQ = MFMA16(kfj, qfi, aQ);
                }
                const float gi = sc[i], bi = sc[64 + i]; f32x4 lv; float qv[4];
#pragma unroll
                for (int r = 0; r < 4; ++r) {
                    const int j = j0 + r; const float d = gi - sc[j];
                    const float dec = (i >= j) ? __expf(d) : 0.f;
                    lv[r] = (i > j) ? bi * aK[r] * dec : 0.f; qv[r] = aQ[r] * dec;
                }
                *(LAS f32x4*)(st + GH_L + (i * 68 + j0) * 4) = lv;
                u32x2 w; w[0] = cvt_pk_bf16(qv[0], qv[1]); w[1] = cvt_pk_bf16(qv[2], qv[3]);
                *(u32x2*)(qkg + i * 64 + j0) = w;
            }
    }
    LDS_BAR();
    if (hw == hs) {
        int ln = lane, lz = 0; asm volatile("" : "+v"(ln), "+v"(lz));
        const LAS char* Lb = st + GH_L + (lz & ~15);
        float t[64];
#pragma unroll
        for (int i = 0; i < 64; ++i) t[i] = 0.f;
        t[0] = (ln == 0) ? 1.f : 0.f;
        f32x4 row[2][16];
        row[1][0] = *(const LAS f32x4*)(Lb + 1 * 272);
#pragma unroll
        for (int i = 1; i < 64; ++i) {
            if (i + 1 < 64) {
#pragma unroll
                for (int q = 0; q < (i + 4) / 4; ++q) row[(i + 1) & 1][q] = *(const LAS f32x4*)(Lb + (i + 1) * 272 + q * 16);
            }
            f32x2 s0 = {0.f, 0.f}, s1 = {0.f, 0.f};
#pragma unroll
            for (int q = 0; q < (i + 3) / 4; ++q) {
                const f32x4 l = row[i & 1][q];
                s0 += (f32x2){l[0], l[1]} * (f32x2){t[4 * q], t[4 * q + 1]};
                s1 += (f32x2){l[2], l[3]} * (f32x2){t[4 * q + 2], t[4 * q + 3]};
            }
            t[i] = ((ln == i) ? 1.f : 0.f) - ((s0[0] + s0[1]) + (s1[0] + s1[1]));
        }
        LAS bf16_t* T = (LAS bf16_t*)(st + GH_T);
#pragma unroll
        for (int i = 0; i < 64; ++i) T[i * 72 + lane] = (bf16_t)(cvt_pk_bf16(t[i], 0.f) & 0xffffu);
    } else if (hw >= 2) {
        const int vt = htid - 128, segv = vt >> 4, chv = (vt & 15) * 8;
        bf16x8 rawv[11]; float wv_[4][8];
        GP_LOAD(rawv, wv_, segv, 2, chv);
        float o[8][8]; GP_CONV(rawv, wv_, o);
        float be[8];
#pragma unroll
        for (int t = 0; t < 8; ++t) be[t] = sc[64 + segv * 8 + t];
#pragma unroll
        for (int c = 0; c < 8; ++c) {
            u32x4 x1 = {cvt_pk_bf16(o[0][c] * be[0], o[1][c] * be[1]), cvt_pk_bf16(o[2][c] * be[2], o[3][c] * be[3]), cvt_pk_bf16(o[4][c] * be[4], o[5][c] * be[5]), cvt_pk_bf16(o[6][c] * be[6], o[7][c] * be[7])};
            *(LAS u32x4*)(st + GH_VBT + (chv + c) * 144 + segv * 16) = x1; }
    }
    LDS_BAR();
#undef GP_LOAD
#undef GP_CONV
    {
        bf16x8 tf[4][2];
#pragma unroll
        for (int mi = 0; mi < 4; ++mi)
#pragma unroll
            for (int ks = 0; ks < 2; ++ks) tf[mi][ks] = ld_frag(st + GH_T + (mi * 16 + l15) * 144 + (ks * 32 + l4 * 8) * 2);
        bf16_t* ut = (bf16_t*)(p.ws + WS_UT) + (size_t)u * 8192; bf16_t* nw = (bf16_t*)(p.ws + WS_NEGW) + (size_t)u * 8192;
#pragma unroll
        for (int q = 0; q < 2; ++q) {
            const int nv = hw + 4 * q;
            bf16x8 vf[2], kf[2];
#pragma unroll
            for (int ks = 0; ks < 2; ++ks) { vf[ks] = ld_frag(st + GH_VBT + (nv * 16 + l15) * 144 + (ks * 32 + l4 * 8) * 2); kf[ks] = ld_frag(st + GH_X + (nv * 16 + l15) * 144 + (ks * 32 + l4 * 8) * 2); }
#pragma unroll
            for (int mi = 0; mi < 4; ++mi) {
                f32x4 au = {0.f, 0.f, 0.f, 0.f}, aw = {0.f, 0.f, 0.f, 0.f};
#pragma unroll
                for (int ks = 0; ks < 2; ++ks) { au = MFMA16(tf[mi][ks], vf[ks], au); aw = MFMA16(kf[ks], tf[mi][ks], aw); }
                u32x2 w; w[0] = cvt_pk_bf16(au[0], au[1]); w[1] = cvt_pk_bf16(au[2], au[3]);
                *(u32x2*)(ut + (nv * 16 + l15) * 64 + mi * 16 + l4 * 4) = w;
                u32x2 w2; w2[0] = cvt_pk_bf16(-aw[0], -aw[1]); w2[1] = cvt_pk_bf16(-aw[2], -aw[3]);
                *(u32x2*)(nw + (mi * 16 + l15) * 128 + nv * 16 + l4 * 4) = w2;
            }
        }
    }
    LDS_BAR();
}

__constant__ double c_invf[16] = {1.0, 0.44036660267178046, 0.19392274474868576, 0.08539710028576561, 0.03760603093086393, 0.016560440080994446, 0.007292664737217109,
    0.003211445994752591, 0.001414213562373095, 0.000622772421914596, 0.0002742481756762073, 0.00012076973741146504, 5.318295896944988e-05, 2.341999896140934e-05,
    1.031338537721246e-05, 4.5416704806078695e-06};

DI void p2_qknorm(const Params& p) {
    const int tid = threadIdx.x, lane = tid & 63, wave = tid >> 6, sub = lane & 15, grp = lane >> 4;
    const bf16_t* proj = (const bf16_t*)(p.ws + WS_PROJ);
    bf16_t* qn = (bf16_t*)(p.ws + WS_QN); bf16_t* kn = (bf16_t*)(p.ws + WS_KN);
    float gq[8], gk[8];
#pragma unroll
    for (int e = 0; e < 8; ++e) { gq[e] = p.q_norm_g[sub * 8 + e]; gk[e] = p.k_norm_g[sub * 8 + e]; }
    for (int tok = blockIdx.x * 8 + wave; tok < NTOK; tok += gridDim.x * 8) {
        const int pos = p.positions[tok];
        const double ad = (double)pos * c_invf[sub];
        const double kk = rint(ad * 0.15915494309189535);
        const float r = (float)(ad - kk * 6.283185307179586);
        const float cs = __cosf(r), sn = __sinf(r);
#pragma unroll
        for (int it = 0; it < 8; ++it) {
            const int v = it * 4 + grp; const bool isq = v < 16;
            const bf16x8 raw = *(const bf16x8*)(proj + (size_t)tok * PROJ_LD + (isq ? PC_QB + v * 128 : PC_KB + (v - 16) * 128) + sub * 8);
            float x[8]; float ss = 0.f;
#pragma unroll
            for (int e = 0; e < 8; ++e) { x[e] = bf2f((unsigned short)raw[e]); ss += x[e] * x[e]; }
            ss += __shfl_xor(ss, 1); ss += __shfl_xor(ss, 2); ss += __shfl_xor(ss, 4); ss += __shfl_xor(ss, 8);
            const float rs = rsqrtf(ss * (1.f / 128.f) + NORM_EPS);
#pragma unroll
            for (int e = 0; e < 8; ++e) x[e] = x[e] * rs * (isq ? gq[e] : gk[e]);
            float y[8];
#pragma unroll
            for (int e = 0; e < 8; ++e) {
                const float py = __shfl_xor(x[e], 2);
                const int src = (lane & 48) | (8 * (sub & 1) + e);
                const float c = __shfl(cs, src), s = __shfl(sn, src);
                y[e] = sub < 2 ? x[e] * c - py * s : (sub < 4 ? x[e] * c + py * s : x[e]);
            }
            u32x4 w = {cvt_pk_bf16(y[0], y[1]), cvt_pk_bf16(y[2], y[3]), cvt_pk_bf16(y[4], y[5]), cvt_pk_bf16(y[6], y[7])};
            *(u32x4*)((isq ? qn : kn) + (size_t)tok * DM + (v & 15) * 128 + sub * 8) = w;
        }
    }
}

constexpr int SC_NEGW = 0, SC_QG = 17408, SC_KDT = 34816, SC_QK = 53248, SC_BUF = 62464, SC_OBUF = 2 * SC_BUF;
DI bf16x8 ld_frag2(const LAS char* p) { const s16x4 lo = *(const LAS s16x4*)p, hi = *(const LAS s16x4*)(p + 32); return __builtin_shufflevector(lo, hi, 0, 1, 2, 3, 4, 5, 6, 7); }
DI bf16x8 pack2(const f32x4& a, const f32x4& b) { u32x4 w = {cvt_pk_bf16(a[0], a[1]), cvt_pk_bf16(a[2], a[3]), cvt_pk_bf16(b[0], b[1]), cvt_pk_bf16(b[2], b[3])}; return __builtin_bit_cast(bf16x8, w); }

DI void gdn_scan_unit(const Params& p, LAS char* st, int bh) {
    int tid_ = threadIdx.x; asm volatile("" : "+v"(tid_));
    const int tid = tid_, lane = tid & 63, wave = tid >> 6, l15 = lane & 15, l4 = lane >> 4;
    const int b = bh >> 4, hh = bh & 15;
    const bf16_t* g_negw = (const bf16_t*)(p.ws + WS_NEGW) + (size_t)bh * 64 * 8192;
    const bf16_t* g_qg = (const bf16_t*)(p.ws + WS_QG) + (size_t)bh * 64 * 8192;
    const bf16_t* g_kdt = (const bf16_t*)(p.ws + WS_KDT) + (size_t)bh * 64 * 8192;
    const bf16_t* g_ut = (const bf16_t*)(p.ws + WS_UT) + (size_t)bh * 64 * 8192;
    const bf16_t* g_qk = (const bf16_t*)(p.ws + WS_QK) + (size_t)bh * 64 * 4096;
    const float* g_gl = (const float*)(p.ws + WS_GL) + bh * 64;
    const bf16_t* proj = (const bf16_t*)(p.ws + WS_PROJ);
    bf16_t* oa = (bf16_t*)(p.ws + WS_OA);
    u32x4 sg[7]; u32x2 ur[4], urn[4];
#define SC_LOAD(n_) do { \
        sg[0] = *(const u32x4*)(g_negw + (size_t)(n_) * 8192 + tid * 8); sg[1] = *(const u32x4*)(g_negw + (size_t)(n_) * 8192 + (tid + 512) * 8); \
        sg[2] = *(const u32x4*)(g_qg + (size_t)(n_) * 8192 + tid * 8);   sg[3] = *(const u32x4*)(g_qg + (size_t)(n_) * 8192 + (tid + 512) * 8); \
        sg[4] = *(const u32x4*)(g_kdt + (size_t)(n_) * 8192 + tid * 8);  sg[5] = *(const u32x4*)(g_kdt + (size_t)(n_) * 8192 + (tid + 512) * 8); \
        sg[6] = *(const u32x4*)(g_qk + (size_t)(n_) * 4096 + tid * 8); \
        _Pragma("unroll") for (int mt = 0; mt < 4; ++mt) urn[mt] = *(const u32x2*)(g_ut + (size_t)(n_) * 8192 + (wave * 16 + l15) * 64 + mt * 16 + l4 * 4); } while (0)
#define SC_WRITE(bsel) do { LAS char* bb = st + (bsel) * SC_BUF; \
        *(LAS u32x4*)(bb + SC_NEGW + (tid >> 4) * 272 + (tid & 15) * 16) = sg[0]; *(LAS u32x4*)(bb + SC_NEGW + ((tid + 512) >> 4) * 272 + (tid & 15) * 16) = sg[1]; \
        *(LAS u32x4*)(bb + SC_QG + (tid >> 4) * 272 + (tid & 15) * 16) = sg[2];   *(LAS u32x4*)(bb + SC_QG + ((tid + 512) >> 4) * 272 + (tid & 15) * 16) = sg[3]; \
        *(LAS u32x4*)(bb + SC_KDT + (tid >> 3) * 144 + (tid & 7) * 16) = sg[4];   *(LAS u32x4*)(bb + SC_KDT + ((tid + 512) >> 3) * 144 + (tid & 7) * 16) = sg[5]; \
        *(LAS u32x4*)(bb + SC_QK + (tid >> 3) * 144 + (tid & 7) * 16) = sg[6]; } while (0)
    f32x4 S[8];
#pragma unroll
    for (int t = 0; t < 8; ++t) S[t] = (f32x4){0.f, 0.f, 0.f, 0.f};
    const int etok = tid >> 3, edv = (tid & 7) * 16;
    float gn[16];
#pragma unroll
    for (int e = 0; e < 16; ++e) gn[e] = p.gdn_norm_g[edv + e];
    SC_LOAD(0); SC_WRITE(0);
#pragma unroll
    for (int mt = 0; mt < 4; ++mt) ur[mt] = urn[mt];
    __syncthreads();
    for (int n = 0; n < 64; ++n) {
        LAS char* bb = st + (n & 1) * SC_BUF;
        if (n + 1 < 64) SC_LOAD(n + 1);
        const size_t zrow = (size_t)(b * SEQ + n * 64 + etok);
        const u32x4 z0 = *(const u32x4*)(proj + zrow * PROJ_LD + PC_Z + hh * 128 + edv), z1 = *(const u32x4*)(proj + zrow * PROJ_LD + PC_Z + hh * 128 + edv + 8);
        const float gl = g_gl[n];
        bf16x8 sb[4];
#pragma unroll
        for (int s = 0; s < 4; ++s) sb[s] = pack2(S[2 * s], S[2 * s + 1]);
        f32x4 vn[4], o[4];
#pragma unroll
        for (int mt = 0; mt < 4; ++mt) {
            vn[mt] = (f32x4){bflo(ur[mt][0]), bfhi(ur[mt][0]), bflo(ur[mt][1]), bfhi(ur[mt][1])};
            o[mt] = (f32x4){0.f, 0.f, 0.f, 0.f};
#pragma unroll
            for (int s = 0; s < 4; ++s) {
                vn[mt] = MFMA16(ld_frag2(bb + SC_NEGW + (mt * 16 + l15) * 272 + (s * 32 + l4 * 4) * 2), sb[s], vn[mt]);
                o[mt] = MFMA16(ld_frag2(bb + SC_QG + (mt * 16 + l15) * 272 + (s * 32 + l4 * 4) * 2), sb[s], o[mt]);
            }
        }
        bf16x8 vb[2];
        vb[0] = pack2(vn[0], vn[1]); vb[1] = pack2(vn[2], vn[3]);
#pragma unroll
        for (int mt = 0; mt < 4; ++mt)
#pragma unroll
            for (int s = 0; s < 2; ++s) o[mt] = MFMA16(ld_frag2(bb + SC_QK + (mt * 16 + l15) * 144 + (s * 32 + l4 * 4) * 2), vb[s], o[mt]);
#pragma unroll
        for (int t = 0; t < 8; ++t) {
            S[t] *= gl;
#pragma unroll
            for (int s = 0; s < 2; ++s) S[t] = MFMA16(ld_frag2(bb + SC_KDT + (t * 16 + l15) * 144 + (s * 32 + l4 * 4) * 2), vb[s], S[t]);
        }
        LAS float* ob = (LAS float*)(st + SC_OBUF);
#pragma unroll
        for (int mt = 0; mt < 4; ++mt)
#pragma unroll
            for (int r = 0; r < 4; ++r) ob[(mt * 16 + l4 * 4 + r) * 132 + wave * 16 + l15] = o[mt][r];
        if (n + 1 < 64) { SC_WRITE((n + 1) & 1);
#pragma unroll
            for (int mt = 0; mt < 4; ++mt) ur[mt] = urn[mt]; }
        LDS_BAR();
        {
            float v[16]; float ss = 0.f;
#pragma unroll
            for (int q = 0; q < 4; ++q) { const f32x4 t4 = *(const LAS f32x4*)(ob + etok * 132 + edv + q * 4); v[q * 4] = t4[0]; v[q * 4 + 1] = t4[1]; v[q * 4 + 2] = t4[2]; v[q * 4 + 3] = t4[3]; }
#pragma unroll
            for (int e = 0; e < 16; ++e) ss += v[e] * v[e];
            ss += __shfl_xor(ss, 1); ss += __shfl_xor(ss, 2); ss += __shfl_xor(ss, 4);
            const float rs = rsqrtf(ss * (1.f / 128.f) + NORM_EPS);
            const unsigned zz[8] = {z0[0], z0[1], z0[2], z0[3], z1[0], z1[1], z1[2], z1[3]};
            u32x4 w0, w1;
#pragma unroll
            for (int q = 0; q < 4; ++q) {
                w0[q] = cvt_pk_bf16(v[2 * q] * rs * gn[2 * q] * bflo(zz[q]), v[2 * q + 1] * rs * gn[2 * q + 1] * bfhi(zz[q]));
                w1[q] = cvt_pk_bf16(v[8 + 2 * q] * rs * gn[8 + 2 * q] * bflo(zz[4 + q]), v[9 + 2 * q] * rs * gn[9 + 2 * q] * bfhi(zz[4 + q]));
            }
            bf16_t* dst = oa + zrow * DM + hh * 128 + edv;
            *(u32x4*)dst = w0; *(u32x4*)(dst + 8) = w1;
        }
        LDS_BAR();
    }
#undef SC_LOAD
#undef SC_WRITE
}

constexpr int AT_K1 = 0, AT_K2 = 16384, AT_V = 32768, AT_BUF = 65536, AT_SCR = 2 * AT_BUF;
constexpr float AT_SCALE = 0.088388347648318440f, AT_THR = 8.f;
#define KSWZ(row, colB) ((row) * 256 + ((colB) ^ (((row) & 7) << 4)))
DI int crow(int r, int hi) { return (r & 3) + 8 * (r >> 2) + 4 * hi; }
DI int v_rd_base(int lane) { return ((lane & 3) << 3) | (((lane >> 2) & 3) << 6) | (((lane >> 4) & 1) << 5) | (((lane >> 5) & 1) << 8); }
constexpr int v_rd_off(int d0, int ks, int half) { return d0 * 512 + ks * 8192 + half * 4096; }
template <int OFF> DI s16x4 tr_read(int vb) { s16x4 r; asm volatile("ds_read_b64_tr_b16 %0, %1 offset:%2" : "=&v"(r) : "v"(vb), "i"(OFF) : "memory"); return r; }
template <int D0, int HH> DI void pv_half(f32x16& od, int vb, bf16x8 pa, bf16x8 pb) {
    const s16x4 l0 = tr_read<v_rd_off(D0, 2 * HH, 0)>(vb), h0 = tr_read<v_rd_off(D0, 2 * HH, 1)>(vb), l1 = tr_read<v_rd_off(D0, 2 * HH + 1, 0)>(vb), h1 = tr_read<v_rd_off(D0, 2 * HH + 1, 1)>(vb);
    asm volatile("s_waitcnt lgkmcnt(0)" ::: "memory"); SCHED();
#define PK(L, H) (bf16x8){L[0], L[1], L[2], L[3], H[0], H[1], H[2], H[3]}
    od = MFMA32(pa, PK(l0, h0), od); od = MFMA32(pb, PK(l1, h1), od);
#undef PK
}

struct VFrag { s16x4 l0, h0, l1, h1, l2, h2, l3, h3; };
template <int D0> DI void pv_load(VFrag& f, int vb) {
    f.l0 = tr_read<v_rd_off(D0, 0, 0)>(vb); f.h0 = tr_read<v_rd_off(D0, 0, 1)>(vb); f.l1 = tr_read<v_rd_off(D0, 1, 0)>(vb); f.h1 = tr_read<v_rd_off(D0, 1, 1)>(vb);
    f.l2 = tr_read<v_rd_off(D0, 2, 0)>(vb); f.h2 = tr_read<v_rd_off(D0, 2, 1)>(vb); f.l3 = tr_read<v_rd_off(D0, 3, 0)>(vb); f.h3 = tr_read<v_rd_off(D0, 3, 1)>(vb);
}
DI void pv_mma(f32x16& od, const VFrag& f, bf16x8 pa0, bf16x8 pa1, bf16x8 pa2, bf16x8 pa3) {
#define PK(L, H) (bf16x8){L[0], L[1], L[2], L[3], H[0], H[1], H[2], H[3]}
    od = MFMA32(pa0, PK(f.l0, f.h0), od); od = MFMA32(pa1, PK(f.l1, f.h1), od); od = MFMA32(pa2, PK(f.l2, f.h2), od); od = MFMA32(pa3, PK(f.l3, f.h3), od);
#undef PK
}
struct VFragH { s16x4 l0, h0, l1, h1; };
template <int D0, int HH> DI void pvh_load(VFragH& f, int vb) {
    f.l0 = tr_read<v_rd_off(D0, 2 * HH, 0)>(vb); f.h0 = tr_read<v_rd_off(D0, 2 * HH, 1)>(vb); f.l1 = tr_read<v_rd_off(D0, 2 * HH + 1, 0)>(vb); f.h1 = tr_read<v_rd_off(D0, 2 * HH + 1, 1)>(vb);
}
DI void pvh_mma(f32x16& od, const VFragH& f, bf16x8 pa, bf16x8 pb) {
#define PK(L, H) (bf16x8){L[0], L[1], L[2], L[3], H[0], H[1], H[2], H[3]}
    od = MFMA32(pa, PK(f.l0, f.h0), od); od = MFMA32(pb, PK(f.l1, f.h1), od);
#undef PK
}
#define PV_STEP(D, FCUR, FNXT) do { pv_load<(D) + 1>(FNXT, vb); asm volatile("s_waitcnt lgkmcnt(8)" ::: "memory"); SCHED(); pv_mma(o[D], FCUR, pa0, pa1, pa2, pa3); } while (0)

DI void attn_unit(const Params& p, LAS char* st, int b, int h, int t, float lam) {
    int tid_ = threadIdx.x; asm volatile("" : "+v"(tid_));
    const int tid = tid_, wid = tid >> 6, lane = tid & 63, r32 = lane & 31, hi = lane >> 5;
    const int comp = wid >> 2, wq = wid & 3;
    const bf16_t* qn = (const bf16_t*)(p.ws + WS_QN); const bf16_t* kn = (const bf16_t*)(p.ws + WS_KN); const bf16_t* proj = (const bf16_t*)(p.ws + WS_PROJ);
    LAS float* scr = (LAS float*)(st + AT_SCR) + wid * 64;
    const int NT = 2 * t + 2;
    const int wv = __builtin_amdgcn_readfirstlane(tid >> 6);
    unsigned ksrc, vsrc;
    { const int row = tid >> 4, colB = ((tid & 15) << 4) ^ ((row & 7) << 4); ksrc = ((unsigned)row * DM + h * 256) * 2u + colB; }
    { const int sub = tid >> 5, kk = (sub >> 3) * 8 + ((tid & 31) >> 2), key = (kk & ~0xC) | ((kk & 4) << 1) | ((kk & 8) >> 1), col = (sub & 7) * 32 + ((tid & 3) << 3);
      vsrc = ((unsigned)key * DM + h * 256 + col) * 2u; }
    const __amdgpu_buffer_rsrc_t rsK = __builtin_amdgcn_make_buffer_rsrc((void*)(kn + (size_t)(b * SEQ) * DM), 0, 0x7fffffff, 0x00020000);
    const __amdgpu_buffer_rsrc_t rsV = __builtin_amdgcn_make_buffer_rsrc((void*)((const bf16_t*)(p.ws + WS_VBUF) + (size_t)(b * SEQ) * DM), 0, 0x7fffffff, 0x00020000);
#define AT_DMA(kt, bsel) do { LAS char* bb_ = st + (bsel) * AT_BUF + wv * 1024; \
        _Pragma("unroll") for (int i_ = 0; i_ < 2; ++i_) { const int so_ = ((kt) * 64 + 32 * i_) * DM * 2; \
            __builtin_amdgcn_raw_ptr_buffer_load_lds(rsK, (LAS unsigned*)(bb_ + AT_K1 + 8192 * i_), 16, ksrc, so_, 0, 0); \
            __builtin_amdgcn_raw_ptr_buffer_load_lds(rsK, (LAS unsigned*)(bb_ + AT_K2 + 8192 * i_), 16, ksrc, so_ + 256, 0, 0); } \
        _Pragma("unroll") for (int i_ = 0; i_ < 4; ++i_) \
            __builtin_amdgcn_raw_ptr_buffer_load_lds(rsV, (LAS unsigned*)(bb_ + AT_V + 8192 * i_), 16, vsrc, ((kt) * 64 + 16 * i_) * DM * 2, 0, 0); } while (0)
    bf16x8 qr[8];
    { const bf16_t* qw = qn + (size_t)(b * SEQ + t * 128 + wq * 32 + r32) * DM + h * 256 + comp * 128 + hi * 8;
#pragma unroll
      for (int d0 = 0; d0 < 8; ++d0) qr[d0] = *(const bf16x8*)(qw + d0 * 16); }
    f32x16 o[8];
#pragma unroll
    for (int d = 0; d < 8; ++d)
#pragma unroll
        for (int r = 0; r < 16; ++r) o[d][r] = 0.f;
    float m_reg = -1e30f, l_reg = 0.f;
    constexpr float C = AT_SCALE * 1.4426950408889634f;
    AT_DMA(0, 0);
    for (int j = 0; j < NT; ++j) {
        WAIT_V(0); WAIT_L(0); BAR();
        if (j + 1 < NT) AT_DMA(j + 1, (j + 1) & 1);
        if (j == NT - 1 && wq < 2) continue;
        const LAS char* bb = st + (j & 1) * AT_BUF; const LAS char* Ks = bb + (comp ? AT_K2 : AT_K1);
        f32x16 p0, p1;
#pragma unroll
        for (int r = 0; r < 16; ++r) { p0[r] = 0.f; p1[r] = 0.f; }
        const int vb = (int)(uintptr_t)(bb + AT_V) + v_rd_base(lane);
#define KF(i) (*(const LAS bf16x8*)(Ks + KSWZ(32 * ((i) >> 3) + r32, (((i) & 7) * 16 + hi * 8) * 2)))
#define QK_STEP(i, F) do { if ((i) < 8) p0 = MFMA32(F, qr[(i) & 7], p0); else p1 = MFMA32(F, qr[(i) & 7], p1); if ((i) + 3 < 16) F = KF((i) + 3); } while (0)
        bf16x8 kf0 = KF(0), kf1 = KF(1), kf2 = KF(2);
        QK_STEP(0, kf0); SCHED(); QK_STEP(1, kf1); SCHED(); QK_STEP(2, kf2); SCHED(); QK_STEP(3, kf0); SCHED();
        QK_STEP(4, kf1); SCHED(); QK_STEP(5, kf2); SCHED(); QK_STEP(6, kf0); SCHED(); QK_STEP(7, kf1); SCHED();
        __builtin_amdgcn_s_setprio(0);
        bf16x8 pa0, pa1, pa2, pa3;
#define PK4(P, BASE, OUT) do { unsigned a0 = cvt_pk_bf16(P[BASE + 0], P[BASE + 1]), a1 = cvt_pk_bf16(P[BASE + 2], P[BASE + 3]); \
        unsigned b0_ = cvt_pk_bf16(P[BASE + 4], P[BASE + 5]), b1_ = cvt_pk_bf16(P[BASE + 6], P[BASE + 7]); \
        auto r0 = __builtin_amdgcn_permlane32_swap(a0, b0_, false, false); auto r1 = __builtin_amdgcn_permlane32_swap(a1, b1_, false, false); \
        u32x4 w = {r0[0], r1[0], r0[1], r1[1]}; OUT = __builtin_bit_cast(bf16x8, w); } while (0)
#define SM_HEAD(P, EX, ALPHA, MNC) \
        float pm_ = P[0]; _Pragma("unroll") for (int r = 1; r < 16; ++r) pm_ = fmaxf(pm_, P[r]); \
        { auto rr = __builtin_amdgcn_permlane32_swap(__float_as_uint(pm_), __float_as_uint(pm_), false, false); pm_ = fmaxf(__uint_as_float(rr[0]), __uint_as_float(rr[1])); } \
        const bool EX = !__all(pm_ - m_reg <= AT_THR / AT_SCALE); \
        const float mn_ = EX ? fmaxf(m_reg, pm_) : m_reg; const float ALPHA = EX ? __builtin_amdgcn_exp2f((m_reg - mn_) * C) : 1.f; m_reg = mn_; const float MNC = -mn_ * C;
#define SM_PAIR(P, c, MNC, PS) do { P[2 * (c)] = __builtin_amdgcn_exp2f(fmaf(P[2 * (c)], C, MNC)); P[2 * (c) + 1] = __builtin_amdgcn_exp2f(fmaf(P[2 * (c) + 1], C, MNC)); PS += P[2 * (c)] + P[2 * (c) + 1]; } while (0)
#define SM_RESCALE(ALPHA) do { if (hi == 0) scr[r32] = ALPHA; WAIT_L(0); \
        _Pragma("unroll") for (int r = 0; r < 16; ++r) { const float a_ = scr[crow(r, hi)]; _Pragma("unroll") for (int d = 0; d < 8; ++d) o[d][r] *= a_; } } while (0)
        float ps0 = 0.f;
        QK_STEP(8, kf2); SCHED(); QK_STEP(9, kf0); SCHED();
        bool ex0; float alpha0, mnC0;
        { SM_HEAD(p0, ex0_, alpha0_, mnC0_); ex0 = ex0_; alpha0 = alpha0_; mnC0 = mnC0_; }
        SCHED();
        QK_STEP(10, kf1); SM_PAIR(p0, 0, mnC0, ps0); SM_PAIR(p0, 1, mnC0, ps0); SCHED();
        QK_STEP(11, kf2); SM_PAIR(p0, 2, mnC0, ps0); SM_PAIR(p0, 3, mnC0, ps0); SCHED();
        QK_STEP(12, kf0); SM_PAIR(p0, 4, mnC0, ps0); PK4(p0, 0, pa0); SCHED();
        QK_STEP(13, kf1); SM_PAIR(p0, 5, mnC0, ps0); SM_PAIR(p0, 6, mnC0, ps0); SCHED();
        QK_STEP(14, kf2); SM_PAIR(p0, 7, mnC0, ps0); SCHED();
        QK_STEP(15, kf0); PK4(p0, 8, pa1); SCHED();
#undef KF
#undef QK_STEP
        { auto rr = __builtin_amdgcn_permlane32_swap(__float_as_uint(ps0), __float_as_uint(ps0), false, false); ps0 = __uint_as_float(rr[0]) + __uint_as_float(rr[1]); }
        l_reg = l_reg * alpha0 + ps0;
        __builtin_amdgcn_s_setprio(0);
        if (ex0) SM_RESCALE(alpha0);
        float ps1 = 0.f; bool ex1; float alpha1, mnC1;
        { SM_HEAD(p1, ex1_, alpha1_, mnC1_); ex1 = ex1_; alpha1 = alpha1_; mnC1 = mnC1_; }
        VFragH fa, fb;
        WAIT_L(0); pvh_load<0, 0>(fa, vb);
#define PVH_STEP(HH, D, FCUR, FNXT, PA, PB, ...) do { pvh_load<(D) + 1, HH>(FNXT, vb); asm volatile("s_waitcnt lgkmcnt(4)" ::: "memory"); SCHED(); pvh_mma(o[D], FCUR, PA, PB); __VA_ARGS__; SCHED(); } while (0)
        PVH_STEP(0, 0, fa, fb, pa0, pa1, SM_PAIR(p1, 0, mnC1, ps1)); PVH_STEP(0, 1, fb, fa, pa0, pa1, SM_PAIR(p1, 1, mnC1, ps1));
        PVH_STEP(0, 2, fa, fb, pa0, pa1, SM_PAIR(p1, 2, mnC1, ps1)); PVH_STEP(0, 3, fb, fa, pa0, pa1, SM_PAIR(p1, 3, mnC1, ps1); PK4(p1, 0, pa2));
        PVH_STEP(0, 4, fa, fb, pa0, pa1, SM_PAIR(p1, 4, mnC1, ps1)); PVH_STEP(0, 5, fb, fa, pa0, pa1, SM_PAIR(p1, 5, mnC1, ps1));
        PVH_STEP(0, 6, fa, fb, pa0, pa1, SM_PAIR(p1, 6, mnC1, ps1));
        asm volatile("s_waitcnt lgkmcnt(0)" ::: "memory"); SCHED(); pvh_mma(o[7], fb, pa0, pa1); SM_PAIR(p1, 7, mnC1, ps1); PK4(p1, 8, pa3); SCHED();
        { auto rr = __builtin_amdgcn_permlane32_swap(__float_as_uint(ps1), __float_as_uint(ps1), false, false); ps1 = __uint_as_float(rr[0]) + __uint_as_float(rr[1]); }
        l_reg = l_reg * alpha1 + ps1;
        __builtin_amdgcn_s_setprio(0);
        if (ex1) SM_RESCALE(alpha1);
        __builtin_amdgcn_s_setprio(1);
        WAIT_L(0); pvh_load<0, 1>(fa, vb);
        PVH_STEP(1, 0, fa, fb, pa2, pa3, (void)0); PVH_STEP(1, 1, fb, fa, pa2, pa3, (void)0); PVH_STEP(1, 2, fa, fb, pa2, pa3, (void)0); PVH_STEP(1, 3, fb, fa, pa2, pa3, (void)0);
        PVH_STEP(1, 4, fa, fb, pa2, pa3, (void)0); PVH_STEP(1, 5, fb, fa, pa2, pa3, (void)0); PVH_STEP(1, 6, fa, fb, pa2, pa3, (void)0);
        asm volatile("s_waitcnt lgkmcnt(0)" ::: "memory"); SCHED(); pvh_mma(o[7], fb, pa2, pa3);
        __builtin_amdgcn_s_setprio(0);
#undef PK4
#undef SM_HEAD
#undef SM_PAIR
#undef SM_RESCALE
#undef PVH_STEP
    }
    WAIT_L(0);
    if (hi == 0) scr[32 + r32] = l_reg;
    WAIT_L(0);
    float rli[16];
#pragma unroll
    for (int r = 0; r < 16; ++r) rli[r] = __builtin_amdgcn_rcpf(scr[32 + crow(r, hi)]);
    __syncthreads();
    LAS float* xch = (LAS float*)st;
    if (comp == 1) {
#pragma unroll
        for (int r = 0; r < 16; ++r) { const float s = rli[r] * lam;
#pragma unroll
            for (int d = 0; d < 8; ++d) xch[(wq * 32 + crow(r, hi)) * 256 + d * 32 + r32] = o[d][r] * s; }
    }
    __syncthreads();
    if (comp == 0) {
        bf16_t* ob = (bf16_t*)(p.ws + WS_OB);
        float sg[8];
#pragma unroll
        for (int d = 0; d < 8; ++d) sg[d] = p.subln_g[d * 32 + r32] * 0.8f;
#pragma unroll
        for (int r = 0; r < 16; ++r) {
            float ss = 0.f;
#pragma unroll
            for (int d = 0; d < 8; ++d) { const float v = o[d][r] * rli[r] - xch[(wq * 32 + crow(r, hi)) * 256 + d * 32 + r32]; o[d][r] = v; ss += v * v; }
            ss += __shfl_xor(ss, 1); ss += __shfl_xor(ss, 2); ss += __shfl_xor(ss, 4); ss += __shfl_xor(ss, 8); ss += __shfl_xor(ss, 16);
            const float rs = rsqrtf(ss * (1.f / 256.f) + NORM_EPS);
            bf16_t* dst = ob + (size_t)(b * SEQ + t * 128 + wq * 32 + crow(r, hi)) * DM + h * 256 + r32;
#pragma unroll
            for (int d = 0; d < 8; ++d) dst[d * 32] = (bf16_t)(cvt_pk_bf16(o[d][r] * rs * sg[d], 0.f) & 0xffffu);
            asm volatile("" ::: "memory");
        }
    }
    __syncthreads();
#undef AT_DMA
}

DI void p3_mixers(const Params& p, LAS char* lds, int rep) {
    const int tid = threadIdx.x;
    LAS char* st = lds + LDS_MISC;
    volatile LAS int* bc = (volatile LAS int*)(lds + 16);
    if (tid < 64) {
        float a = p.lq1[tid] * p.lk1[tid] + p.lq1[tid + 64] * p.lk1[tid + 64], c = p.lq2[tid] * p.lk2[tid] + p.lq2[tid + 64] * p.lk2[tid + 64];
#pragma unroll
        for (int o = 32; o >= 1; o >>= 1) { a += __shfl_xor(a, o); c += __shfl_xor(c, o); }
        if (tid == 0) ((volatile LAS float*)bc)[1] = __expf(a) - __expf(c) + 0.2f;
    }
    __syncthreads();
    const float lam = ((volatile LAS float*)bc)[1];
    unsigned* queue = (unsigned*)(p.ws + WS_CTL) + CW_QUEUE + 1024 * rep;
#define PULL(item_) do { if (tid == 0) bc[0] = (int)__hip_atomic_fetch_add(queue, 1u, __ATOMIC_RELAXED, __HIP_MEMORY_SCOPE_AGENT); __syncthreads(); item_ = bc[0]; __syncthreads(); } while (0)
    const int xq = blockIdx.x & 7;
    unsigned* queueA = queue + 64 * (1 + xq); unsigned* queueB = queue + 32;
#define PULLA(item_) do { if (tid == 0) bc[0] = (int)__hip_atomic_fetch_add(queueA, 1u, __ATOMIC_RELAXED, __HIP_MEMORY_SCOPE_AGENT); __syncthreads(); item_ = bc[0]; __syncthreads(); } while (0)
#define PULLB(item_) do { if (tid == 0) bc[0] = (int)__hip_atomic_fetch_add(queueB, 1u, __ATOMIC_RELAXED, __HIP_MEMORY_SCOPE_AGENT); __syncthreads(); item_ = bc[0]; __syncthreads(); } while (0)
    int item;
#ifndef MK_NO_CONV
    if (((blockIdx.x >> 3) & 7) < 4) { PULLB(item); while (item < 768) { cvt_tiles<32>(p, lds, 3072 + item * 32, 1); PULLB(item); } }
#endif
    PULLA(item);
#ifndef MK_NO_SCAN
    while (item < 8) { gdn_scan_unit(p, st, xq * 8 + item); PULLA(item); }
#endif
#ifndef MK_NO_ATTN
    while (item < 8 + 128) { const int idx = item - 8, bhh = xq * 4 + (idx >> 5), t = 31 - (idx & 31); attn_unit(p, st, bhh >> 3, bhh & 7, t, lam); PULLA(item); }
#endif
#ifndef MK_NO_CONV
    PULLB(item); while (item < 768) { cvt_tiles<32>(p, lds, 3072 + item * 32, 1); PULLB(item); }
#endif
#undef PULLA
#undef PULLB
#undef PULL
}

DI void p6_router(const Params& p, LAS char* lds) {
    const int tid = threadIdx.x, lane = tid & 63, wave = tid >> 6, l15 = lane & 15, l4 = lane >> 4;
    LAS char* st = lds + LDS_MISC;
    LAS float* lg = (LAS float*)st;
    LAS float* rsd = (LAS float*)(st + 8448);
    LAS int* sel = (LAS int*)(st + 8704);
    LAS float* selw = (LAS float*)(st + 9728);
    LAS int* lcnt = (LAS int*)(st + 10752);
    const bf16_t* rhi = (const bf16_t*)(p.ws + WS_WS) + 32 * 2048; const bf16_t* rlo = rhi + 32 * 2048;
    unsigned char* h2 = p.ws + WS_H;
    unsigned* cnt = (unsigned*)(p.ws + WS_CTL) + CW_CNT;
    int* list = (int*)(p.ws + WS_LIST); float* wlist = (float*)(p.ws + WS_WLIST); int* tinfo = (int*)(p.ws + WS_TINFO);
    for (int grp = blockIdx.x; grp < NTOK / 64; grp += gridDim.x) {
        const int tok0 = grp * 64;
        if (tid < 64) lcnt[tid] = 0;
        if (wave < 4) {
            const float* xr = p.out + (size_t)(tok0 + wave * 16 + l15) * DM + l4 * 8;
            const bf16_t* bh0 = rhi + (size_t)l15 * DM + l4 * 8; const bf16_t* bl0 = rlo + (size_t)l15 * DM + l4 * 8;
            f32x4 a0 = {0.f, 0.f, 0.f, 0.f}, a1 = {0.f, 0.f, 0.f, 0.f}; float ss = 0.f;
#pragma unroll 4
            for (int k0 = 0; k0 < DM; k0 += 32) {
                const f32x4 xa = *(const f32x4*)(xr + k0), xb = *(const f32x4*)(xr + k0 + 4);
                const f32x4 ga = *(const f32x4*)(p.norm2_g + k0 + l4 * 8), gb = *(const f32x4*)(p.norm2_g + k0 + l4 * 8 + 4);
                float a[8] = {xa[0] * ga[0], xa[1] * ga[1], xa[2] * ga[2], xa[3] * ga[3], xb[0] * gb[0], xb[1] * gb[1], xb[2] * gb[2], xb[3] * gb[3]};
                ss += xa[0] * xa[0] + xa[1] * xa[1] + xa[2] * xa[2] + xa[3] * xa[3] + xb[0] * xb[0] + xb[1] * xb[1] + xb[2] * xb[2] + xb[3] * xb[3];
                u32x4 hw, lw;
#pragma unroll
                for (int q = 0; q < 4; ++q) { hw[q] = cvt_pk_bf16(a[2 * q], a[2 * q + 1]); lw[q] = cvt_pk_bf16(a[2 * q] - bflo(hw[q]), a[2 * q + 1] - bfhi(hw[q])); }
                const bf16x8 ah = __builtin_bit_cast(bf16x8, hw), al = __builtin_bit_cast(bf16x8, lw);
                const bf16x8 bh_0 = *(const bf16x8*)(bh0 + k0), bh_1 = *(const bf16x8*)(bh0 + 16 * DM + k0), bl_0 = *(const bf16x8*)(bl0 + k0), bl_1 = *(const bf16x8*)(bl0 + 16 * DM + k0);
                a0 = MFMA16(ah, bh_0, a0); a0 = MFMA16(ah, bl_0, a0); a0 = MFMA16(al, bh_0, a0);
                a1 = MFMA16(ah, bh_1, a1); a1 = MFMA16(ah, bl_1, a1); a1 = MFMA16(al, bh_1, a1);
            }
            ss += __shfl_xor(ss, 16); ss += __shfl_xor(ss, 32);
            const float rstd = rsqrtf(ss * (1.f / DM) + NORM_EPS);
            if (l4 == 0) rsd[wave * 16 + l15] = rstd;
            const float br0 = p.b_router[l15], br1 = p.b_router[16 + l15];
#pragma unroll
            for (int r = 0; r < 4; ++r) {
                const float rs = __shfl(rstd, l4 * 4 + r);
                lg[(wave * 16 + l4 * 4 + r) * 33 + l15] = a0[r] * rs + br0;
                lg[(wave * 16 + l4 * 4 + r) * 33 + 16 + l15] = a1[r] * rs + br1;
            }
        }
        __syncthreads();
        if (tid < 64) {
            float v[32];
#pragma unroll
            for (int e = 0; e < 32; ++e) v[e] = lg[tid * 33 + e];
            float tv[4]; int ti[4];
#pragma unroll
            for (int k = 0; k < 4; ++k) {
                float best = -3.0e38f; int bi = 0;
#pragma unroll
                for (int e = 0; e < 32; ++e) { const bool take = v[e] > best; best = take ? v[e] : best; bi = take ? e : bi; }
                tv[k] = best; ti[k] = bi;
#pragma unroll
                for (int e = 0; e < 32; ++e) v[e] = (e == bi) ? -3.0e38f : v[e];
            }
            const float e1 = __expf(tv[1] - tv[0]), e2 = __expf(tv[2] - tv[0]), e3 = __expf(tv[3] - tv[0]); const float inv = 1.f / (1.f + e1 + e2 + e3);
            const float w4[4] = {inv, e1 * inv, e2 * inv, e3 * inv};
#pragma unroll
            for (int k = 0; k < 4; ++k) { const int lp = atomicAdd((int*)&lcnt[ti[k]], 1); sel[tid * 4 + k] = ti[k] | (lp << 8); selw[tid * 4 + k] = w4[k]; }
        }
        __syncthreads();
        if (tid < 32) lcnt[32 + tid] = (int)__hip_atomic_fetch_add(cnt + tid * 16, (unsigned)lcnt[tid], __ATOMIC_RELAXED, __HIP_MEMORY_SCOPE_AGENT);
        __syncthreads();
        if (tid < 256) {
            const int s = sel[tid], e = s & 255, pos = lcnt[32 + e] + (s >> 8), tok = tok0 + (tid >> 2);
            list[e * NTOK + pos] = tok; wlist[e * NTOK + pos] = selw[tid];
            tinfo[(size_t)tok * 8 + (tid & 3) * 2] = e; tinfo[(size_t)tok * 8 + (tid & 3) * 2 + 1] = pos;
        }
#pragma unroll 1
        for (int tt = 0; tt < 8; ++tt) {
            const int tl = wave * 8 + tt; const float rs = rsd[tl];
            const float* xr = p.out + (size_t)(tok0 + tl) * DM;
#pragma unroll
            for (int i = 0; i < 8; ++i) {
                const f32x4 xv = *(const f32x4*)(xr + (i * 64 + lane) * 4), g = *(const f32x4*)(p.norm2_g + (i * 64 + lane) * 4);
                const float rs2 = rs * H8_SCALE;
                *(unsigned*)(h2 + (size_t)(tok0 + tl) * DM + (i * 64 + lane) * 4) = cvt4_fp8(xv[0] * rs2 * g[0], xv[1] * rs2 * g[1], xv[2] * rs2 * g[2], xv[3] * rs2 * g[3]);
            }
        }
        __syncthreads();
    }
}

DI void moe_table(const Params& p, LAS char* lds) {
    LAS int* ts = (LAS int*)(lds + 64); LAS int* cn = (LAS int*)(lds + 256);
    const int tid = threadIdx.x;
    if (tid < 64) {
        const int e = tid & 31;
        const int c = (int)__hip_atomic_load((unsigned*)(p.ws + WS_CTL) + CW_CNT + e * 16, __ATOMIC_RELAXED, __HIP_MEMORY_SCOPE_AGENT);
        const int tl = (c + 255) >> 8; int incl = tl;
#pragma unroll
        for (int o = 1; o < 32; o <<= 1) { const int t = __shfl_up(incl, o); if ((tid & 31) >= o) incl += t; }
        if (tid < 32) { ts[e + 1] = incl; cn[e] = c; if (e == 0) ts[0] = 0; }
    }
    __syncthreads();
}
DI bool moe_unit(const LAS int* ts, int u, int NTN, int& e, int& mt, int& nt, int& tile0) {
    if (u >= __builtin_amdgcn_readfirstlane(ts[32]) * NTN) return false;
    int ee = 0;
    for (int k = 1; k < 32; ++k) ee = (u >= __builtin_amdgcn_readfirstlane(ts[k]) * NTN) ? k : ee;
    const int t0 = __builtin_amdgcn_readfirstlane(ts[ee]), t1 = __builtin_amdgcn_readfirstlane(ts[ee + 1]);
    const int l = u - t0 * NTN, nte = t1 - t0;
    if (NTN == 8) { const int g = l / (2 * nte), r = l - g * 2 * nte; nt = 2 * g + (r & 1); mt = r >> 1; }
    else { nt = l / nte; mt = l - nt * nte; }
    e = ee; tile0 = t0; return true;
}
DI int moe_uidx(int i) {
    if (gridDim.x != 256) return (int)blockIdx.x + i * (int)gridDim.x;
    const int c = blockIdx.x, x = c & 7, s = c >> 3;
    return 256 * i + 8 * (x + 8 * (s >> 3)) + (s & 7);
}
DI void p7_gateup(const Params& p, LAS char* lds) {
    moe_table(p, lds);
    const LAS int* ts = (const LAS int*)(lds + 64); const LAS int* cn = (const LAS int*)(lds + 256);
    const int tid = threadIdx.x; const int* list = (const int*)(p.ws + WS_LIST);
    const bf16_t* h2 = (const bf16_t*)(p.ws + WS_H); const unsigned char* wgu = p.ws + WS_WGU;
    int e, mt, nt, t0; bool have = moe_unit(ts, moe_uidx(0), 16, e, mt, nt, t0), pre = false;
    if (have && tid < 256) { const int pos = mt * 256 + tid; ((LAS int*)(lds + 1024))[tid] = pos < cn[e] ? list[e * NTOK + pos] : 0; }
    __syncthreads();
    for (int i = 0; have; ++i) {
        LAS int* rowidx = (LAS int*)(lds + 1024 + (i & 1) * 1024); LAS int* rowidx2 = (LAS int*)(lds + 1024 + ((i + 1) & 1) * 1024);
        int e2, mt2, nt2, t02; const bool have2 = moe_unit(ts, moe_uidx(i + 1), 16, e2, mt2, nt2, t02);
        if (have2 && tid < 256) { const int pos = mt2 * 256 + tid; rowidx2[tid] = pos < cn[e2] ? list[e2 * NTOK + pos] : 0; }
        EpiGateUp ep{p.ws + WS_ACT, p.b_gu + (size_t)e * 4096, (t0 + mt) * 256, nt};
        auto next = [&]() { if (have2) gemm_issue<true, true>(h2, DM / 2, 0, rowidx2, (const bf16_t*)(wgu + ((size_t)e2 * 4096 + nt2 * 256) * DM), DM / 2, lds + LDS_MISC); };
        gemm_tile<true, true>(h2, DM / 2, 0, rowidx, (const bf16_t*)(wgu + ((size_t)e * 4096 + nt * 256) * DM), DM / 2, lds + LDS_MISC, ep, pre, next);
        pre = have2; have = have2; e = e2; mt = mt2; nt = nt2; t0 = t02;
    }
}
DI void p8_down(const Params& p, LAS char* lds) {
    moe_table(p, lds);
    const LAS int* ts = (const LAS int*)(lds + 64);
    const bf16_t* act = (const bf16_t*)(p.ws + WS_ACT); const unsigned char* wd = p.ws + WS_WD;
    int e, mt, nt, t0; bool have = moe_unit(ts, moe_uidx(0), 8, e, mt, nt, t0), pre = false;
    for (int i = 0; have; ++i) {
        int e2, mt2, nt2, t02; const bool have2 = moe_unit(ts, moe_uidx(i + 1), 8, e2, mt2, nt2, t02);
        const int slot0 = (t0 + mt) * 256;
        EpiDown ep{p.ws + WS_YS, p.b_down + (size_t)e * 2048, (const float*)(p.ws + WS_WLIST) + (size_t)e * NTOK + mt * 256, slot0, nt};
        auto next = [&]() { if (have2) gemm_issue<false, true>(act, DM / 2, (t02 + mt2) * 256, (const LAS int*)nullptr, (const bf16_t*)(wd + ((size_t)e2 * 2048 + nt2 * 256) * DM), DM / 2, lds + LDS_MISC); };
        gemm_tile<false, true>(act, DM / 2, slot0, (const LAS int*)nullptr, (const bf16_t*)(wd + ((size_t)e * 2048 + nt * 256) * DM), DM / 2, lds + LDS_MISC, ep, pre, next);
        pre = have2; have = have2; e = e2; mt = mt2; nt = nt2; t0 = t02;
    }
}
DI void p9_combine(const Params& p, LAS char* lds) {
    moe_table(p, lds);
    const LAS int* ts = (const LAS int*)(lds + 64);
    const int tid = threadIdx.x, lane = tid & 63, wave = tid >> 6;
    const int* tinfo = (const int*)(p.ws + WS_TINFO); const unsigned char* ys = p.ws + WS_YS;
    constexpr float iy = 1.f / Y8_SCALE;
    for (int tok = blockIdx.x * 8 + wave; tok < NTOK; tok += gridDim.x * 8) {
        int slot[4];
#pragma unroll
        for (int k = 0; k < 4; ++k) { const int e = tinfo[(size_t)tok * 8 + k * 2], pos = tinfo[(size_t)tok * 8 + k * 2 + 1]; slot[k] = ts[e] * 256 + pos; }
#pragma unroll
        for (int i = 0; i < 4; ++i) {
            const int cA = i * 512 + lane * 4, cB = cA + 256;
            f32x4 a0 = {0.f, 0.f, 0.f, 0.f}, a1 = {0.f, 0.f, 0.f, 0.f};
#pragma unroll
            for (int k = 0; k < 4; ++k) { const unsigned wa = *(const unsigned*)(ys + (size_t)slot[k] * DM + cA), wb = *(const unsigned*)(ys + (size_t)slot[k] * DM + cB);
                const f32x2 q0 = __builtin_amdgcn_cvt_pk_f32_fp8((int)wa, false), q1 = __builtin_amdgcn_cvt_pk_f32_fp8((int)wa, true);
                const f32x2 q2 = __builtin_amdgcn_cvt_pk_f32_fp8((int)wb, false), q3 = __builtin_amdgcn_cvt_pk_f32_fp8((int)wb, true);
                a0[0] += q0[0]; a0[1] += q0[1]; a0[2] += q1[0]; a0[3] += q1[1]; a1[0] += q2[0]; a1[1] += q2[1]; a1[2] += q3[0]; a1[3] += q3[1]; }
            float* o = p.out + (size_t)tok * DM;
            const f32x4 x0 = *(const f32x4*)(o + cA), x1 = *(const f32x4*)(o + cB);
            *(f32x4*)(o + cA) = x0 + a0 * iy; *(f32x4*)(o + cB) = x1 + a1 * iy;
        }
    }
}

__global__ void __launch_bounds__(512, 2) mega(Params p) {
    extern __shared__ __attribute__((aligned(16))) unsigned char lds_raw[];
    LAS char* lds = (LAS char*)lds_raw;
    const int tid = threadIdx.x;
    if (tid < 16) ((LAS unsigned*)lds)[tid] = 0u;
    __syncthreads();
    XcdBarrier bar; bar.bar = (unsigned*)(p.ws + WS_CTL); bar.x = 0; bar.st = (volatile LAS unsigned*)lds;
    const int lo = p.ph_lo, hi = p.ph_hi;
    if (hi - lo > 1) bar = xcd_barrier_post((unsigned*)(p.ws + WS_CTL), (volatile LAS unsigned*)lds);
#ifdef MK_ONLY
#define IN(k) ((k) == MK_ONLY && lo <= (k) && (k) < hi)
#else
#define IN(k) (lo <= (k) && (k) < hi)
#endif
#define SEAM(k) do { if (IN(k) && IN((k) + 1)) xcd_barrier(bar); } while (0)
#ifndef MK_DUP
#define MK_DUP (-1)
#endif
#define REP(k) for (int rep_ = 0; rep_ < ((k) == MK_DUP ? 2 : 1); ++rep_)
    if (IN(0)) REP(0) { p0_prologue(p, lds); } SEAM(0);
    if (IN(1)) REP(1) { p1_inproj(p, lds); } SEAM(1);
    if (IN(2)) REP(2) {
        for (int pr = blockIdx.x; pr < 2048; pr += gridDim.x) gdn_prep_pair(p, lds + LDS_MISC, pr);
        p2_qknorm(p);
    } SEAM(2);
    if (IN(3)) REP(3) { p3_mixers(p, lds, rep_); } SEAM(3);
    if (IN(4)) REP(4) { p4_branches(p, lds); } SEAM(4);
    if (IN(5)) REP(5) { p5_outproj(p, lds); } SEAM(5);
    if (IN(6)) { p6_router(p, lds); } SEAM(6);
    if (IN(7)) REP(7) { p7_gateup(p, lds); } SEAM(7);
    if (IN(8)) REP(8) { p8_down(p, lds); } SEAM(8);
    if (IN(9)) { p9_combine(p, lds); }
#undef IN
#undef SEAM
}

#ifndef MK_N_LAUNCHES
#define MK_N_LAUNCHES 1
#endif
extern "C" void kernel_launch(void* const* d_in, const int* in_sizes, int n_in, void* d_out, int out_size, void* d_ws, size_t ws_size, hipStream_t stream) {
    static int grid = 0;
    if (grid == 0) {
        if (n_in != 26 || out_size != NTOK * DM || ws_size < WS_END) { fprintf(stderr, "kernel_launch: unexpected shapes (n_in %d out %d ws %zu, need ws >= %zu)\n", n_in, out_size, ws_size, (size_t)WS_END); grid = -1; return; }
        int dev = 0, cus = 0, per_cu = 0;
        (void)hipGetDevice(&dev); (void)hipDeviceGetAttribute(&cus, hipDeviceAttributeMultiprocessorCount, dev);
        if (hipFuncSetAttribute((const void*)mega, hipFuncAttributeMaxDynamicSharedMemorySize, LDS_BYTES) != hipSuccess) { fprintf(stderr, "kernel_launch: hipFuncSetAttribute(%d) failed\n", LDS_BYTES); grid = -1; return; }
        (void)hipOccupancyMaxActiveBlocksPerMultiprocessor(&per_cu, (const void*)mega, 512, LDS_BYTES);
        (void)hipGetLastError();
        if (per_cu < 1) fprintf(stderr, "kernel_launch: occupancy query says %d blocks per CU\n", per_cu);
        grid = cus;
    }
    if (grid < 0) return;
    (void)hipMemsetAsync((char*)d_ws + WS_CTL, 0, CTL_ZERO_BYTES, stream);
    Params p{};
    p.x = (const float*)d_in[0]; p.positions = (const int*)d_in[1]; p.norm1_g = (const float*)d_in[2]; p.w_in = (const float*)d_in[3]; p.b_gate = (const float*)d_in[4];
    p.conv_w = (const float*)d_in[5]; p.a_log = (const float*)d_in[6]; p.dt_bias = (const float*)d_in[7]; p.gdn_norm_g = (const float*)d_in[8]; p.q_norm_g = (const float*)d_in[9];
    p.k_norm_g = (const float*)d_in[10]; p.lq1 = (const float*)d_in[11]; p.lk1 = (const float*)d_in[12]; p.lq2 = (const float*)d_in[13]; p.lk2 = (const float*)d_in[14];
    p.subln_g = (const float*)d_in[15]; p.w_a = (const float*)d_in[16]; p.w_b = (const float*)d_in[17]; p.w_out = (const float*)d_in[18]; p.norm2_g = (const float*)d_in[19];
    p.w_router = (const float*)d_in[20]; p.b_router = (const float*)d_in[21]; p.w_gu = (const float*)d_in[22]; p.b_gu = (const float*)d_in[23]; p.w_down = (const float*)d_in[24];
    p.b_down = (const float*)d_in[25]; p.out = (float*)d_out; p.ws = (unsigned char*)d_ws;
    if (MK_N_LAUNCHES == 1) { p.ph_lo = 0; p.ph_hi = 10; hipLaunchKernelGGL(mega, dim3(grid), dim3(512), LDS_BYTES, stream, p); }
    else for (int ph = 0; ph < 10; ++ph) { p.ph_lo = ph; p.ph_hi = ph + 1; hipLaunchKernelGGL(mega, dim3(grid), dim3(512), LDS_BYTES, stream, p); }
    const hipError_t le = hipPeekAtLastError();
    if (le != hipSuccess) fprintf(stderr, "kernel_launch: launch failed: %s\n", hipGetErrorName(le));
}
```

```cpp
#include <hip/hip_runtime.h>
#include <stdint.h>
#include <stdio.h>

#define DI __device__ __forceinline__
#define LAS __attribute__((address_space(3)))

typedef unsigned short bf16_t;
typedef short bf16x8 __attribute__((ext_vector_type(8)));
typedef short s16x4 __attribute__((ext_vector_type(4)));
typedef float f32x2 __attribute__((ext_vector_type(2)));
typedef float f32x4 __attribute__((ext_vector_type(4)));
typedef float f32x16 __attribute__((ext_vector_type(16)));
typedef unsigned u32x2 __attribute__((ext_vector_type(2)));
typedef unsigned u32x4 __attribute__((ext_vector_type(4)));

constexpr int NTOK = 16384, DM = 2048, SEQ = 4096, NBATCH = 4;
constexpr int IN_COLS = 18464;
constexpr int PROJ_LD = 18432;
constexpr int PC_QKV = 0, PC_Z = 6144, PC_QB = 8192, PC_KB = 10240, PC_VB = 12288, PC_GATE = 14336;
constexpr int NEXP = 32, TOPK = 4;
constexpr float NORM_EPS = 1e-6f;
constexpr int MAX_SLOTS = 73728;

constexpr size_t MiB = (size_t)1 << 20;
constexpr size_t WS_CTL = 0;
constexpr size_t CTL_ZERO_BYTES = 64 * 1024;
constexpr size_t WS_H = 1 * MiB;
constexpr size_t WS_WIN = 65 * MiB;
constexpr size_t WS_WA = 137 * MiB, WS_WB = 145 * MiB, WS_WO = 153 * MiB;
constexpr size_t WS_WS = 161 * MiB;
constexpr size_t WS_BA = 162 * MiB;
constexpr size_t WS_WGU = 164 * MiB;
constexpr size_t WS_WD = 676 * MiB;
constexpr size_t WS_PROJ = 932 * MiB;
constexpr size_t WS_NEGW = 1508 * MiB;
constexpr size_t WS_QG = 1572 * MiB;
constexpr size_t WS_KDT = 1636 * MiB;
constexpr size_t WS_UT = 1700 * MiB;
constexpr size_t WS_QK = 1764 * MiB;
constexpr size_t WS_GL = 1796 * MiB;
constexpr size_t WS_QN = 1797 * MiB;
constexpr size_t WS_KN = 1861 * MiB;
constexpr size_t WS_OA = 1925 * MiB;
constexpr size_t WS_OB = 1989 * MiB;
constexpr size_t WS_TMP = 2053 * MiB;
constexpr size_t WS_MRG = 2181 * MiB;
constexpr size_t WS_LIST = 2245 * MiB;
constexpr size_t WS_WLIST = 2247 * MiB;
constexpr size_t WS_TINFO = 2249 * MiB;
constexpr size_t WS_ACT = 2250 * MiB;
constexpr size_t WS_YS = 2538 * MiB;
constexpr size_t WS_H8 = 2826 * MiB;
constexpr size_t WS_WIN8 = 2858 * MiB;
constexpr size_t WS_GVBT = 2866 * MiB, WS_GKBGT = 2930 * MiB;
constexpr size_t WS_VBUF = 2994 * MiB;
constexpr size_t WS_END = 3058 * MiB;

#define XB_TMO      128
#define XB_XCNT(j)  (256  + 64 * (j))
#define XB_XSUB(j)  (1280 + 64 * (j))
#define XB_XGEN(j)  (2304 + 64 * (j))
#define XB_TOP      3328
#define XB_TOPGEN   3392
#define XCD_BAR_WORDS 3456
#define XB_SPIN_CAP (1u << 19)
constexpr int CW_QUEUE = 4096;
constexpr int CW_CNT = 8192;

typedef __bf16 bf16v2_t __attribute__((ext_vector_type(2)));
DI unsigned cvt_pk_bf16(float lo, float hi) { f32x2 v = {lo, hi}; bf16v2_t r = __builtin_convertvector(v, bf16v2_t); return __builtin_bit_cast(unsigned, r); }
DI float bf2f(unsigned short v) { return __uint_as_float(((unsigned)v) << 16); }
DI float bflo(unsigned w) { return __uint_as_float(w << 16); }
DI float bfhi(unsigned w) { return __uint_as_float(w & 0xffff0000u); }
DI float sigmoidf_(float x) { return __builtin_amdgcn_rcpf(1.f + __expf(-x)); }
DI float siluf_(float x) { return x * __builtin_amdgcn_rcpf(1.f + __expf(-x)); }
DI unsigned cvt4_fp8(float a, float b, float c, float d) { int w = __builtin_amdgcn_cvt_pk_fp8_f32(a, b, 0, false); w = __builtin_amdgcn_cvt_pk_fp8_f32(c, d, w, true); return (unsigned)w; }
constexpr float Y8_SCALE = 16.f;
constexpr float W8_SCALE = 64.f, H8_SCALE = 2.f, A8_SCALE = 4.f;
#define MFMA16(a, b, c) __builtin_amdgcn_mfma_f32_16x16x32_bf16((a), (b), (c), 0, 0, 0)
#define MFMA32(a, b, c) __builtin_amdgcn_mfma_f32_32x32x16_bf16((a), (b), (c), 0, 0, 0)
#define WAIT_V(n) asm volatile("s_waitcnt vmcnt(" #n ")" ::: "memory")
#define WAIT_L(n) asm volatile("s_waitcnt lgkmcnt(" #n ")" ::: "memory")
#define BAR() __builtin_amdgcn_s_barrier()
#define SCHED() __builtin_amdgcn_sched_barrier(0)
#define LDS_BAR() do { asm volatile("s_waitcnt lgkmcnt(0)" ::: "memory"); __builtin_amdgcn_s_barrier(); asm volatile("" ::: "memory"); } while (0)

DI unsigned xb_ld(unsigned* p)              { return __hip_atomic_load(p, __ATOMIC_RELAXED, __HIP_MEMORY_SCOPE_AGENT); }
DI unsigned xb_add(unsigned* p, unsigned v) { return __hip_atomic_fetch_add(p, v, __ATOMIC_RELAXED, __HIP_MEMORY_SCOPE_AGENT); }
DI unsigned xb_xcc_id() { return (unsigned)__builtin_amdgcn_s_getreg((3 << 11) | 20) & 0xFu; }
#define XB_SPIN(cond, bar) do { unsigned _sp = 0; while (cond) { __builtin_amdgcn_s_sleep(1); \
    if ((++_sp & 255u) == 0u) { if (xb_ld(&(bar)[XB_TMO])) break; if (_sp > XB_SPIN_CAP) { atomicAdd(&(bar)[XB_TMO], 1u); break; } } } } while (0)
struct XcdBarrier { unsigned* bar; unsigned x; volatile LAS unsigned* st; };
DI XcdBarrier xcd_barrier_post(unsigned* bar, volatile LAS unsigned* st) {
    XcdBarrier b; b.bar = bar; b.x = xb_xcc_id(); b.st = st;
    if (threadIdx.x == 0) (void)xb_add(&bar[XB_XCNT(b.x)], 1u);
    return b;
}
DI void xcd_barrier_complete(unsigned* bar, unsigned x, unsigned& nloc, unsigned& nx) {
    const unsigned G = gridDim.x * gridDim.y * gridDim.z;
    unsigned sum, cnt, mine, sp = 0u;
    for (;;) {
        sum = 0u; cnt = 0u; mine = 0u;
#pragma unroll
        for (unsigned j = 0; j < 16; ++j) { const unsigned c = xb_ld(&bar[XB_XCNT(j)]); sum += c; cnt += (c > 0u) ? 1u : 0u; mine = (j == x) ? c : mine; }
        if (sum == G) break;
        __builtin_amdgcn_s_sleep(1);
        if ((++sp & 255u) == 0u) { if (xb_ld(&bar[XB_TMO])) break; if (sp > XB_SPIN_CAP) { atomicAdd(&bar[XB_TMO], 1u); break; } }
    }
    nloc = mine > 0u ? mine : 1u; nx = cnt > 0u ? cnt : 1u;
}
DI void xcd_barrier(const XcdBarrier& b) {
    asm volatile("s_waitcnt vmcnt(0)" ::: "memory");
    __syncthreads();
    if (threadIdx.x == 0) {
        unsigned* bar = b.bar;
        __builtin_amdgcn_s_waitcnt(0);
        unsigned nloc = b.st[0], nx = b.st[1];
        if (nloc == 0u) { xcd_barrier_complete(bar, b.x, nloc, nx); b.st[0] = nloc; b.st[1] = nx; }
        const unsigned old = xb_add(&bar[XB_XSUB(b.x)], 1u);
        const unsigned gen = old / nloc;
        if (old + 1u == (gen + 1u) * nloc) {
            __builtin_amdgcn_fence(__ATOMIC_RELEASE, "agent");
            asm volatile("s_waitcnt vmcnt(0)" ::: "memory");
            const unsigned og = xb_add(&bar[XB_TOP], 1u);
            const unsigned tg = og / nx;
            if (og + 1u == (tg + 1u) * nx) xb_add(&bar[XB_TOPGEN], 1u);
            else XB_SPIN(xb_ld(&bar[XB_TOPGEN]) == tg, bar);
            __builtin_amdgcn_fence(__ATOMIC_ACQUIRE, "agent");
            xb_add(&bar[XB_XGEN(b.x)], 1u);
            asm volatile("s_waitcnt vmcnt(0)" ::: "memory");
        } else {
            XB_SPIN(xb_ld(&bar[XB_XGEN(b.x)]) == gen, bar);
            __builtin_amdgcn_fence(__ATOMIC_ACQUIRE, "agent");
            asm volatile("s_waitcnt vmcnt(0)" ::: "memory");
        }
    }
    __syncthreads();
}

struct Params {
    const float* x; const int* positions; const float* norm1_g; const float* w_in; const float* b_gate; const float* conv_w;
    const float* a_log; const float* dt_bias; const float* gdn_norm_g; const float* q_norm_g; const float* k_norm_g;
    const float* lq1; const float* lk1; const float* lq2; const float* lk2; const float* subln_g;
    const float* w_a; const float* w_b; const float* w_out; const float* norm2_g; const float* w_router; const float* b_router;
    const float* w_gu; const float* b_gu; const float* w_down; const float* b_down;
    float* out; unsigned char* ws;
    int ph_lo, ph_hi;
};

constexpr int LDS_MISC = 3072;
constexpr int LDS_BYTES = 160 * 1024 - 1024;

struct CvtTile { const float* src; int ld; unsigned char* dst; int ldd; int f8; };
constexpr int CVT_NT = 2304 + 768 + 16384 + 8192;

DI CvtTile cvt_tile_of(const Params& p, int t) {
    CvtTile c;
    if (t < 2304) {
        const int kb = t / 144, nb = t % 144, n1 = nb * 128, sc = n1 < 8192 ? n1 : n1 + 32;
        c.src = p.w_in + (size_t)kb * 128 * IN_COLS + sc; c.ld = IN_COLS;
        if (n1 >= PC_GATE) { c.dst = p.ws + WS_WIN8 + (size_t)(n1 - PC_GATE) * 2048 + kb * 128; c.ldd = 2048; c.f8 = 1; }
        else if (n1 >= PC_Z && n1 < PC_QB) { c.dst = p.ws + WS_WIN8 + (size_t)(4096 + n1 - PC_Z) * 2048 + kb * 128; c.ldd = 2048; c.f8 = 1; }
        else { c.dst = p.ws + WS_WIN + ((size_t)n1 * 2048 + kb * 128) * 2; c.ldd = 4096; c.f8 = 0; }
    } else if (t < 3072) {
        const int m = (t - 2304) >> 8, r = (t - 2304) & 255, kb = r >> 4, nb = r & 15;
        const float* s = m == 0 ? p.w_a : (m == 1 ? p.w_b : p.w_out);
        const size_t d = m == 0 ? WS_WA : (m == 1 ? WS_WB : WS_WO);
        c.src = s + (size_t)kb * 128 * 2048 + nb * 128; c.ld = 2048;
        c.dst = p.ws + d + ((size_t)nb * 128 * 2048 + kb * 128) * 2; c.ldd = 4096; c.f8 = 0;
    } else if (t < 3072 + 16384) {
        const int r = t - 3072, e = r >> 9, r2 = r & 511, kb = r2 >> 5, nb = r2 & 31;
        const int drow = nb < 16 ? nb * 256 : (nb - 16) * 256 + 128;
        c.src = p.w_gu + (size_t)e * 2048 * 4096 + (size_t)kb * 128 * 4096 + nb * 128; c.ld = 4096;
        c.dst = p.ws + WS_WGU + ((size_t)e * 4096 + drow) * 2048 + kb * 128; c.ldd = 2048; c.f8 = 1;
    } else {
        const int r = t - 19456, e = r >> 8, r2 = r & 255, kb = r2 >> 4, nb = r2 & 15;
        c.src = p.w_down + (size_t)e * 2048 * 2048 + (size_t)kb * 128 * 2048 + nb * 128; c.ld = 2048;
        c.dst = p.ws + WS_WD + ((size_t)e * 2048 + nb * 128) * 2048 + kb * 128; c.ldd = 2048; c.f8 = 1;
    }
    return c;
}

DI void cvt_store(const CvtTile& cur, const LAS float* tile, int tid) {
    const int n = tid & 127, kseg = (tid >> 7) * 32;
    if (cur.f8) {
        u32x4 w[2];
#pragma unroll
        for (int g = 0; g < 8; ++g) {
            float e[4];
#pragma unroll
            for (int j = 0; j < 4; ++j) e[j] = tile[(kseg + g * 4 + j) * 132 + n] * W8_SCALE;
            w[g >> 2][g & 3] = cvt4_fp8(e[0], e[1], e[2], e[3]);
        }
        *(u32x4*)(cur.dst + (size_t)n * cur.ldd + kseg) = w[0]; *(u32x4*)(cur.dst + (size_t)n * cur.ldd + kseg + 16) = w[1];
    } else {
#pragma unroll
        for (int g = 0; g < 4; ++g) {
            float e[8];
#pragma unroll
            for (int j = 0; j < 8; ++j) e[j] = tile[(kseg + g * 8 + j) * 132 + n];
            u32x4 w = {cvt_pk_bf16(e[0], e[1]), cvt_pk_bf16(e[2], e[3]), cvt_pk_bf16(e[4], e[5]), cvt_pk_bf16(e[6], e[7])};
            *(u32x4*)(cur.dst + (size_t)n * cur.ldd + (kseg + g * 8) * 2) = w;
        }
    }
}
template <int NT>
DI void cvt_tiles(const Params& p, LAS char* lds, int t0, int step) {
    int tid_ = threadIdx.x; asm volatile("" : "+v"(tid_));
    const int tid = tid_;
    LAS float* tile = (LAS float*)(lds + LDS_MISC);
    f32x4 v[4][8]; CvtTile c[4];
#define CV_LOAD(s_, t) do { const int sl_ = (s_); c[sl_] = cvt_tile_of(p, t); _Pragma("unroll") for (int i_ = 0; i_ < 8; ++i_) { const int idx = tid + 512 * i_; \
        const float* a_ = c[sl_].src + (size_t)(idx >> 5) * c[sl_].ld + (idx & 31) * 4; asm volatile("global_load_dwordx4 %0, %1, off nt" : "=v"(v[sl_][i_]) : "v"(a_) : "memory"); } } while (0)
#define CV_BAR() do { asm volatile("s_waitcnt lgkmcnt(0)" ::: "memory"); __builtin_amdgcn_s_barrier(); asm volatile("" ::: "memory"); } while (0)
#pragma unroll
    for (int i = 0; i < 4; ++i) if (i < NT) CV_LOAD(i, t0 + i * step);
#pragma unroll
    for (int i = 0; i < NT; ++i) {
        const int younger = (NT - 1 - i) < 3 ? (NT - 1 - i) : 3;
        if (younger == 3) asm volatile("s_waitcnt vmcnt(24)" ::: "memory");
        else if (younger == 2) asm volatile("s_waitcnt vmcnt(16)" ::: "memory");
        else if (younger == 1) asm volatile("s_waitcnt vmcnt(8)" ::: "memory");
        else asm volatile("s_waitcnt vmcnt(0)" ::: "memory");
#pragma unroll
        for (int q = 0; q < 8; ++q) { const int idx = tid + 512 * q; *(LAS f32x4*)(tile + (idx >> 5) * 132 + (idx & 31) * 4) = v[i & 3][q]; }
        CV_BAR();
        const CvtTile cur = c[i & 3];
        if (i + 4 < NT) CV_LOAD(i & 3, t0 + (i + 4) * step);
        cvt_store(cur, tile, tid);
        CV_BAR();
    }
#undef CV_LOAD
#undef CV_BAR
}

DI void p0_prologue(const Params& p, LAS char* lds) {
    const int tid = threadIdx.x, lane = tid & 63, wave = tid >> 6;
    {
        bf16_t* h = (bf16_t*)(p.ws + WS_H);
        for (int row = blockIdx.x * 8 + wave; row < NTOK; row += gridDim.x * 8) {
            const float* xr = p.x + (size_t)row * DM;
            f32x4 v[8]; float ss = 0.f;
#pragma unroll
            for (int i = 0; i < 8; ++i) { v[i] = *(const f32x4*)(xr + (i * 64 + lane) * 4); ss += v[i][0] * v[i][0] + v[i][1] * v[i][1] + v[i][2] * v[i][2] + v[i][3] * v[i][3]; }
#pragma unroll
            for (int o = 32; o >= 1; o >>= 1) ss += __shfl_xor(ss, o);
            const float rs = rsqrtf(ss * (1.f / DM) + NORM_EPS);
#pragma unroll
            for (int i = 0; i < 8; ++i) {
                const f32x4 g = *(const f32x4*)(p.norm1_g + (i * 64 + lane) * 4);
                u32x2 w; w[0] = cvt_pk_bf16(v[i][0] * rs * g[0], v[i][1] * rs * g[1]); w[1] = cvt_pk_bf16(v[i][2] * rs * g[2], v[i][3] * rs * g[3]);
                *(u32x2*)(h + (size_t)row * DM + (i * 64 + lane) * 4) = w;
                const float rs2 = rs * H8_SCALE;
                *(unsigned*)(p.ws + WS_H8 + (size_t)row * DM + (i * 64 + lane) * 4) = cvt4_fp8(v[i][0] * rs2 * g[0], v[i][1] * rs2 * g[1], v[i][2] * rs2 * g[2], v[i][3] * rs2 * g[3]);
            }
        }
    }
    {
        bf16_t* wsl = (bf16_t*)(p.ws + WS_WS); bf16_t* rhi = wsl + 32 * 2048; bf16_t* rlo = rhi + 32 * 2048;
        for (int idx = blockIdx.x * 512 + tid; idx < 32 * 2048; idx += gridDim.x * 512) {
            const int n = idx >> 11, k = idx & 2047;
            const float a = p.w_in[(size_t)k * IN_COLS + 8192 + n];
            wsl[idx] = (bf16_t)(cvt_pk_bf16(a, 0.f) & 0xffff);
            const float r = p.w_router[k * 32 + n];
            const unsigned hi = cvt_pk_bf16(r, 0.f) & 0xffff; const float rem = r - bflo(hi);
            rhi[idx] = (bf16_t)hi; rlo[idx] = (bf16_t)(cvt_pk_bf16(rem, 0.f) & 0xffff);
        }
    }
    if (gridDim.x == 256) cvt_tiles<12>(p, lds, blockIdx.x, 256);
    else for (int t = blockIdx.x; t < 3072; t += gridDim.x) cvt_tiles<1>(p, lds, t, 0);
    __syncthreads();
}

constexpr int G_HT = 128 * 64;
DI int lds_byte(int r, int c) { const int st = (r >> 4) * 2 + (c >> 5), rr = r & 15, cc = c & 31, ob = rr * 64 + cc * 2; return st * 1024 + (ob ^ (((ob >> 9) & 1) << 5)); }
DI int perm32(int rho) { const int n = rho >> 4, i = rho & 15; return 8 * (i >> 2) + 4 * n + (i & 3); }
DI void stage_rc(int b, int& R, int& C) { const int st = b / 1024, sb = b % 1024, swz = sb ^ (((sb >> 9) & 1) << 5); R = (st >> 1) * 16 + swz / 64; C = (st & 1) * 32 + (swz % 64) / 2; }

typedef int i32x8 __attribute__((ext_vector_type(8)));
typedef int i32x4 __attribute__((ext_vector_type(4)));
DI i32x8 cat8(bf16x8 a, bf16x8 b) { const i32x4 x = __builtin_bit_cast(i32x4, a), y = __builtin_bit_cast(i32x4, b); return __builtin_shufflevector(x, y, 0, 1, 2, 3, 4, 5, 6, 7); }
DI void mfma_f8(f32x4& acc, i32x8 a, i32x8 b, int one8) {
    asm volatile("s_nop 1\n\tv_mfma_scale_f32_16x16x128_f8f6f4 %0, %1, %2, %0, %3, %3 op_sel_hi:[0,0,0]" : "+v"(acc) : "v"(a), "v"(b), "v"(one8));
}
template <bool GATHER, bool PERM>
DI void gemm_issue(const bf16_t* A, int lda, int brow, const LAS int* rowidx, const bf16_t* Bt, int K, LAS char* stage) {
    LAS bf16_t* shm = (LAS bf16_t*)stage;
    int tid = threadIdx.x; asm volatile("" : "+v"(tid));
    const int wv = __builtin_amdgcn_readfirstlane(tid >> 6);
    int R0, C0; stage_rc(tid * 16, R0, C0);
    const __amdgpu_buffer_rsrc_t rsA = __builtin_amdgcn_make_buffer_rsrc((void*)A, 0, 0x7fffffff, 0x00020000);
    const __amdgpu_buffer_rsrc_t rsB = __builtin_amdgcn_make_buffer_rsrc((void*)Bt, 0, 0x7fffffff, 0x00020000);
    const int Rb = PERM ? ((R0 & ~31) + perm32(R0 & 31)) : R0;
    const unsigned bgb = ((unsigned)Rb * (unsigned)K + C0) * 2u;
#define GI_A(b, h, kt) do { _Pragma("unroll") for (int _i = 0; _i < 2; ++_i) { const int r_ = (h) * 128 + _i * 64 + R0; \
        const unsigned o_ = ((GATHER ? (unsigned)rowidx[r_] : (unsigned)(brow + r_)) * (unsigned)lda + C0) * 2u; \
        __builtin_amdgcn_raw_ptr_buffer_load_lds(rsA, (LAS unsigned*)((LAS char*)(shm + ((b) * 2 + (h)) * G_HT) + wv * 1024 + _i * 8192), 16, o_, (kt) * 128, 0, 0); } } while (0)
#define GI_B(b, h, kt) do { _Pragma("unroll") for (int _i = 0; _i < 2; ++_i) \
        __builtin_amdgcn_raw_ptr_buffer_load_lds(rsB, (LAS unsigned*)((LAS char*)(shm + (4 + (b) * 2 + (h)) * G_HT) + wv * 1024 + _i * 8192), 16, bgb, (((h) * 128 + _i * 64) * K + (kt) * 64) * 2, 0, 0); } while (0)
    GI_B(0, 0, 0); GI_A(0, 0, 0); GI_B(0, 1, 0); GI_A(0, 1, 0); GI_B(1, 0, 1); GI_A(1, 0, 1); GI_B(1, 1, 1);
#undef GI_A
#undef GI_B
}
struct NoNext { DI void operator()() const {} };

template <bool GATHER, bool FP8, bool ZERO, class Epi, class Next>
DI void gemm_tile_acc(const bf16_t* A, int lda, int brow, const LAS int* rowidx, const bf16_t* Bt, int K, LAS char* stage, const Epi& epi, bool pre, const Next& next, f32x4 (&acc)[2][2][4][2]) {
    LAS bf16_t* shm = (LAS bf16_t*)stage;
#define SA(b, h) (shm + ((b) * 2 + (h)) * G_HT)
#define SB(b, h) (shm + (4 + (b) * 2 + (h)) * G_HT)
    int tid = threadIdx.x;
    const int wv = __builtin_amdgcn_readfirstlane(tid >> 6);
    int R0, C0; stage_rc(tid * 16, R0, C0);
    unsigned agb[2][2];
    if (GATHER) {
#pragma unroll
        for (int h = 0; h < 2; ++h)
#pragma unroll
            for (int i = 0; i < 2; ++i) agb[h][i] = ((unsigned)rowidx[h * 128 + i * 64 + R0] * (unsigned)lda + C0) * 2u;
    } else {
#pragma unroll
        for (int h = 0; h < 2; ++h)
#pragma unroll
            for (int i = 0; i < 2; ++i) agb[h][i] = ((unsigned)(brow + h * 128 + i * 64 + R0) * (unsigned)lda + C0) * 2u;
    }
    const int Rb = Epi::PERM ? ((R0 & ~31) + perm32(R0 & 31)) : R0;
    const unsigned bgb = ((unsigned)Rb * (unsigned)K + C0) * 2u;
    const __amdgpu_buffer_rsrc_t rsA = __builtin_amdgcn_make_buffer_rsrc((void*)A, 0, 0x7fffffff, 0x00020000);
    const __amdgpu_buffer_rsrc_t rsB = __builtin_amdgcn_make_buffer_rsrc((void*)Bt, 0, 0x7fffffff, 0x00020000);
#define STAGE_A(P, h, kt) do { _Pragma("unroll") for (int _i = 0; _i < 2; ++_i) \
        __builtin_amdgcn_raw_ptr_buffer_load_lds(rsA, (LAS unsigned*)((LAS char*)(P) + wv * 1024 + _i * 8192), 16, agb[h][_i], (kt) * 128, 0, 0); } while (0)
#define STAGE_B(P, h, kt) do { _Pragma("unroll") for (int _i = 0; _i < 2; ++_i) \
        __builtin_amdgcn_raw_ptr_buffer_load_lds(rsB, (LAS unsigned*)((LAS char*)(P) + wv * 1024 + _i * 8192), 16, bgb, (((h) * 128 + _i * 64) * K + (kt) * 64) * 2, 0, 0); } while (0)
#define LDA(dst, b, h) _Pragma("unroll") for (int m = 0; m < 4; ++m) _Pragma("unroll") for (int k = 0; k < 2; ++k) \
        dst[m][k] = *(const LAS bf16x8*)((LAS char*)SA(b, h) + lds_byte(wr * 64 + m * 16 + fr, k * 32 + fq * 8))
#define LDB(dst, b, h) _Pragma("unroll") for (int n = 0; n < 2; ++n) _Pragma("unroll") for (int k = 0; k < 2; ++k) \
        dst[n][k] = *(const LAS bf16x8*)((LAS char*)SB(b, h) + lds_byte(wc * 32 + n * 16 + fr, k * 32 + fq * 8))
#define MMA(ai, bj, At_, Bt_) do { __builtin_amdgcn_s_setprio(1); \
        if (!FP8) { _Pragma("unroll") for (int m = 0; m < 4; ++m) _Pragma("unroll") for (int n = 0; n < 2; ++n) _Pragma("unroll") for (int k = 0; k < 2; ++k) \
            acc[ai][bj][m][n] = MFMA16(Bt_[n][k], At_[m][k], acc[ai][bj][m][n]); } \
        else { _Pragma("unroll") for (int m = 0; m < 4; ++m) _Pragma("unroll") for (int n = 0; n < 2; ++n) \
            mfma_f8(acc[ai][bj][m][n], cat8(Bt_[n][0], Bt_[n][1]), cat8(At_[m][0], At_[m][1]), one8); } \
        __builtin_amdgcn_s_setprio(0); } while (0)

    int wid = tid >> 6, lane = tid & 63, wr = wid >> 2, wc = wid & 3, fr = lane & 15, fq = lane >> 4;
    if (ZERO) {
#pragma unroll
    for (int a = 0; a < 2; ++a)
#pragma unroll
        for (int b = 0; b < 2; ++b)
#pragma unroll
            for (int m = 0; m < 4; ++m)
#pragma unroll
                for (int n = 0; n < 2; ++n) acc[a][b][m][n] = (f32x4){0.f, 0.f, 0.f, 0.f};
    }
    bf16x8 At[4][2], B0[2][2], B1[2][2];
    const int one8 = 0x7f7f7f7f;
    const int nt = K / 64;
    if (!pre) {
        WAIT_V(0);
        STAGE_B(SB(0, 0), 0, 0); STAGE_A(SA(0, 0), 0, 0);
        STAGE_B(SB(0, 1), 1, 0); STAGE_A(SA(0, 1), 1, 0);
        if (wr == 1) BAR();
        WAIT_V(4); BAR();
        STAGE_B(SB(1, 0), 0, 1); STAGE_A(SA(1, 0), 0, 1); STAGE_B(SB(1, 1), 1, 1);
        WAIT_V(6); BAR();
    } else {
        if (wr == 1) BAR();
        WAIT_V(0); BAR();
        BAR();
    }
    for (int t = 0; t < nt - 2; t += 2) {
        LDB(B0, 0, 0); SCHED(); LDA(At, 0, 0); STAGE_A(SA(1, 1), 1, t + 1);
        WAIT_L(8); BAR(); WAIT_L(0); MMA(0, 0, At, B0); BAR(); SCHED();
        LDB(B1, 0, 1); STAGE_B(SB(0, 0), 0, t + 2);
        BAR(); WAIT_L(0); MMA(0, 1, At, B1); BAR();
        LDA(At, 0, 1); STAGE_A(SA(0, 0), 0, t + 2);
        BAR(); WAIT_L(0); MMA(1, 0, At, B0); BAR(); SCHED();
        STAGE_B(SB(0, 1), 1, t + 2);
        WAIT_V(6); BAR(); MMA(1, 1, At, B1); BAR();
        LDB(B0, 1, 0); SCHED(); LDA(At, 1, 0); STAGE_A(SA(0, 1), 1, t + 2);
        WAIT_L(8); BAR(); WAIT_L(0); MMA(0, 0, At, B0); BAR(); SCHED();
        LDB(B1, 1, 1); STAGE_B(SB(1, 0), 0, t + 3);
        BAR(); WAIT_L(0); MMA(0, 1, At, B1); BAR();
        LDA(At, 1, 1); STAGE_A(SA(1, 0), 0, t + 3);
        BAR(); WAIT_L(0); MMA(1, 0, At, B0); BAR(); SCHED();
        STAGE_B(SB(1, 1), 1, t + 3);
        WAIT_V(6); BAR(); MMA(1, 1, At, B1); BAR();
    }
    { LDB(B0, 0, 0); WAIT_V(0); LDA(At, 0, 0); STAGE_A(SA(1, 1), 1, nt - 1);
      BAR(); WAIT_L(0); MMA(0, 0, At, B0); BAR();
      LDB(B1, 0, 1); BAR(); WAIT_L(0); MMA(0, 1, At, B1); BAR();
      LDA(At, 0, 1); WAIT_V(4); BAR(); WAIT_L(0); MMA(1, 0, At, B0); MMA(1, 1, At, B1); BAR(); }
    { LDB(B0, 1, 0); LDA(At, 1, 0); WAIT_V(2); BAR(); WAIT_L(0); MMA(0, 0, At, B0); BAR();
      LDB(B1, 1, 1); WAIT_V(0); BAR(); WAIT_L(0); MMA(0, 1, At, B1); BAR();
      LDA(At, 1, 1); BAR(); WAIT_L(0); MMA(1, 0, At, B0); MMA(1, 1, At, B1); BAR(); }
    if (wr == 0) BAR();
    if (FP8) asm volatile("s_nop 15\n\ts_nop 15" ::: "memory");
    int tz = threadIdx.x; asm volatile("" : "+v"(tz)); wid = tz >> 6; lane = tz & 63; wr = wid >> 2; wc = wid & 3; fr = lane & 15; fq = lane >> 4;
    next();
    epi(acc, wr, wc, fr, fq);
#undef SA
#undef SB
#undef STAGE_A
#undef STAGE_B
#undef LDA
#undef LDB
#undef MMA
}
template <class Epi, class Mid, class Next>
DI void gemm_tile_dual(const bf16_t* A, const bf16_t* A2, int lda, int brow, const bf16_t* Bt, const bf16_t* Bt2, int K, LAS char* stage, const Epi& epi, const Mid& mid, bool pre, const Next& next) {
    constexpr bool GATHER = false, FP8 = false, ZERO = true; const LAS int* rowidx = nullptr; (void)rowidx;
    f32x4 acc[2][2][4][2];
    LAS bf16_t* shm = (LAS bf16_t*)stage;
#define SA(b, h) (shm + ((b) * 2 + (h)) * G_HT)
#define SB(b, h) (shm + (4 + (b) * 2 + (h)) * G_HT)
    int tid = threadIdx.x;
    const int wv = __builtin_amdgcn_readfirstlane(tid >> 6);
    int R0, C0; stage_rc(tid * 16, R0, C0);
    unsigned agb[2][2];
    if (GATHER) {
#pragma unroll
        for (int h = 0; h < 2; ++h)
#pragma unroll
            for (int i = 0; i < 2; ++i) agb[h][i] = ((unsigned)rowidx[h * 128 + i * 64 + R0] * (unsigned)lda + C0) * 2u;
    } else {
#pragma unroll
        for (int h = 0; h < 2; ++h)
#pragma unroll
            for (int i = 0; i < 2; ++i) agb[h][i] = ((unsigned)(brow + h * 128 + i * 64 + R0) * (unsigned)lda + C0) * 2u;
    }
    const int Rb = Epi::PERM ? ((R0 & ~31) + perm32(R0 & 31)) : R0;
    const unsigned bgb = ((unsigned)Rb * (unsigned)K + C0) * 2u;
    const __amdgpu_buffer_rsrc_t rsA = __builtin_amdgcn_make_buffer_rsrc((void*)A, 0, 0x7fffffff, 0x00020000);
    const __amdgpu_buffer_rsrc_t rsB = __builtin_amdgcn_make_buffer_rsrc((void*)Bt, 0, 0x7fffffff, 0x00020000);
    const __amdgpu_buffer_rsrc_t rsA2 = __builtin_amdgcn_make_buffer_rsrc((void*)A2, 0, 0x7fffffff, 0x00020000);
    const __amdgpu_buffer_rsrc_t rsB2 = __builtin_amdgcn_make_buffer_rsrc((void*)Bt2, 0, 0x7fffffff, 0x00020000);
    const int nt1 = K / 64;
#define STAGE_A(P, h, kt) do { const int kt_ = (kt); _Pragma("unroll") for (int _i = 0; _i < 2; ++_i) { \
        if (kt_ < nt1) __builtin_amdgcn_raw_ptr_buffer_load_lds(rsA, (LAS unsigned*)((LAS char*)(P) + wv * 1024 + _i * 8192), 16, agb[h][_i], kt_ * 128, 0, 0); \
        else __builtin_amdgcn_raw_ptr_buffer_load_lds(rsA2, (LAS unsigned*)((LAS char*)(P) + wv * 1024 + _i * 8192), 16, agb[h][_i], (kt_ - nt1) * 128, 0, 0); } } while (0)
#define STAGE_B(P, h, kt) do { const int kt_ = (kt); _Pragma("unroll") for (int _i = 0; _i < 2; ++_i) { \
        if (kt_ < nt1) __builtin_amdgcn_raw_ptr_buffer_load_lds(rsB, (LAS unsigned*)((LAS char*)(P) + wv * 1024 + _i * 8192), 16, bgb, (((h) * 128 + _i * 64) * K + kt_ * 64) * 2, 0, 0); \
        else __builtin_amdgcn_raw_ptr_buffer_load_lds(rsB2, (LAS unsigned*)((LAS char*)(P) + wv * 1024 + _i * 8192), 16, bgb, (((h) * 128 + _i * 64) * K + (kt_ - nt1) * 64) * 2, 0, 0); } } while (0)
#define LDA(dst, b, h) _Pragma("unroll") for (int m = 0; m < 4; ++m) _Pragma("unroll") for (int k = 0; k < 2; ++k) \
        dst[m][k] = *(const LAS bf16x8*)((LAS char*)SA(b, h) + lds_byte(wr * 64 + m * 16 + fr, k * 32 + fq * 8))
#define LDB(dst, b, h) _Pragma("unroll") for (int n = 0; n < 2; ++n) _Pragma("unroll") for (int k = 0; k < 2; ++k) \
        dst[n][k] = *(const LAS bf16x8*)((LAS char*)SB(b, h) + lds_byte(wc * 32 + n * 16 + fr, k * 32 + fq * 8))
#define MMA(ai, bj, At_, Bt_) do { __builtin_amdgcn_s_setprio(1); \
        if (!FP8) { _Pragma("unroll") for (int m = 0; m < 4; ++m) _Pragma("unroll") for (int n = 0; n < 2; ++n) _Pragma("unroll") for (int k = 0; k < 2; ++k) \
            acc[ai][bj][m][n] = MFMA16(Bt_[n][k], At_[m][k], acc[ai][bj][m][n]); } \
        else { _Pragma("unroll") for (int m = 0; m < 4; ++m) _Pragma("unroll") for (int n = 0; n < 2; ++n) \
            mfma_f8(acc[ai][bj][m][n], cat8(Bt_[n][0], Bt_[n][1]), cat8(At_[m][0], At_[m][1]), one8); } \
        __builtin_amdgcn_s_setprio(0); } while (0)

    int wid = tid >> 6, lane = tid & 63, wr = wid >> 2, wc = wid & 3, fr = lane & 15, fq = lane >> 4;
    if (ZERO) {
#pragma unroll
    for (int a = 0; a < 2; ++a)
#pragma unroll
        for (int b = 0; b < 2; ++b)
#pragma unroll
            for (int m = 0; m < 4; ++m)
#pragma unroll
                for (int n = 0; n < 2; ++n) acc[a][b][m][n] = (f32x4){0.f, 0.f, 0.f, 0.f};
    }
    bf16x8 At[4][2], B0[2][2], B1[2][2];
    const int one8 = 0x7f7f7f7f;
    const int nt = 2 * nt1;
    if (!pre) {
        WAIT_V(0);
        STAGE_B(SB(0, 0), 0, 0); STAGE_A(SA(0, 0), 0, 0);
        STAGE_B(SB(0, 1), 1, 0); STAGE_A(SA(0, 1), 1, 0);
        if (wr == 1) BAR();
        WAIT_V(4); BAR();
        STAGE_B(SB(1, 0), 0, 1); STAGE_A(SA(1, 0), 0, 1); STAGE_B(SB(1, 1), 1, 1);
        WAIT_V(6); BAR();
    } else {
        if (wr == 1) BAR();
        WAIT_V(0); BAR();
        BAR();
    }
    for (int t = 0; t < nt - 2; t += 2) {
        if (t == nt1) {
            int t2 = threadIdx.x; asm volatile("" : "+v"(t2));
            mid(acc, (t2 >> 6) >> 2, (t2 >> 6) & 3, (t2 & 63) & 15, (t2 & 63) >> 4);
        }
        LDB(B0, 0, 0); SCHED(); LDA(At, 0, 0); STAGE_A(SA(1, 1), 1, t + 1);
        WAIT_L(8); BAR(); WAIT_L(0); MMA(0, 0, At, B0); BAR(); SCHED();
        LDB(B1, 0, 1); STAGE_B(SB(0, 0), 0, t + 2);
        BAR(); WAIT_L(0); MMA(0, 1, At, B1); BAR();
        LDA(At, 0, 1); STAGE_A(SA(0, 0), 0, t + 2);
        BAR(); WAIT_L(0); MMA(1, 0, At, B0); BAR(); SCHED();
        STAGE_B(SB(0, 1), 1, t + 2);
        WAIT_V(6); BAR(); MMA(1, 1, At, B1); BAR();
        LDB(B0, 1, 0); SCHED(); LDA(At, 1, 0); STAGE_A(SA(0, 1), 1, t + 2);
        WAIT_L(8); BAR(); WAIT_L(0); MMA(0, 0, At, B0); BAR(); SCHED();
        LDB(B1, 1, 1); STAGE_B(SB(1, 0), 0, t + 3);
        BAR(); WAIT_L(0); MMA(0, 1, At, B1); BAR();
        LDA(At, 1, 1); STAGE_A(SA(1, 0), 0, t + 3);
        BAR(); WAIT_L(0); MMA(1, 0, At, B0); BAR(); SCHED();
        STAGE_B(SB(1, 1), 1, t + 3);
        WAIT_V(6); BAR(); MMA(1, 1, At, B1); BAR();
    }
    { LDB(B0, 0, 0); WAIT_V(0); LDA(At, 0, 0); STAGE_A(SA(1, 1), 1, nt - 1);
      BAR(); WAIT_L(0); MMA(0, 0, At, B0); BAR();
      LDB(B1, 0, 1); BAR(); WAIT_L(0); MMA(0, 1, At, B1); BAR();
      LDA(At, 0, 1); WAIT_V(4); BAR(); WAIT_L(0); MMA(1, 0, At, B0); MMA(1, 1, At, B1); BAR(); }
    { LDB(B0, 1, 0); LDA(At, 1, 0); WAIT_V(2); BAR(); WAIT_L(0); MMA(0, 0, At, B0); BAR();
      LDB(B1, 1, 1); WAIT_V(0); BAR(); WAIT_L(0); MMA(0, 1, At, B1); BAR();
      LDA(At, 1, 1); BAR(); WAIT_L(0); MMA(1, 0, At, B0); MMA(1, 1, At, B1); BAR(); }
    if (wr == 0) BAR();
    if (FP8) asm volatile("s_nop 15\n\ts_nop 15" ::: "memory");
    int tz = threadIdx.x; asm volatile("" : "+v"(tz)); wid = tz >> 6; lane = tz & 63; wr = wid >> 2; wc = wid & 3; fr = lane & 15; fq = lane >> 4;
    next();
    epi(acc, wr, wc, fr, fq);
#undef SA
#undef SB
#undef STAGE_A
#undef STAGE_B
#undef LDA
#undef LDB
#undef MMA
}
template <bool GATHER, bool FP8, class Epi, class Next>
DI void gemm_tile(const bf16_t* A, int lda, int brow, const LAS int* rowidx, const bf16_t* Bt, int K, LAS char* stage, const Epi& epi, bool pre, const Next& next) {
    f32x4 acc[2][2][4][2];
    gemm_tile_acc<GATHER, FP8, true>(A, lda, brow, rowidx, Bt, K, stage, epi, pre, next, acc);
}

DI bool unit_order(int i, int G, int c, int nM, int nN, int& pm, int& pn) {
    const int nwg = nM * nN; const long L = (long)i * G + c; if (L >= nwg) return false;
    int wgid = (int)L; { const int q = nwg / 8, r = nwg % 8, xcd = wgid % 8, off = wgid / 8; wgid = (xcd < r ? xcd * (q + 1) : r * (q + 1) + (xcd - r) * q) + off; }
    const int nig = 8 * nN, gid = wgid / nig, fm = gid * 8, gsz = (nM - fm) < 8 ? (nM - fm) : 8;
    pm = fm + ((wgid % nig) % gsz); pn = (wgid % nig) / gsz; return true;
}

#define EPI_LOOP(BODY) _Pragma("unroll") for (int ai = 0; ai < 2; ++ai) _Pragma("unroll") for (int m = 0; m < 4; ++m) { const int row = row0 + ai * 128 + m * 16; \
    _Pragma("unroll") for (int bj = 0; bj < 2; ++bj) _Pragma("unroll") for (int n = 0; n < 2; ++n) { const int col = col0 + bj * 128 + n * 16; f32x4 v = acc[ai][bj][m][n]; BODY } }

#define EPI_LOOP8(...) _Pragma("unroll") for (int ai = 0; ai < 2; ++ai) _Pragma("unroll") for (int m = 0; m < 4; ++m) { const int row = row0 + ai * 128 + m * 16; \
    _Pragma("unroll") for (int bj = 0; bj < 2; ++bj) { const int col = col0 + bj * 128; const f32x4 va = acc[ai][bj][m][0], vb = acc[ai][bj][m][1]; \
        float v[8] = {va[0], va[1], va[2], va[3], vb[0], vb[1], vb[2], vb[3]}; __VA_ARGS__ } }
struct EpiProj {
    static constexpr bool PERM = true;
    bf16_t* proj; const float* b_gate; int pm, pn; float sc; int ld, colsub;
    DI void operator()(f32x4 (&acc)[2][2][4][2], int wr, int wc, int fr, int fq) const {
        const int row0 = pm * 256 + wr * 64 + fr, col0 = pn * 256 + wc * 32 + fq * 8;
        const int kind = pn < 24 ? 0 : (pn < 32 ? 1 : (pn < 56 ? 0 : 2));
        EPI_LOOP8(
            v[0] *= sc; v[1] *= sc; v[2] *= sc; v[3] *= sc; v[4] *= sc; v[5] *= sc; v[6] *= sc; v[7] *= sc;
            if (kind == 1) { v[0] = siluf_(v[0]); v[1] = siluf_(v[1]); v[2] = siluf_(v[2]); v[3] = siluf_(v[3]); v[4] = siluf_(v[4]); v[5] = siluf_(v[5]); v[6] = siluf_(v[6]); v[7] = siluf_(v[7]); }
            if (kind == 2) { const f32x4 b0 = *(const f32x4*)(b_gate + (col - PC_GATE)), b1 = *(const f32x4*)(b_gate + (col - PC_GATE) + 4);
                v[0] = sigmoidf_(v[0] + b0[0]); v[1] = sigmoidf_(v[1] + b0[1]); v[2] = sigmoidf_(v[2] + b0[2]); v[3] = sigmoidf_(v[3] + b0[3]);
                v[4] = sigmoidf_(v[4] + b1[0]); v[5] = sigmoidf_(v[5] + b1[1]); v[6] = sigmoidf_(v[6] + b1[2]); v[7] = sigmoidf_(v[7] + b1[3]); }
            u32x4 w = {cvt_pk_bf16(v[0], v[1]), cvt_pk_bf16(v[2], v[3]), cvt_pk_bf16(v[4], v[5]), cvt_pk_bf16(v[6], v[7])};
            *(u32x4*)(proj + (size_t)row * ld + (col - colsub)) = w;
        )
    }
};
struct EpiScaleA {
    static constexpr bool PERM = true;
    const bf16_t* proj; int pm, pn;
    DI void operator()(f32x4 (&acc)[2][2][4][2], int wr, int wc, int fr, int fq) const {
        const int row0 = pm * 256 + wr * 64 + fr, col0 = pn * 256 + wc * 32 + fq * 8;
#pragma unroll
        for (int ai = 0; ai < 2; ++ai)
#pragma unroll
            for (int m = 0; m < 4; ++m) { const int row = row0 + ai * 128 + m * 16;
#pragma unroll
                for (int bj = 0; bj < 2; ++bj) { const int col = col0 + bj * 128;
                    const u32x4 ga = *(const u32x4*)(proj + (size_t)row * PROJ_LD + PC_GATE + col), gb = *(const u32x4*)(proj + (size_t)row * PROJ_LD + PC_GATE + 2048 + col);
                    f32x4 v0 = acc[ai][bj][m][0], v1 = acc[ai][bj][m][1];
                    v0[0] *= bflo(ga[0]) * __builtin_amdgcn_rcpf(fmaxf(bflo(gb[0]), 1e-18f)); v0[1] *= bfhi(ga[0]) * __builtin_amdgcn_rcpf(fmaxf(bfhi(gb[0]), 1e-18f));
                    v0[2] *= bflo(ga[1]) * __builtin_amdgcn_rcpf(fmaxf(bflo(gb[1]), 1e-18f)); v0[3] *= bfhi(ga[1]) * __builtin_amdgcn_rcpf(fmaxf(bfhi(gb[1]), 1e-18f));
                    v1[0] *= bflo(ga[2]) * __builtin_amdgcn_rcpf(fmaxf(bflo(gb[2]), 1e-18f)); v1[1] *= bfhi(ga[2]) * __builtin_amdgcn_rcpf(fmaxf(bfhi(gb[2]), 1e-18f));
                    v1[2] *= bflo(ga[3]) * __builtin_amdgcn_rcpf(fmaxf(bflo(gb[3]), 1e-18f)); v1[3] *= bfhi(ga[3]) * __builtin_amdgcn_rcpf(fmaxf(bfhi(gb[3]), 1e-18f));
                    acc[ai][bj][m][0] = v0; acc[ai][bj][m][1] = v1;
                } }
    }
};
struct EpiBranchB {
    static constexpr bool PERM = true;
    const bf16_t* proj; bf16_t* mrg; int pm, pn;
    DI void operator()(f32x4 (&acc)[2][2][4][2], int wr, int wc, int fr, int fq) const {
        const int row0 = pm * 256 + wr * 64 + fr, col0 = pn * 256 + wc * 32 + fq * 8;
        EPI_LOOP8(
            const u32x4 g = *(const u32x4*)(proj + (size_t)row * PROJ_LD + PC_GATE + 2048 + col);
            v[0] *= bflo(g[0]); v[1] *= bfhi(g[0]); v[2] *= bflo(g[1]); v[3] *= bfhi(g[1]); v[4] *= bflo(g[2]); v[5] *= bfhi(g[2]); v[6] *= bflo(g[3]); v[7] *= bfhi(g[3]);
            u32x4 w = {cvt_pk_bf16(v[0], v[1]), cvt_pk_bf16(v[2], v[3]), cvt_pk_bf16(v[4], v[5]), cvt_pk_bf16(v[6], v[7])};
            *(u32x4*)(mrg + (size_t)row * DM + col) = w;
        )
    }
};
struct EpiOut {
    static constexpr bool PERM = false;
    const float* x; float* out; int pm, pn;
    DI void operator()(f32x4 (&acc)[2][2][4][2], int wr, int wc, int fr, int fq) const {
        const int row0 = pm * 256 + wr * 64 + fr, col0 = pn * 256 + wc * 32 + fq * 4;
        EPI_LOOP(
            const f32x4 t = *(const f32x4*)(x + (size_t)row * DM + col);
            v += t;
            *(f32x4*)(out + (size_t)row * DM + col) = v;
        )
    }
};
struct EpiGateUp {
    static constexpr bool PERM = true;
    unsigned char* act; const float* bias; int slot0, nt;
    DI void operator()(f32x4 (&acc)[2][2][4][2], int wr, int wc, int fr, int fq) const {
        const int row0 = slot0 + wr * 64 + fr, col = nt * 128 + wc * 32 + fq * 8;
        constexpr float isc = 1.f / (W8_SCALE * H8_SCALE);
        const f32x4 bg0 = *(const f32x4*)(bias + col), bg1 = *(const f32x4*)(bias + col + 4), bu0 = *(const f32x4*)(bias + 2048 + col), bu1 = *(const f32x4*)(bias + 2048 + col + 4);
#pragma unroll
        for (int ai = 0; ai < 2; ++ai)
#pragma unroll
            for (int m = 0; m < 4; ++m) {
                const int row = row0 + ai * 128 + m * 16;
                const f32x4 g0 = acc[ai][0][m][0] * isc + bg0, g1 = acc[ai][0][m][1] * isc + bg1, u0 = acc[ai][1][m][0] * isc + bu0, u1 = acc[ai][1][m][1] * isc + bu1;
                float r[8];
#pragma unroll
                for (int j = 0; j < 4; ++j) {
                    const float ga = fminf(g0[j], 7.f), ua = fminf(fmaxf(u0[j], -7.f), 7.f); r[j] = (ua + 1.f) * ga * sigmoidf_(1.702f * ga) * A8_SCALE;
                    const float gb = fminf(g1[j], 7.f), ub = fminf(fmaxf(u1[j], -7.f), 7.f); r[4 + j] = (ub + 1.f) * gb * sigmoidf_(1.702f * gb) * A8_SCALE;
                }
                u32x2 w; w[0] = cvt4_fp8(r[0], r[1], r[2], r[3]); w[1] = cvt4_fp8(r[4], r[5], r[6], r[7]);
                *(u32x2*)(act + (size_t)row * DM + col) = w;
            }
    }
};
struct EpiDown {
    static constexpr bool PERM = true;
    unsigned char* ys; const float* bias; const float* wrow; int slot0, pn;
    DI void operator()(f32x4 (&acc)[2][2][4][2], int wr, int wc, int fr, int fq) const {
        const int r0 = wr * 64 + fr, col0 = pn * 256 + wc * 32 + fq * 8;
        constexpr float isc = 1.f / (W8_SCALE * A8_SCALE);
#pragma unroll
        for (int bj = 0; bj < 2; ++bj) {
            const int col = col0 + bj * 128;
            const f32x4 b0 = *(const f32x4*)(bias + col), b1 = *(const f32x4*)(bias + col + 4);
#pragma unroll
            for (int ai = 0; ai < 2; ++ai)
#pragma unroll
                for (int m = 0; m < 4; ++m) {
                    const int r = r0 + ai * 128 + m * 16; const float w8 = wrow[r] * Y8_SCALE;
                    const f32x4 v0 = (acc[ai][bj][m][0] * isc + b0) * w8, v1 = (acc[ai][bj][m][1] * isc + b1) * w8;
                    u32x2 w = {cvt4_fp8(v0[0], v0[1], v0[2], v0[3]), cvt4_fp8(v1[0], v1[1], v1[2], v1[3])};
                    *(u32x2*)(ys + (size_t)(slot0 + r) * DM + col) = w;
                }
        }
    }
};

DI void p1_inproj(const Params& p, LAS char* lds) {
    const int tid = threadIdx.x, lane = tid & 63, wave = tid >> 6;
    const bf16_t* h = (const bf16_t*)(p.ws + WS_H);
    {
        const bf16_t* wsl = (const bf16_t*)(p.ws + WS_WS); float* ba = (float*)(p.ws + WS_BA);
        const int l15 = lane & 15, l4 = lane >> 4;
        for (int task = blockIdx.x * 8 + wave; task < NTOK / 16; task += gridDim.x * 8) {
            f32x4 a0 = {0.f, 0.f, 0.f, 0.f}, a1 = {0.f, 0.f, 0.f, 0.f};
            const bf16_t* ar = h + (size_t)(task * 16 + l15) * DM + l4 * 8;
            const bf16_t* b0 = wsl + (size_t)l15 * DM + l4 * 8; const bf16_t* b1 = b0 + 16 * DM;
#pragma unroll 8
            for (int k0 = 0; k0 < DM; k0 += 32) {
                const bf16x8 a = *(const bf16x8*)(ar + k0);
                a0 = MFMA16(a, *(const bf16x8*)(b0 + k0), a0); a1 = MFMA16(a, *(const bf16x8*)(b1 + k0), a1);
            }
#pragma unroll
            for (int r = 0; r < 4; ++r) { float* o = ba + (size_t)(task * 16 + l4 * 4 + r) * 32 + l15; o[0] = a0[r]; o[16] = a1[r]; }
        }
    }
    const bf16_t* win = (const bf16_t*)(p.ws + WS_WIN);
    const bf16_t* h8 = (const bf16_t*)(p.ws + WS_H8); const unsigned char* win8 = p.ws + WS_WIN8;
    int pm, pn; bool have = unit_order(0, gridDim.x, blockIdx.x, 64, 72, pm, pn), pre = false;
    for (int i = 0; have; ++i) {
        int pm2, pn2; const bool have2 = unit_order(i + 1, gridDim.x, blockIdx.x, 64, 72, pm2, pn2);
        const bool f8 = pn >= 56 || (pn >= 24 && pn < 32), f82 = pn2 >= 56 || (pn2 >= 24 && pn2 < 32);
        const int r8 = pn >= 56 ? (pn - 56) * 256 : 4096 + (pn - 24) * 256, r82 = pn2 >= 56 ? (pn2 - 56) * 256 : 4096 + (pn2 - 24) * 256;
        const bool isv = pn >= 48 && pn < 56;
        EpiProj e{(bf16_t*)(p.ws + (isv ? WS_VBUF : WS_PROJ)), p.b_gate, pm, pn, f8 ? 1.f / (W8_SCALE * H8_SCALE) : 1.f, isv ? DM : PROJ_LD, isv ? PC_VB : 0};
        auto next = [&]() { if (have2) { if (f82) gemm_issue<false, true>(h8, DM / 2, pm2 * 256, (const LAS int*)nullptr, (const bf16_t*)(win8 + (size_t)r82 * DM), DM / 2, lds + LDS_MISC);
                                         else gemm_issue<false, true>(h, DM, pm2 * 256, (const LAS int*)nullptr, win + (size_t)pn2 * 256 * DM, DM, lds + LDS_MISC); } };
        if (f8) gemm_tile<false, true>(h8, DM / 2, pm * 256, (const LAS int*)nullptr, (const bf16_t*)(win8 + (size_t)r8 * DM), DM / 2, lds + LDS_MISC, e, pre, next);
        else gemm_tile<false, false>(h, DM, pm * 256, (const LAS int*)nullptr, win + (size_t)pn * 256 * DM, DM, lds + LDS_MISC, e, pre, next);
        pre = have2; have = have2; pm = pm2; pn = pn2;
    }
}

DI void p4_branches(const Params& p, LAS char* lds) {
    const bf16_t* oa = (const bf16_t*)(p.ws + WS_OA); const bf16_t* ob = (const bf16_t*)(p.ws + WS_OB);
    const bf16_t* wa = (const bf16_t*)(p.ws + WS_WA); const bf16_t* wb = (const bf16_t*)(p.ws + WS_WB);
    int pm, pn; bool have = unit_order(0, gridDim.x, blockIdx.x, 64, 8, pm, pn), pre = false;
    for (int i = 0; have; ++i) {
        int pm2, pn2; const bool have2 = unit_order(i + 1, gridDim.x, blockIdx.x, 64, 8, pm2, pn2);
        EpiScaleA ea{(const bf16_t*)(p.ws + WS_PROJ), pm, pn};
        EpiBranchB eb{(const bf16_t*)(p.ws + WS_PROJ), (bf16_t*)(p.ws + WS_MRG), pm, pn};
        auto next = [&]() { if (have2) gemm_issue<false, true>(oa, DM, pm2 * 256, (const LAS int*)nullptr, wa + (size_t)pn2 * 256 * DM, DM, lds + LDS_MISC); };
        gemm_tile_dual(oa, ob, DM, pm * 256, wa + (size_t)pn * 256 * DM, wb + (size_t)pn * 256 * DM, DM, lds + LDS_MISC, eb, ea, pre, next);
        pre = have2; have = have2; pm = pm2; pn = pn2;
    }
}
DI void p5_outproj(const Params& p, LAS char* lds) {
    const bf16_t* mg = (const bf16_t*)(p.ws + WS_MRG); const bf16_t* wo = (const bf16_t*)(p.ws + WS_WO);
    int pm, pn; bool have = unit_order(0, gridDim.x, blockIdx.x, 64, 8, pm, pn), pre = false;
    for (int i = 0; have; ++i) {
        int pm2, pn2; const bool have2 = unit_order(i + 1, gridDim.x, blockIdx.x, 64, 8, pm2, pn2);
        EpiOut e{p.x, p.out, pm, pn};
        auto next = [&]() { if (have2) gemm_issue<false, false>(mg, DM, pm2 * 256, (const LAS int*)nullptr, wo + (size_t)pn2 * 256 * DM, DM, lds + LDS_MISC); };
        gemm_tile<false, false>(mg, DM, pm * 256, (const LAS int*)nullptr, wo + (size_t)pn * 256 * DM, DM, lds + LDS_MISC, e, pre, next);
        pre = have2; have = have2; pm = pm2; pn = pn2;
    }
}

constexpr int GP_SC = 0, GP_Q = 1024, GP_K = GP_Q + 17408, GP_VBT = GP_K + 17408, GP_KBGT = GP_VBT + 18432, GP_L = GP_KBGT + 18432, GP_T = GP_L + 17408;
DI bf16x8 ld_frag(const LAS char* p) { return *(const LAS bf16x8*)p; }

DI void gdn_prep_unit(const Params& p, LAS char* st, int u) {
    const int tid = threadIdx.x, lane = tid & 63, wave = tid >> 6, l15 = lane & 15, l4 = lane >> 4;
    const int bh = u >> 6, n = u & 63, b = bh >> 4, hh = bh & 15;
    const int row_base = b * SEQ + n * 64;
    LAS float* sc = (LAS float*)(st + GP_SC);
    const bf16_t* proj = (const bf16_t*)(p.ws + WS_PROJ);
    if (wave == 0) {
        const float* ba = (const float*)(p.ws + WS_BA) + (size_t)(row_base + lane) * 32;
        const float braw = ba[hh], araw = ba[16 + hh] + p.dt_bias[hh];
        const float sp = fmaxf(araw, 0.f) + log1pf(__expf(-fabsf(araw)));
        const float g = -__expf(p.a_log[hh]) * sp;
        float c = g;
#pragma unroll
        for (int o = 1; o < 64; o <<= 1) { const float t = __shfl_up(c, o); if (lane >= o) c += t; }
        const float gl = __shfl(c, 63);
        sc[lane] = c; sc[64 + lane] = sigmoidf_(braw); sc[128 + lane] = __expf(c); sc[192 + lane] = __expf(gl - c);
        if (lane == 0) ((float*)(p.ws + WS_GL))[u] = __expf(gl);
    }
    float o[8][8]; int seg = 0, part = 0, ch0 = 0;
    if (tid < 384) {
        seg = tid / 48; const int rem = tid % 48; part = rem >> 4; ch0 = (rem & 15) * 8;
        const int colb = PC_QKV + part * 2048 + hh * 128 + ch0;
        const bf16_t* src = proj + (size_t)(row_base + seg * 8) * PROJ_LD + colb;
        bf16x8 raw[11];
#pragma unroll
        for (int r = 0; r < 11; ++r) {
            raw[r] = (bf16x8){0, 0, 0, 0, 0, 0, 0, 0};
            if (!(n == 0 && seg == 0 && r < 3)) raw[r] = *(const bf16x8*)(src + (ptrdiff_t)(r - 3) * PROJ_LD);
        }
        float w[4][8];
#pragma unroll
        for (int j = 0; j < 4; ++j) {
            const f32x4 w0 = *(const f32x4*)(p.conv_w + j * 6144 + colb), w1 = *(const f32x4*)(p.conv_w + j * 6144 + colb + 4);
            w[j][0] = w0[0]; w[j][1] = w0[1]; w[j][2] = w0[2]; w[j][3] = w0[3]; w[j][4] = w1[0]; w[j][5] = w1[1]; w[j][6] = w1[2]; w[j][7] = w1[3];
        }
#pragma unroll
        for (int t = 0; t < 8; ++t)
#pragma unroll
            for (int c = 0; c < 8; ++c) {
                float a = 0.f;
#pragma unroll
                for (int j = 0; j < 4; ++j) a += bf2f((unsigned short)raw[t + j][c]) * w[j][c];
                o[t][c] = siluf_(a);
            }
    }
    __syncthreads();
    if (tid < 384) {
        const bf16_t* dummy = nullptr; (void)dummy;
        float rinv[8];
        if (part < 2) {
#pragma unroll
            for (int t = 0; t < 8; ++t) {
                float ss = 0.f;
#pragma unroll
                for (int c = 0; c < 8; ++c) ss += o[t][c] * o[t][c];
                ss += __shfl_xor(ss, 1); ss += __shfl_xor(ss, 2); ss += __shfl_xor(ss, 4); ss += __shfl_xor(ss, 8);
                rinv[t] = rsqrtf(ss + NORM_EPS);
            }
        }
        if (part == 0) {
            bf16_t* qg = (bf16_t*)(p.ws + WS_QG) + (size_t)u * 8192;
#pragma unroll
            for (int t = 0; t < 8; ++t) {
                const int tok = seg * 8 + t; const float s = rinv[t] * 0.08838834764831845f, eg = sc[128 + tok];
                float q[8];
#pragma unroll
                for (int c = 0; c < 8; ++c) q[c] = o[t][c] * s;
                u32x4 w = {cvt_pk_bf16(q[0], q[1]), cvt_pk_bf16(q[2], q[3]), cvt_pk_bf16(q[4], q[5]), cvt_pk_bf16(q[6], q[7])};
                *(LAS u32x4*)(st + GP_Q + tok * 272 + ch0 * 2) = w;
                u32x4 w2 = {cvt_pk_bf16(q[0] * eg, q[1] * eg), cvt_pk_bf16(q[2] * eg, q[3] * eg), cvt_pk_bf16(q[4] * eg, q[5] * eg), cvt_pk_bf16(q[6] * eg, q[7] * eg)};
                *(u32x4*)(qg + tok * 128 + ch0) = w2;
            }
        } else if (part == 1) {
            bf16_t* kdt = (bf16_t*)(p.ws + WS_KDT) + (size_t)u * 8192;
            float be[8], ed[8];
#pragma unroll
            for (int t = 0; t < 8; ++t) { const int tok = seg * 8 + t; be[t] = sc[64 + tok] * sc[128 + tok]; ed[t] = sc[192 + tok]; }
#pragma unroll
            for (int t = 0; t < 8; ++t) {
                const int tok = seg * 8 + t;
#pragma unroll
                for (int c = 0; c < 8; ++c) o[t][c] *= rinv[t];
                u32x4 w = {cvt_pk_bf16(o[t][0], o[t][1]), cvt_pk_bf16(o[t][2], o[t][3]), cvt_pk_bf16(o[t][4], o[t][5]), cvt_pk_bf16(o[t][6], o[t][7])};
                *(LAS u32x4*)(st + GP_K + tok * 272 + ch0 * 2) = w;
            }
#pragma unroll
            for (int c = 0; c < 8; ++c) {
                u32x4 w = {cvt_pk_bf16(o[0][c] * be[0], o[1][c] * be[1]), cvt_pk_bf16(o[2][c] * be[2], o[3][c] * be[3]), cvt_pk_bf16(o[4][c] * be[4], o[5][c] * be[5]), cvt_pk_bf16(o[6][c] * be[6], o[7][c] * be[7])};
                *(LAS u32x4*)(st + GP_KBGT + (ch0 + c) * 144 + seg * 16) = w;
                u32x4 w2 = {cvt_pk_bf16(o[0][c] * ed[0], o[1][c] * ed[1]), cvt_pk_bf16(o[2][c] * ed[2], o[3][c] * ed[3]), cvt_pk_bf16(o[4][c] * ed[4], o[5][c] * ed[5]), cvt_pk_bf16(o[6][c] * ed[6], o[7][c] * ed[7])};
                *(u32x4*)(kdt + (ch0 + c) * 64 + seg * 8) = w2;
            }
        } else {
            float be[8];
#pragma unroll
            for (int t = 0; t < 8; ++t) be[t] = sc[64 + seg * 8 + t];
#pragma unroll
            for (int c = 0; c < 8; ++c) {
                u32x4 w = {cvt_pk_bf16(o[0][c] * be[0], o[1][c] * be[1]), cvt_pk_bf16(o[2][c] * be[2], o[3][c] * be[3]), cvt_pk_bf16(o[4][c] * be[4], o[5][c] * be[5]), cvt_pk_bf16(o[6][c] * be[6], o[7][c] * be[7])};
                *(LAS u32x4*)(st + GP_VBT + (ch0 + c) * 144 + seg * 16) = w;
            }
        }
    }
    __syncthreads();
    {
        const int mi = wave >> 1; bf16_t* qkg = (bf16_t*)(p.ws + WS_QK) + (size_t)u * 4096;
#pragma unroll
        for (int jj = 0; jj < 2; ++jj) {
            const int nj = (wave & 1) * 2 + jj;
            const int i = mi * 16 + l15, j0 = nj * 16 + l4 * 4;
            if (nj > mi) { *(u32x2*)(qkg + i * 64 + j0) = (u32x2){0u, 0u}; continue; }
            f32x4 aK = {0.f, 0.f, 0.f, 0.f}, aQ = {0.f, 0.f, 0.f, 0.f};
#pragma unroll
            for (int ks = 0; ks < 4; ++ks) {
                const int kb = (ks * 32 + l4 * 8) * 2;
                const bf16x8 kfj = ld_frag(st + GP_K + (nj * 16 + l15) * 272 + kb), kfi = ld_frag(st + GP_K + (mi * 16 + l15) * 272 + kb), qfi = ld_frag(st + GP_Q + (mi * 16 + l15) * 272 + kb);
                aK = MFMA16(kfj, kfi, aK); aQ = MFMA16(kfj, qfi, aQ);
            }
            const float gi = sc[i], bi = sc[64 + i]; f32x4 lv; float qv[4];
#pragma unroll
            for (int r = 0; r < 4; ++r) {
                const int j = j0 + r; const float d = gi - sc[j];
                const float dec = (i >= j) ? __expf(d) : 0.f;
                lv[r] = (i > j) ? bi * aK[r] * dec : 0.f; qv[r] = aQ[r] * dec;
            }
            *(LAS f32x4*)(st + GP_L + (i * 68 + j0) * 4) = lv;
            u32x2 w; w[0] = cvt_pk_bf16(qv[0], qv[1]); w[1] = cvt_pk_bf16(qv[2], qv[3]);
            *(u32x2*)(qkg + i * 64 + j0) = w;
        }
    }
    __syncthreads();
    if (wave == 0) {
        int ln = lane, lz = 0; asm volatile("" : "+v"(ln), "+v"(lz));
        const LAS char* Lb = st + GP_L + (lz & ~15);
        float t[64];
#pragma unroll
        for (int i = 0; i < 64; ++i) t[i] = 0.f;
        t[0] = (ln == 0) ? 1.f : 0.f;
        f32x4 row[2][16];
        row[1][0] = *(const LAS f32x4*)(Lb + 1 * 272);
#pragma unroll
        for (int i = 1; i < 64; ++i) {
            if (i + 1 < 64) {
#pragma unroll
                for (int q = 0; q < (i + 4) / 4; ++q) row[(i + 1) & 1][q] = *(const LAS f32x4*)(Lb + (i + 1) * 272 + q * 16);
            }
            f32x2 s0 = {0.f, 0.f}, s1 = {0.f, 0.f};
#pragma unroll
            for (int q = 0; q < (i + 3) / 4; ++q) {
                const f32x4 l = row[i & 1][q];
                s0 += (f32x2){l[0], l[1]} * (f32x2){t[4 * q], t[4 * q + 1]};
                s1 += (f32x2){l[2], l[3]} * (f32x2){t[4 * q + 2], t[4 * q + 3]};
            }
            t[i] = ((ln == i) ? 1.f : 0.f) - ((s0[0] + s0[1]) + (s1[0] + s1[1]));
        }
        LAS bf16_t* T = (LAS bf16_t*)(st + GP_T);
#pragma unroll
        for (int i = 0; i < 64; ++i) T[i * 72 + lane] = (bf16_t)(cvt_pk_bf16(t[i], 0.f) & 0xffffu);
    }
    __syncthreads();
    {
        bf16x8 tf[4][2];
#pragma unroll
        for (int mi = 0; mi < 4; ++mi)
#pragma unroll
            for (int ks = 0; ks < 2; ++ks) tf[mi][ks] = ld_frag(st + GP_T + (mi * 16 + l15) * 144 + (ks * 32 + l4 * 8) * 2);
        bf16x8 vf[2], kf[2];
#pragma unroll
        for (int ks = 0; ks < 2; ++ks) { vf[ks] = ld_frag(st + GP_VBT + (wave * 16 + l15) * 144 + (ks * 32 + l4 * 8) * 2); kf[ks] = ld_frag(st + GP_KBGT + (wave * 16 + l15) * 144 + (ks * 32 + l4 * 8) * 2); }
        bf16_t* ut = (bf16_t*)(p.ws + WS_UT) + (size_t)u * 8192; bf16_t* nw = (bf16_t*)(p.ws + WS_NEGW) + (size_t)u * 8192;
#pragma unroll
        for (int mi = 0; mi < 4; ++mi) {
            f32x4 au = {0.f, 0.f, 0.f, 0.f}, aw = {0.f, 0.f, 0.f, 0.f};
#pragma unroll
            for (int ks = 0; ks < 2; ++ks) { au = MFMA16(tf[mi][ks], vf[ks], au); aw = MFMA16(kf[ks], tf[mi][ks], aw); }
            u32x2 w; w[0] = cvt_pk_bf16(au[0], au[1]); w[1] = cvt_pk_bf16(au[2], au[3]);
            *(u32x2*)(ut + (wave * 16 + l15) * 64 + mi * 16 + l4 * 4) = w;
            u32x2 w2; w2[0] = cvt_pk_bf16(-aw[0], -aw[1]); w2[1] = cvt_pk_bf16(-aw[2], -aw[3]);
            *(u32x2*)(nw + (mi * 16 + l15) * 128 + wave * 16 + l4 * 4) = w2;
        }
    }
    __syncthreads();
}

constexpr int GH_SC = 0, GH_Q = 1024, GH_K = GH_Q + 18432, GH_L = GH_K + 17408, GH_X = GH_L + 17408, GH_T = GH_K, GH_VBT = GH_Q, GH_BYTES = GH_X + 18432;

DI void gdn_prep_pair(const Params& p, LAS char* st0, int pair) {
    int tid_ = threadIdx.x; asm volatile("" : "+v"(tid_));
    const int tid = tid_, lane = tid & 63, wave = __builtin_amdgcn_readfirstlane(tid >> 6), l15 = lane & 15, l4 = lane >> 4;
    const int hs = wave >> 2, hw = wave & 3, htid = tid & 255;
    LAS char* st = st0 + hs * GH_BYTES;
    const int u = pair * 2 + hs;
    const int bh = u >> 6, n = u & 63, b = bh >> 4, hh = bh & 15;
    const int row_base = b * SEQ + n * 64;
    LAS float* sc = (LAS float*)(st + GH_SC);
    const bf16_t* proj = (const bf16_t*)(p.ws + WS_PROJ);
#define GP_LOAD(raw, w, seg, part, ch0) do { const int colb_ = PC_QKV + (part) * 2048 + hh * 128 + (ch0); \
        const bf16_t* src_ = proj + (size_t)(row_base + (seg) * 8) * PROJ_LD + colb_; \
        _Pragma("unroll") for (int r = 0; r < 11; ++r) { raw[r] = (bf16x8){0, 0, 0, 0, 0, 0, 0, 0}; if (!(n == 0 && (seg) == 0 && r < 3)) raw[r] = *(const bf16x8*)(src_ + (ptrdiff_t)(r - 3) * PROJ_LD); } \
        _Pragma("unroll") for (int j = 0; j < 4; ++j) { const f32x4 a_ = *(const f32x4*)(p.conv_w + j * 6144 + colb_), b_ = *(const f32x4*)(p.conv_w + j * 6144 + colb_ + 4); \
            w[j][0] = a_[0]; w[j][1] = a_[1]; w[j][2] = a_[2]; w[j][3] = a_[3]; w[j][4] = b_[0]; w[j][5] = b_[1]; w[j][6] = b_[2]; w[j][7] = b_[3]; } } while (0)
#define GP_CONV(raw, w, o) do { _Pragma("unroll") for (int t = 0; t < 8; ++t) _Pragma("unroll") for (int c = 0; c < 8; ++c) { float a = 0.f; \
            _Pragma("unroll") for (int j = 0; j < 4; ++j) a += bf2f((unsigned short)raw[t + j][c]) * w[j][c]; o[t][c] = siluf_(a); } } while (0)
    const int seg0 = htid >> 5, part0 = (htid >> 4) & 1, ch00 = (htid & 15) * 8;
    bf16x8 raw0[11]; float w0[4][8];
    GP_LOAD(raw0, w0, seg0, part0, ch00);
    if (hw == 0) {
        const float* ba = (const float*)(p.ws + WS_BA) + (size_t)(row_base + lane) * 32;
        const float braw = ba[hh], araw = ba[16 + hh] + p.dt_bias[hh];
        const float sp = fmaxf(araw, 0.f) + log1pf(__expf(-fabsf(araw)));
        const float g = -__expf(p.a_log[hh]) * sp;
        float c = g;
#pragma unroll
        for (int o = 1; o < 64; o <<= 1) { const float t = __shfl_up(c, o); if (lane >= o) c += t; }
        const float gl = __shfl(c, 63);
        sc[lane] = c; sc[64 + lane] = sigmoidf_(braw); sc[128 + lane] = __expf(c); sc[192 + lane] = __expf(gl - c);
        if (lane == 0) ((float*)(p.ws + WS_GL))[u] = __expf(gl);
    }
    LDS_BAR();
    {
        float o[8][8]; GP_CONV(raw0, w0, o);
        float rinv[8];
#pragma unroll
        for (int t = 0; t < 8; ++t) { float ss = 0.f;
#pragma unroll
            for (int c = 0; c < 8; ++c) ss += o[t][c] * o[t][c];
            ss += __shfl_xor(ss, 1); ss += __shfl_xor(ss, 2); ss += __shfl_xor(ss, 4); ss += __shfl_xor(ss, 8); rinv[t] = rsqrtf(ss + NORM_EPS); }
        if (part0 == 0) { bf16_t* qg = (bf16_t*)(p.ws + WS_QG) + (size_t)u * 8192;
#pragma unroll
            for (int t = 0; t < 8; ++t) { const int tok = seg0 * 8 + t; const float s_ = rinv[t] * 0.08838834764831845f, eg = sc[128 + tok]; float q[8];
#pragma unroll
                for (int c = 0; c < 8; ++c) q[c] = o[t][c] * s_;
                u32x4 x1 = {cvt_pk_bf16(q[0], q[1]), cvt_pk_bf16(q[2], q[3]), cvt_pk_bf16(q[4], q[5]), cvt_pk_bf16(q[6], q[7])};
                *(LAS u32x4*)(st + GH_Q + tok * 272 + ch00 * 2) = x1;
                u32x4 x2 = {cvt_pk_bf16(q[0] * eg, q[1] * eg), cvt_pk_bf16(q[2] * eg, q[3] * eg), cvt_pk_bf16(q[4] * eg, q[5] * eg), cvt_pk_bf16(q[6] * eg, q[7] * eg)};
                *(u32x4*)(qg + tok * 128 + ch00) = x2; }
        } else { bf16_t* kdt = (bf16_t*)(p.ws + WS_KDT) + (size_t)u * 8192; float be[8], ed[8];
#pragma unroll
            for (int t = 0; t < 8; ++t) { const int tok = seg0 * 8 + t; be[t] = sc[64 + tok] * sc[128 + tok]; ed[t] = sc[192 + tok]; }
#pragma unroll
            for (int t = 0; t < 8; ++t) { const int tok = seg0 * 8 + t;
#pragma unroll
                for (int c = 0; c < 8; ++c) o[t][c] *= rinv[t];
                u32x4 x1 = {cvt_pk_bf16(o[t][0], o[t][1]), cvt_pk_bf16(o[t][2], o[t][3]), cvt_pk_bf16(o[t][4], o[t][5]), cvt_pk_bf16(o[t][6], o[t][7])};
                *(LAS u32x4*)(st + GH_K + tok * 272 + ch00 * 2) = x1; }
#pragma unroll
            for (int c = 0; c < 8; ++c) {
                u32x4 x1 = {cvt_pk_bf16(o[0][c] * be[0], o[1][c] * be[1]), cvt_pk_bf16(o[2][c] * be[2], o[3][c] * be[3]), cvt_pk_bf16(o[4][c] * be[4], o[5][c] * be[5]), cvt_pk_bf16(o[6][c] * be[6], o[7][c] * be[7])};
                *(LAS u32x4*)(st + GH_X + (ch00 + c) * 144 + seg0 * 16) = x1;
                u32x4 x2 = {cvt_pk_bf16(o[0][c] * ed[0], o[1][c] * ed[1]), cvt_pk_bf16(o[2][c] * ed[2], o[3][c] * ed[3]), cvt_pk_bf16(o[4][c] * ed[4], o[5][c] * ed[5]), cvt_pk_bf16(o[6][c] * ed[6], o[7][c] * ed[7])};
                *(u32x4*)(kdt + (ch00 + c) * 64 + seg0 * 8) = x2; }
        }
    }
    LDS_BAR();
    {
        bf16_t* qkg = (bf16_t*)(p.ws + WS_QK) + (size_t)u * 4096;
#pragma unroll
        for (int mi = 0; mi < 4; ++mi)
#pragma unroll
            for (int nj = 0; nj < 4; ++nj) {
                if (((mi + nj) & 3) != hw) continue;
                const int i = mi * 16 + l15, j0 = nj * 16 + l4 * 4;
                if (nj > mi) { *(u32x2*)(qkg + i * 64 + j0) = (u32x2){0u, 0u}; continue; }
                f32x4 aK = {0.f, 0.f, 0.f, 0.f}, aQ = {0.f, 0.f, 0.f, 0.f};
#pragma unroll
                for (int ks = 0; ks < 4; ++ks) {
                    const int kb = (ks * 32 + l4 * 8) * 2;
                    const bf16x8 kfj = ld_frag(st + GH_K + (nj * 16 + l15) * 272 + kb), kfi = ld_frag(st + GH_K + (mi * 16 + l15) * 272 + kb), qfi = ld_frag(st + GH_Q + (mi * 16 + l15) * 272 + kb);
                    aK = MFMA16(kfj, kfi, aK); aQ = MFMA16(kfj, qfi, aQ);
                }
                const float gi = sc[i], bi = sc[64 + i]; f32x4 lv; float qv[4];
#pragma unroll
                for (int r = 0; r < 4; ++r) {
                    const int j = j0 + r; const float d = gi - sc[j];
                    const float dec = (i >= j) ? __expf(d) : 0.f;
                    lv[r] = (i > j) ? bi * aK[r] * dec : 0.f; qv[r] = aQ[r] * dec;
                }
                *(LAS f32x4*)(st + GH_L + (i * 68 + j0) * 4) = lv;
                u32x2 w; w[0] = cvt_pk_bf16(qv[0], qv[1]); w[1] = cvt_pk_bf16(qv[2], qv[3]);
                *(u32x2*)(qkg + i * 64 + j0) = w;
            }
    }
    LDS_BAR();
    if (hw == hs) {
        int ln = lane, lz = 0; asm volatile("" : "+v"(ln), "+v"(lz));
        const LAS char* Lb = st + GH_L + (lz & ~15);
        float t[64];
#pragma unroll
        for (int i = 0; i < 64; ++i) t[i] = 0.f;
        t[0] = (ln == 0) ? 1.f : 0.f;
        f32x4 row[2][16];
        row[1][0] = *(const LAS f32x4*)(Lb + 1 * 272);
#pragma unroll
        for (int i = 1; i < 64; ++i) {
            if (i + 1 < 64) {
#pragma unroll
                for (int q = 0; q < (i + 4) / 4; ++q) row[(i + 1) & 1][q] = *(const LAS f32x4*)(Lb + (i + 1) * 272 + q * 16);
            }
            f32x2 s0 = {0.f, 0.f}, s1 = {0.f, 0.f};
#pragma unroll
            for (int q = 0; q < (i + 3) / 4; ++q) {
                const f32x4 l = row[i & 1][q];
                s0 += (f32x2){l[0], l[1]} * (f32x2){t[4 * q], t[4 * q + 1]};
                s1 += (f32x2){l[2], l[3]} * (f32x2){t[4 * q + 2], t[4 * q + 3]};
            }
            t[i] = ((ln == i) ? 1.f : 0.f) - ((s0[0] + s0[1]) + (s1[0] + s1[1]));
        }
        LAS bf16_t* T = (LAS bf16_t*)(st + GH_T);
#pragma unroll
        for (int i = 0; i < 64; ++i) T[i * 72 + lane] = (bf16_t)(cvt_pk_bf16(t[i], 0.f) & 0xffffu);
    } else if (hw >= 2) {
        const int vt = htid - 128, segv = vt >> 4, chv = (vt & 15) * 8;
        bf16x8 rawv[11]; float wv_[4][8];
        GP_LOAD(rawv, wv_, segv, 2, chv);
        float o[8][8]; GP_CONV(rawv, wv_, o);
        float be[8];
#pragma unroll
        for (int t = 0; t < 8; ++t) be[t] = sc[64 + segv * 8 + t];
#pragma unroll
        for (int c = 0; c < 8; ++c) {
            u32x4 x1 = {cvt_pk_bf16(o[0][c] * be[0], o[1][c] * be[1]), cvt_pk_bf16(o[2][c] * be[2], o[3][c] * be[3]), cvt_pk_bf16(o[4][c] * be[4], o[5][c] * be[5]), cvt_pk_bf16(o[6][c] * be[6], o[7][c] * be[7])};
            *(LAS u32x4*)(st + GH_VBT + (chv + c) * 144 + segv * 16) = x1; }
    }
    LDS_BAR();
#undef GP_LOAD
#undef GP_CONV
    {
        bf16x8 tf[4][2];
#pragma unroll
        for (int mi = 0; mi < 4; ++mi)
#pragma unroll
            for (int ks = 0; ks < 2; ++ks) tf[mi][ks] = ld_frag(st + GH_T + (mi * 16 + l15) * 144 + (ks * 32 + l4 * 8) * 2);
        bf16_t* ut = (bf16_t*)(p.ws + WS_UT) + (size_t)u * 8192; bf16_t* nw = (bf16_t*)(p.ws + WS_NEGW) + (size_t)u * 8192;
#pragma unroll
        for (int q = 0; q < 2; ++q) {
            const int nv = hw + 4 * q;
            bf16x8 vf[2], kf[2];
#pragma unroll
            for (int ks = 0; ks < 2; ++ks) { vf[ks] = ld_frag(st + GH_VBT + (nv * 16 + l15) * 144 + (ks * 32 + l4 * 8) * 2); kf[ks] = ld_frag(st + GH_X + (nv * 16 + l15) * 144 + (ks * 32 + l4 * 8) * 2); }
#pragma unroll
            for (int mi = 0; mi < 4; ++mi) {
                f32x4 au = {0.f, 0.f, 0.f, 0.f}, aw = {0.f, 0.f, 0.f, 0.f};
#pragma unroll
                for (int ks = 0; ks < 2; ++ks) { au = MFMA16(tf[mi][ks], vf[ks], au); aw = MFMA16(kf[ks], tf[mi][ks], aw); }
                u32x2 w; w[0] = cvt_pk_bf16(au[0], au[1]); w[1] = cvt_pk_bf16(au[2], au[3]);
                *(u32x2*)(ut + (nv * 16 + l15) * 64 + mi * 16 + l4 * 4) = w;
                u32x2 w2; w2[0] = cvt_pk_bf16(-aw[0], -aw[1]); w2[1] = cvt_pk_bf16(-aw[2], -aw[3]);
                *(u32x2*)(nw + (mi * 16 + l15) * 128 + nv * 16 + l4 * 4) = w2;
            }
        }
    }
    LDS_BAR();
}

__constant__ double c_invf[16] = {1.0, 0.44036660267178046, 0.19392274474868576, 0.08539710028576561, 0.03760603093086393, 0.016560440080994446, 0.007292664737217109,
    0.003211445994752591, 0.001414213562373095, 0.000622772421914596, 0.0002742481756762073, 0.00012076973741146504, 5.318295896944988e-05, 2.341999896140934e-05,
    1.031338537721246e-05, 4.5416704806078695e-06};

DI void p2_qknorm(const Params& p) {
    const int tid = threadIdx.x, lane = tid & 63, wave = tid >> 6, sub = lane & 15, grp = lane >> 4;
    const bf16_t* proj = (const bf16_t*)(p.ws + WS_PROJ);
    bf16_t* qn = (bf16_t*)(p.ws + WS_QN); bf16_t* kn = (bf16_t*)(p.ws + WS_KN);
    float gq[8], gk[8];
#pragma unroll
    for (int e = 0; e < 8; ++e) { gq[e] = p.q_norm_g[sub * 8 + e]; gk[e] = p.k_norm_g[sub * 8 + e]; }
    for (int tok = blockIdx.x * 8 + wave; tok < NTOK; tok += gridDim.x * 8) {
        const int pos = p.positions[tok];
        const double ad = (double)pos * c_invf[sub];
        const double kk = rint(ad * 0.15915494309189535);
        const float r = (float)(ad - kk * 6.283185307179586);
        const float cs = __cosf(r), sn = __sinf(r);
#pragma unroll
        for (int it = 0; it < 8; ++it) {
            const int v = it * 4 + grp; const bool isq = v < 16;
            const bf16x8 raw = *(const bf16x8*)(proj + (size_t)tok * PROJ_LD + (isq ? PC_QB + v * 128 : PC_KB + (v - 16) * 128) + sub * 8);
            float x[8]; float ss = 0.f;
#pragma unroll
            for (int e = 0; e < 8; ++e) { x[e] = bf2f((unsigned short)raw[e]); ss += x[e] * x[e]; }
            ss += __shfl_xor(ss, 1); ss += __shfl_xor(ss, 2); ss += __shfl_xor(ss, 4); ss += __shfl_xor(ss, 8);
            const float rs = rsqrtf(ss * (1.f / 128.f) + NORM_EPS);
#pragma unroll
            for (int e = 0; e < 8; ++e) x[e] = x[e] * rs * (isq ? gq[e] : gk[e]);
            float y[8];
#pragma unroll
            for (int e = 0; e < 8; ++e) {
                const float py = __shfl_xor(x[e], 2);
                const int src = (lane & 48) | (8 * (sub & 1) + e);
                const float c = __shfl(cs, src), s = __shfl(sn, src);
                y[e] = sub < 2 ? x[e] * c - py * s : (sub < 4 ? x[e] * c + py * s : x[e]);
            }
            u32x4 w = {cvt_pk_bf16(y[0], y[1]), cvt_pk_bf16(y[2], y[3]), cvt_pk_bf16(y[4], y[5]), cvt_pk_bf16(y[6], y[7])};
            *(u32x4*)((isq ? qn : kn) + (size_t)tok * DM + (v & 15) * 128 + sub * 8) = w;
        }
    }
}

constexpr int SC_NEGW = 0, SC_QG = 17408, SC_KDT = 34816, SC_QK = 53248, SC_BUF = 62464, SC_OBUF = 2 * SC_BUF;
DI bf16x8 ld_frag2(const LAS char* p) { const s16x4 lo = *(const LAS s16x4*)p, hi = *(const LAS s16x4*)(p + 32); return __builtin_shufflevector(lo, hi, 0, 1, 2, 3, 4, 5, 6, 7); }
DI bf16x8 pack2(const f32x4& a, const f32x4& b) { u32x4 w = {cvt_pk_bf16(a[0], a[1]), cvt_pk_bf16(a[2], a[3]), cvt_pk_bf16(b[0], b[1]), cvt_pk_bf16(b[2], b[3])}; return __builtin_bit_cast(bf16x8, w); }

DI void gdn_scan_unit(const Params& p, LAS char* st, int bh) {
    int tid_ = threadIdx.x; asm volatile("" : "+v"(tid_));
    const int tid = tid_, lane = tid & 63, wave = tid >> 6, l15 = lane & 15, l4 = lane >> 4;
    const int b = bh >> 4, hh = bh & 15;
    const bf16_t* g_negw = (const bf16_t*)(p.ws + WS_NEGW) + (size_t)bh * 64 * 8192;
    const bf16_t* g_qg = (const bf16_t*)(p.ws + WS_QG) + (size_t)bh * 64 * 8192;
    const bf16_t* g_kdt = (const bf16_t*)(p.ws + WS_KDT) + (size_t)bh * 64 * 8192;
    const bf16_t* g_ut = (const bf16_t*)(p.ws + WS_UT) + (size_t)bh * 64 * 8192;
    const bf16_t* g_qk = (const bf16_t*)(p.ws + WS_QK) + (size_t)bh * 64 * 4096;
    const float* g_gl = (const float*)(p.ws + WS_GL) + bh * 64;
    const bf16_t* proj = (const bf16_t*)(p.ws + WS_PROJ);
    bf16_t* oa = (bf16_t*)(p.ws + WS_OA);
    u32x4 sg[7]; u32x2 ur[4], urn[4];
#define SC_LOAD(n_) do { \
        sg[0] = *(const u32x4*)(g_negw + (size_t)(n_) * 8192 + tid * 8); sg[1] = *(const u32x4*)(g_negw + (size_t)(n_) * 8192 + (tid + 512) * 8); \
        sg[2] = *(const u32x4*)(g_qg + (size_t)(n_) * 8192 + tid * 8);   sg[3] = *(const u32x4*)(g_qg + (size_t)(n_) * 8192 + (tid + 512) * 8); \
        sg[4] = *(const u32x4*)(g_kdt + (size_t)(n_) * 8192 + tid * 8);  sg[5] = *(const u32x4*)(g_kdt + (size_t)(n_) * 8192 + (tid + 512) * 8); \
        sg[6] = *(const u32x4*)(g_qk + (size_t)(n_) * 4096 + tid * 8); \
        _Pragma("unroll") for (int mt = 0; mt < 4; ++mt) urn[mt] = *(const u32x2*)(g_ut + (size_t)(n_) * 8192 + (wave * 16 + l15) * 64 + mt * 16 + l4 * 4); } while (0)
#define SC_WRITE(bsel) do { LAS char* bb = st + (bsel) * SC_BUF; \
        *(LAS u32x4*)(bb + SC_NEGW + (tid >> 4) * 272 + (tid & 15) * 16) = sg[0]; *(LAS u32x4*)(bb + SC_NEGW + ((tid + 512) >> 4) * 272 + (tid & 15) * 16) = sg[1]; \
        *(LAS u32x4*)(bb + SC_QG + (tid >> 4) * 272 + (tid & 15) * 16) = sg[2];   *(LAS u32x4*)(bb + SC_QG + ((tid + 512) >> 4) * 272 + (tid & 15) * 16) = sg[3]; \
        *(LAS u32x4*)(bb + SC_KDT + (tid >> 3) * 144 + (tid & 7) * 16) = sg[4];   *(LAS u32x4*)(bb + SC_KDT + ((tid + 512) >> 3) * 144 + (tid & 7) * 16) = sg[5]; \
        *(LAS u32x4*)(bb + SC_QK + (tid >> 3) * 144 + (tid & 7) * 16) = sg[6]; } while (0)
    f32x4 S[8];
#pragma unroll
    for (int t = 0; t < 8; ++t) S[t] = (f32x4){0.f, 0.f, 0.f, 0.f};
    const int etok = tid >> 3, edv = (tid & 7) * 16;
    float gn[16];
#pragma unroll
    for (int e = 0; e < 16; ++e) gn[e] = p.gdn_norm_g[edv + e];
    SC_LOAD(0); SC_WRITE(0);
#pragma unroll
    for (int mt = 0; mt < 4; ++mt) ur[mt] = urn[mt];
    __syncthreads();
    for (int n = 0; n < 64; ++n) {
        LAS char* bb = st + (n & 1) * SC_BUF;
        if (n + 1 < 64) SC_LOAD(n + 1);
        const size_t zrow = (size_t)(b * SEQ + n * 64 + etok);
        const u32x4 z0 = *(const u32x4*)(proj + zrow * PROJ_LD + PC_Z + hh * 128 + edv), z1 = *(const u32x4*)(proj + zrow * PROJ_LD + PC_Z + hh * 128 + edv + 8);
        const float gl = g_gl[n];
        bf16x8 sb[4];
#pragma unroll
        for (int s = 0; s < 4; ++s) sb[s] = pack2(S[2 * s], S[2 * s + 1]);
        f32x4 vn[4], o[4];
#pragma unroll
        for (int mt = 0; mt < 4; ++mt) {
            vn[mt] = (f32x4){bflo(ur[mt][0]), bfhi(ur[mt][0]), bflo(ur[mt][1]), bfhi(ur[mt][1])};
            o[mt] = (f32x4){0.f, 0.f, 0.f, 0.f};
#pragma unroll
            for (int s = 0; s < 4; ++s) {
                vn[mt] = MFMA16(ld_frag2(bb + SC_NEGW + (mt * 16 + l15) * 272 + (s * 32 + l4 * 4) * 2), sb[s], vn[mt]);
                o[mt] = MFMA16(ld_frag2(bb + SC_QG + (mt * 16 + l15) * 272 + (s * 32 + l4 * 4) * 2), sb[s], o[mt]);
            }
        }
        bf16x8 vb[2];
        vb[0] = pack2(vn[0], vn[1]); vb[1] = pack2(vn[2], vn[3]);
#pragma unroll
        for (int mt = 0; mt < 4; ++mt)
#pragma unroll
            for (int s = 0; s < 2; ++s) o[mt] = MFMA16(ld_frag2(bb + SC_QK + (mt * 16 + l15) * 144 + (s * 32 + l4 * 4) * 2), vb[s], o[mt]);
#pragma unroll
        for (int t = 0; t < 8; ++t) {
            S[t] *= gl;
#pragma unroll
            for (int s = 0; s < 2; ++s) S[t] = MFMA16(ld_frag2(bb + SC_KDT + (t * 16 + l15) * 144 + (s * 32 + l4 * 4) * 2), vb[s], S[t]);
        }
        LAS float* ob = (LAS float*)(st + SC_OBUF);
#pragma unroll
        for (int mt = 0; mt < 4; ++mt)
#pragma unroll
            for (int r = 0; r < 4; ++r) ob[(mt * 16 + l4 * 4 + r) * 132 + wave * 16 + l15] = o[mt][r];
        if (n + 1 < 64) { SC_WRITE((n + 1) & 1);
#pragma unroll
            for (int mt = 0; mt < 4; ++mt) ur[mt] = urn[mt]; }
        LDS_BAR();
        {
            float v[16]; float ss = 0.f;
#pragma unroll
            for (int q = 0; q < 4; ++q) { const f32x4 t4 = *(const LAS f32x4*)(ob + etok * 132 + edv + q * 4); v[q * 4] = t4[0]; v[q * 4 + 1] = t4[1]; v[q * 4 + 2] = t4[2]; v[q * 4 + 3] = t4[3]; }
#pragma unroll
            for (int e = 0; e < 16; ++e) ss += v[e] * v[e];
            ss += __shfl_xor(ss, 1); ss += __shfl_xor(ss, 2); ss += __shfl_xor(ss, 4);
            const float rs = rsqrtf(ss * (1.f / 128.f) + NORM_EPS);
            const unsigned zz[8] = {z0[0], z0[1], z0[2], z0[3], z1[0], z1[1], z1[2], z1[3]};
            u32x4 w0, w1;
#pragma unroll
            for (int q = 0; q < 4; ++q) {
                w0[q] = cvt_pk_bf16(v[2 * q] * rs * gn[2 * q] * bflo(zz[q]), v[2 * q + 1] * rs * gn[2 * q + 1] * bfhi(zz[q]));
                w1[q] = cvt_pk_bf16(v[8 + 2 * q] * rs * gn[8 + 2 * q] * bflo(zz[4 + q]), v[9 + 2 * q] * rs * gn[9 + 2 * q] * bfhi(zz[4 + q]));
            }
            bf16_t* dst = oa + zrow * DM + hh * 128 + edv;
            *(u32x4*)dst = w0; *(u32x4*)(dst + 8) = w1;
        }
        LDS_BAR();
    }
#undef SC_LOAD
#undef SC_WRITE
}

constexpr int AT_K1 = 0, AT_K2 = 16384, AT_V = 32768, AT_BUF = 65536, AT_SCR = 2 * AT_BUF;
constexpr float AT_SCALE = 0.088388347648318440f, AT_THR = 8.f;
#define KSWZ(row, colB) ((row) * 256 + ((colB) ^ (((row) & 7) << 4)))
DI int crow(int r, int hi) { return (r & 3) + 8 * (r >> 2) + 4 * hi; }
DI int v_rd_base(int lane) { return ((lane & 3) << 3) | (((lane >> 2) & 3) << 6) | (((lane >> 4) & 1) << 5) | (((lane >> 5) & 1) << 8); }
constexpr int v_rd_off(int d0, int ks, int half) { return d0 * 512 + ks * 8192 + half * 4096; }
template <int OFF> DI s16x4 tr_read(int vb) { s16x4 r; asm volatile("ds_read_b64_tr_b16 %0, %1 offset:%2" : "=&v"(r) : "v"(vb), "i"(OFF) : "memory"); return r; }
template <int D0, int HH> DI void pv_half(f32x16& od, int vb, bf16x8 pa, bf16x8 pb) {
    const s16x4 l0 = tr_read<v_rd_off(D0, 2 * HH, 0)>(vb), h0 = tr_read<v_rd_off(D0, 2 * HH, 1)>(vb), l1 = tr_read<v_rd_off(D0, 2 * HH + 1, 0)>(vb), h1 = tr_read<v_rd_off(D0, 2 * HH + 1, 1)>(vb);
    asm volatile("s_waitcnt lgkmcnt(0)" ::: "memory"); SCHED();
#define PK(L, H) (bf16x8){L[0], L[1], L[2], L[3], H[0], H[1], H[2], H[3]}
    od = MFMA32(pa, PK(l0, h0), od); od = MFMA32(pb, PK(l1, h1), od);
#undef PK
}

struct VFrag { s16x4 l0, h0, l1, h1, l2, h2, l3, h3; };
template <int D0> DI void pv_load(VFrag& f, int vb) {
    f.l0 = tr_read<v_rd_off(D0, 0, 0)>(vb); f.h0 = tr_read<v_rd_off(D0, 0, 1)>(vb); f.l1 = tr_read<v_rd_off(D0, 1, 0)>(vb); f.h1 = tr_read<v_rd_off(D0, 1, 1)>(vb);
    f.l2 = tr_read<v_rd_off(D0, 2, 0)>(vb); f.h2 = tr_read<v_rd_off(D0, 2, 1)>(vb); f.l3 = tr_read<v_rd_off(D0, 3, 0)>(vb); f.h3 = tr_read<v_rd_off(D0, 3, 1)>(vb);
}
DI void pv_mma(f32x16& od, const VFrag& f, bf16x8 pa0, bf16x8 pa1, bf16x8 pa2, bf16x8 pa3) {
#define PK(L, H) (bf16x8){L[0], L[1], L[2], L[3], H[0], H[1], H[2], H[3]}
    od = MFMA32(pa0, PK(f.l0, f.h0), od); od = MFMA32(pa1, PK(f.l1, f.h1), od); od = MFMA32(pa2, PK(f.l2, f.h2), od); od = MFMA32(pa3, PK(f.l3, f.h3), od);
#undef PK
}
struct VFragH { s16x4 l0, h0, l1, h1; };
template <int D0, int HH> DI void pvh_load(VFragH& f, int vb) {
    f.l0 = tr_read<v_rd_off(D0, 2 * HH, 0)>(vb); f.h0 = tr_read<v_rd_off(D0, 2 * HH, 1)>(vb); f.l1 = tr_read<v_rd_off(D0, 2 * HH + 1, 0)>(vb); f.h1 = tr_read<v_rd_off(D0, 2 * HH + 1, 1)>(vb);
}
DI void pvh_mma(f32x16& od, const VFragH& f, bf16x8 pa, bf16x8 pb) {
#define PK(L, H) (bf16x8){L[0], L[1], L[2], L[3], H[0], H[1], H[2], H[3]}
    od = MFMA32(pa, PK(f.l0, f.h0), od); od = MFMA32(pb, PK(f.l1, f.h1), od);
#undef PK
}
#define PV_STEP(D, FCUR, FNXT) do { pv_load<(D) + 1>(FNXT, vb); asm volatile("s_waitcnt lgkmcnt(8)" ::: "memory"); SCHED(); pv_mma(o[D], FCUR, pa0, pa1, pa2, pa3); } while (0)

DI void attn_unit(const Params& p, LAS char* st, int b, int h, int t, float lam) {
    int tid_ = threadIdx.x; asm volatile("" : "+v"(tid_));
    const int tid = tid_, wid = tid >> 6, lane = tid & 63, r32 = lane & 31, hi = lane >> 5;
    const int comp = wid >> 2, wq = wid & 3;
    const bf16_t* qn = (const bf16_t*)(p.ws + WS_QN); const bf16_t* kn = (const bf16_t*)(p.ws + WS_KN); const bf16_t* proj = (const bf16_t*)(p.ws + WS_PROJ);
    LAS float* scr = (LAS float*)(st + AT_SCR) + wid * 64;
    const int NT = 2 * t + 2;
    const int wv = __builtin_amdgcn_readfirstlane(tid >> 6);
    unsigned ksrc, vsrc;
    { const int row = tid >> 4, colB = ((tid & 15) << 4) ^ ((row & 7) << 4); ksrc = ((unsigned)row * DM + h * 256) * 2u + colB; }
    { const int sub = tid >> 5, kk = (sub >> 3) * 8 + ((tid & 31) >> 2), key = (kk & ~0xC) | ((kk & 4) << 1) | ((kk & 8) >> 1), col = (sub & 7) * 32 + ((tid & 3) << 3);
      vsrc = ((unsigned)key * DM + h * 256 + col) * 2u; }
    const __amdgpu_buffer_rsrc_t rsK = __builtin_amdgcn_make_buffer_rsrc((void*)(kn + (size_t)(b * SEQ) * DM), 0, 0x7fffffff, 0x00020000);
    const __amdgpu_buffer_rsrc_t rsV = __builtin_amdgcn_make_buffer_rsrc((void*)((const bf16_t*)(p.ws + WS_VBUF) + (size_t)(b * SEQ) * DM), 0, 0x7fffffff, 0x00020000);
#define AT_DMA(kt, bsel) do { LAS char* bb_ = st + (bsel) * AT_BUF + wv * 1024; \
        _Pragma("unroll") for (int i_ = 0; i_ < 2; ++i_) { const int so_ = ((kt) * 64 + 32 * i_) * DM * 2; \
            __builtin_amdgcn_raw_ptr_buffer_load_lds(rsK, (LAS unsigned*)(bb_ + AT_K1 + 8192 * i_), 16, ksrc, so_, 0, 0); \
            __builtin_amdgcn_raw_ptr_buffer_load_lds(rsK, (LAS unsigned*)(bb_ + AT_K2 + 8192 * i_), 16, ksrc, so_ + 256, 0, 0); } \
        _Pragma("unroll") for (int i_ = 0; i_ < 4; ++i_) \
            __builtin_amdgcn_raw_ptr_buffer_load_lds(rsV, (LAS unsigned*)(bb_ + AT_V + 8192 * i_), 16, vsrc, ((kt) * 64 + 16 * i_) * DM * 2, 0, 0); } while (0)
    bf16x8 qr[8];
    { const bf16_t* qw = qn + (size_t)(b * SEQ + t * 128 + wq * 32 + r32) * DM + h * 256 + comp * 128 + hi * 8;
#pragma unroll
      for (int d0 = 0; d0 < 8; ++d0) qr[d0] = *(const bf16x8*)(qw + d0 * 16); }
    f32x16 o[8];
#pragma unroll
    for (int d = 0; d < 8; ++d)
#pragma unroll
        for (int r = 0; r < 16; ++r) o[d][r] = 0.f;
    float m_reg = -1e30f, l_reg = 0.f;
    constexpr float C = AT_SCALE * 1.4426950408889634f;
    AT_DMA(0, 0);
    for (int j = 0; j < NT; ++j) {
        WAIT_V(0); WAIT_L(0); BAR();
        if (j + 1 < NT) AT_DMA(j + 1, (j + 1) & 1);
        if (j == NT - 1 && wq < 2) continue;
        const LAS char* bb = st + (j & 1) * AT_BUF; const LAS char* Ks = bb + (comp ? AT_K2 : AT_K1);
        f32x16 p0, p1;
#pragma unroll
        for (int r = 0; r < 16; ++r) { p0[r] = 0.f; p1[r] = 0.f; }
        const int vb = (int)(uintptr_t)(bb + AT_V) + v_rd_base(lane);
#define KF(i) (*(const LAS bf16x8*)(Ks + KSWZ(32 * ((i) >> 3) + r32, (((i) & 7) * 16 + hi * 8) * 2)))
#define QK_STEP(i, F) do { if ((i) < 8) p0 = MFMA32(F, qr[(i) & 7], p0); else p1 = MFMA32(F, qr[(i) & 7], p1); if ((i) + 3 < 16) F = KF((i) + 3); } while (0)
        bf16x8 kf0 = KF(0), kf1 = KF(1), kf2 = KF(2);
        __builtin_amdgcn_s_setprio(1);
        QK_STEP(0, kf0); SCHED(); QK_STEP(1, kf1); SCHED(); QK_STEP(2, kf2); SCHED(); QK_STEP(3, kf0); SCHED();
        QK_STEP(4, kf1); SCHED(); QK_STEP(5, kf2); SCHED(); QK_STEP(6, kf0); SCHED(); QK_STEP(7, kf1); SCHED();
        __builtin_amdgcn_s_setprio(0);
        bf16x8 pa0, pa1, pa2, pa3;
#define PK4(P, BASE, OUT) do { unsigned a0 = cvt_pk_bf16(P[BASE + 0], P[BASE + 1]), a1 = cvt_pk_bf16(P[BASE + 2], P[BASE + 3]); \
        unsigned b0_ = cvt_pk_bf16(P[BASE + 4], P[BASE + 5]), b1_ = cvt_pk_bf16(P[BASE + 6], P[BASE + 7]); \
        auto r0 = __builtin_amdgcn_permlane32_swap(a0, b0_, false, false); auto r1 = __builtin_amdgcn_permlane32_swap(a1, b1_, false, false); \
        u32x4 w = {r0[0], r1[0], r0[1], r1[1]}; OUT = __builtin_bit_cast(bf16x8, w); } while (0)
#define SM_HEAD(P, EX, ALPHA, MNC) \
        float pm_ = P[0]; _Pragma("unroll") for (int r = 1; r < 16; ++r) pm_ = fmaxf(pm_, P[r]); \
        { auto rr = __builtin_amdgcn_permlane32_swap(__float_as_uint(pm_), __float_as_uint(pm_), false, false); pm_ = fmaxf(__uint_as_float(rr[0]), __uint_as_float(rr[1])); } \
        const bool EX = !__all(pm_ - m_reg <= AT_THR / AT_SCALE); \
        const float mn_ = EX ? fmaxf(m_reg, pm_) : m_reg; const float ALPHA = EX ? __builtin_amdgcn_exp2f((m_reg - mn_) * C) : 1.f; m_reg = mn_; const float MNC = -mn_ * C;
#define SM_PAIR(P, c, MNC, PS) do { P[2 * (c)] = __builtin_amdgcn_exp2f(fmaf(P[2 * (c)], C, MNC)); P[2 * (c) + 1] = __builtin_amdgcn_exp2f(fmaf(P[2 * (c) + 1], C, MNC)); PS += P[2 * (c)] + P[2 * (c) + 1]; } while (0)
#define SM_RESCALE(ALPHA) do { if (hi == 0) scr[r32] = ALPHA; WAIT_L(0); \
        _Pragma("unroll") for (int r = 0; r < 16; ++r) { const float a_ = scr[crow(r, hi)]; _Pragma("unroll") for (int d = 0; d < 8; ++d) o[d][r] *= a_; } } while (0)
        float ps0 = 0.f;
        QK_STEP(8, kf2); SCHED(); QK_STEP(9, kf0); SCHED();
        bool ex0; float alpha0, mnC0;
        { SM_HEAD(p0, ex0_, alpha0_, mnC0_); ex0 = ex0_; alpha0 = alpha0_; mnC0 = mnC0_; }
        SCHED();
        QK_STEP(10, kf1); SM_PAIR(p0, 0, mnC0, ps0); SM_PAIR(p0, 1, mnC0, ps0); SCHED();
        QK_STEP(11, kf2); SM_PAIR(p0, 2, mnC0, ps0); SM_PAIR(p0, 3, mnC0, ps0); SCHED();
        QK_STEP(12, kf0); SM_PAIR(p0, 4, mnC0, ps0); PK4(p0, 0, pa0); SCHED();
        QK_STEP(13, kf1); SM_PAIR(p0, 5, mnC0, ps0); SM_PAIR(p0, 6, mnC0, ps0); SCHED();
        QK_STEP(14, kf2); SM_PAIR(p0, 7, mnC0, ps0); SCHED();
        QK_STEP(15, kf0); PK4(p0, 8, pa1); SCHED();
#undef KF
#undef QK_STEP
        { auto rr = __builtin_amdgcn_permlane32_swap(__float_as_uint(ps0), __float_as_uint(ps0), false, false); ps0 = __uint_as_float(rr[0]) + __uint_as_float(rr[1]); }
        l_reg = l_reg * alpha0 + ps0;
        __builtin_amdgcn_s_setprio(0);
        if (ex0) SM_RESCALE(alpha0);
        float ps1 = 0.f; bool ex1; float alpha1, mnC1;
        { SM_HEAD(p1, ex1_, alpha1_, mnC1_); ex1 = ex1_; alpha1 = alpha1_; mnC1 = mnC1_; }
        VFragH fa, fb;
        WAIT_L(0); pvh_load<0, 0>(fa, vb);
#define PVH_STEP(HH, D, FCUR, FNXT, PA, PB, ...) do { pvh_load<(D) + 1, HH>(FNXT, vb); asm volatile("s_waitcnt lgkmcnt(4)" ::: "memory"); SCHED(); pvh_mma(o[D], FCUR, PA, PB); __VA_ARGS__; SCHED(); } while (0)
        PVH_STEP(0, 0, fa, fb, pa0, pa1, SM_PAIR(p1, 0, mnC1, ps1)); PVH_STEP(0, 1, fb, fa, pa0, pa1, SM_PAIR(p1, 1, mnC1, ps1));
        PVH_STEP(0, 2, fa, fb, pa0, pa1, SM_PAIR(p1, 2, mnC1, ps1)); PVH_STEP(0, 3, fb, fa, pa0, pa1, SM_PAIR(p1, 3, mnC1, ps1); PK4(p1, 0, pa2));
        PVH_STEP(0, 4, fa, fb, pa0, pa1, SM_PAIR(p1, 4, mnC1, ps1)); PVH_STEP(0, 5, fb, fa, pa0, pa1, SM_PAIR(p1, 5, mnC1, ps1));
        PVH_STEP(0, 6, fa, fb, pa0, pa1, SM_PAIR(p1, 6, mnC1, ps1));
        asm volatile("s_waitcnt lgkmcnt(0)" ::: "memory"); SCHED(); pvh_mma(o[7], fb, pa0, pa1); SM_PAIR(p1, 7, mnC1, ps1); PK4(p1, 8, pa3); SCHED();
        { auto rr = __builtin_amdgcn_permlane32_swap(__float_as_uint(ps1), __float_as_uint(ps1), false, false); ps1 = __uint_as_float(rr[0]) + __uint_as_float(rr[1]); }
        l_reg = l_reg * alpha1 + ps1;
        __builtin_amdgcn_s_setprio(0);
        if (ex1) SM_RESCALE(alpha1);
        WAIT_L(0); pvh_load<0, 1>(fa, vb);
        PVH_STEP(1, 0, fa, fb, pa2, pa3, (void)0); PVH_STEP(1, 1, fb, fa, pa2, pa3, (void)0); PVH_STEP(1, 2, fa, fb, pa2, pa3, (void)0); PVH_STEP(1, 3, fb, fa, pa2, pa3, (void)0);
        PVH_STEP(1, 4, fa, fb, pa2, pa3, (void)0); PVH_STEP(1, 5, fb, fa, pa2, pa3, (void)0); PVH_STEP(1, 6, fa, fb, pa2, pa3, (void)0);
        asm volatile("s_waitcnt lgkmcnt(0)" ::: "memory"); SCHED(); pvh_mma(o[7], fb, pa2, pa3);
        __builtin_amdgcn_s_setprio(0);
#undef PK4
#undef SM_HEAD
#undef SM_PAIR
#undef SM_RESCALE
#undef PVH_STEP
    }
    WAIT_L(0);
    if (hi == 0) scr[32 + r32] = l_reg;
    WAIT_L(0);
    float rli[16];
#pragma unroll
    for (int r = 0; r < 16; ++r) rli[r] = __builtin_amdgcn_rcpf(scr[32 + crow(r, hi)]);
    __syncthreads();
    LAS float* xch = (LAS float*)st;
    if (comp == 1) {
#pragma unroll
        for (int r = 0; r < 16; ++r) { const float s = rli[r] * lam;
#pragma unroll
            for (int d = 0; d < 8; ++d) xch[(wq * 32 + crow(r, hi)) * 256 + d * 32 + r32] = o[d][r] * s; }
    }
    __syncthreads();
    if (comp == 0) {
        bf16_t* ob = (bf16_t*)(p.ws + WS_OB);
        float sg[8];
#pragma unroll
        for (int d = 0; d < 8; ++d) sg[d] = p.subln_g[d * 32 + r32] * 0.8f;
#pragma unroll
        for (int r = 0; r < 16; ++r) {
            float ss = 0.f;
#pragma unroll
            for (int d = 0; d < 8; ++d) { const float v = o[d][r] * rli[r] - xch[(wq * 32 + crow(r, hi)) * 256 + d * 32 + r32]; o[d][r] = v; ss += v * v; }
            ss += __shfl_xor(ss, 1); ss += __shfl_xor(ss, 2); ss += __shfl_xor(ss, 4); ss += __shfl_xor(ss, 8); ss += __shfl_xor(ss, 16);
            const float rs = rsqrtf(ss * (1.f / 256.f) + NORM_EPS);
            bf16_t* dst = ob + (size_t)(b * SEQ + t * 128 + wq * 32 + crow(r, hi)) * DM + h * 256 + r32;
#pragma unroll
            for (int d = 0; d < 8; ++d) dst[d * 32] = (bf16_t)(cvt_pk_bf16(o[d][r] * rs * sg[d], 0.f) & 0xffffu);
            asm volatile("" ::: "memory");
        }
    }
    __syncthreads();
#undef AT_DMA
}

DI void p3_mixers(const Params& p, LAS char* lds, int rep) {
    const int tid = threadIdx.x;
    LAS char* st = lds + LDS_MISC;
    volatile LAS int* bc = (volatile LAS int*)(lds + 16);
    if (tid < 64) {
        float a = p.lq1[tid] * p.lk1[tid] + p.lq1[tid + 64] * p.lk1[tid + 64], c = p.lq2[tid] * p.lk2[tid] + p.lq2[tid + 64] * p.lk2[tid + 64];
#pragma unroll
        for (int o = 32; o >= 1; o >>= 1) { a += __shfl_xor(a, o); c += __shfl_xor(c, o); }
        if (tid == 0) ((volatile LAS float*)bc)[1] = __expf(a) - __expf(c) + 0.2f;
    }
    __syncthreads();
    const float lam = ((volatile LAS float*)bc)[1];
    unsigned* queue = (unsigned*)(p.ws + WS_CTL) + CW_QUEUE + 1024 * rep;
#define PULL(item_) do { if (tid == 0) bc[0] = (int)__hip_atomic_fetch_add(queue, 1u, __ATOMIC_RELAXED, __HIP_MEMORY_SCOPE_AGENT); __syncthreads(); item_ = bc[0]; __syncthreads(); } while (0)
    const int xq = blockIdx.x & 7;
    unsigned* queueA = queue + 64 * (1 + xq); unsigned* queueB = queue + 32;
#define PULLA(item_) do { if (tid == 0) bc[0] = (int)__hip_atomic_fetch_add(queueA, 1u, __ATOMIC_RELAXED, __HIP_MEMORY_SCOPE_AGENT); __syncthreads(); item_ = bc[0]; __syncthreads(); } while (0)
#define PULLB(item_) do { if (tid == 0) bc[0] = (int)__hip_atomic_fetch_add(queueB, 1u, __ATOMIC_RELAXED, __HIP_MEMORY_SCOPE_AGENT); __syncthreads(); item_ = bc[0]; __syncthreads(); } while (0)
    int item;
#ifndef MK_NO_CONV
    if (((blockIdx.x >> 3) & 7) < 4) { PULLB(item); while (item < 768) { cvt_tiles<32>(p, lds, 3072 + item * 32, 1); PULLB(item); } }
#endif
    PULLA(item);
#ifndef MK_NO_SCAN
    while (item < 8) { gdn_scan_unit(p, st, xq * 8 + item); PULLA(item); }
#endif
#ifndef MK_NO_ATTN
    while (item < 8 + 128) { const int idx = item - 8, bhh = xq * 4 + (idx >> 5), t = 31 - (idx & 31); attn_unit(p, st, bhh >> 3, bhh & 7, t, lam); PULLA(item); }
#endif
#ifndef MK_NO_CONV
    PULLB(item); while (item < 768) { cvt_tiles<32>(p, lds, 3072 + item * 32, 1); PULLB(item); }
#endif
#undef PULLA
#undef PULLB
#undef PULL
}

DI void p6_router(const Params& p, LAS char* lds) {
    const int tid = threadIdx.x, lane = tid & 63, wave = tid >> 6, l15 = lane & 15, l4 = lane >> 4;
    LAS char* st = lds + LDS_MISC;
    LAS float* lg = (LAS float*)st;
    LAS float* rsd = (LAS float*)(st + 8448);
    LAS int* sel = (LAS int*)(st + 8704);
    LAS float* selw = (LAS float*)(st + 9728);
    LAS int* lcnt = (LAS int*)(st + 10752);
    const bf16_t* rhi = (const bf16_t*)(p.ws + WS_WS) + 32 * 2048; const bf16_t* rlo = rhi + 32 * 2048;
    unsigned char* h2 = p.ws + WS_H;
    unsigned* cnt = (unsigned*)(p.ws + WS_CTL) + CW_CNT;
    int* list = (int*)(p.ws + WS_LIST); float* wlist = (float*)(p.ws + WS_WLIST); int* tinfo = (int*)(p.ws + WS_TINFO);
    for (int grp = blockIdx.x; grp < NTOK / 64; grp += gridDim.x) {
        const int tok0 = grp * 64;
        if (tid < 64) lcnt[tid] = 0;
        if (wave < 4) {
            const float* xr = p.out + (size_t)(tok0 + wave * 16 + l15) * DM + l4 * 8;
            const bf16_t* bh0 = rhi + (size_t)l15 * DM + l4 * 8; const bf16_t* bl0 = rlo + (size_t)l15 * DM + l4 * 8;
            f32x4 a0 = {0.f, 0.f, 0.f, 0.f}, a1 = {0.f, 0.f, 0.f, 0.f}; float ss = 0.f;
#pragma unroll 4
            for (int k0 = 0; k0 < DM; k0 += 32) {
                const f32x4 xa = *(const f32x4*)(xr + k0), xb = *(const f32x4*)(xr + k0 + 4);
                const f32x4 ga = *(const f32x4*)(p.norm2_g + k0 + l4 * 8), gb = *(const f32x4*)(p.norm2_g + k0 + l4 * 8 + 4);
                float a[8] = {xa[0] * ga[0], xa[1] * ga[1], xa[2] * ga[2], xa[3] * ga[3], xb[0] * gb[0], xb[1] * gb[1], xb[2] * gb[2], xb[3] * gb[3]};
                ss += xa[0] * xa[0] + xa[1] * xa[1] + xa[2] * xa[2] + xa[3] * xa[3] + xb[0] * xb[0] + xb[1] * xb[1] + xb[2] * xb[2] + xb[3] * xb[3];
                u32x4 hw, lw;
#pragma unroll
                for (int q = 0; q < 4; ++q) { hw[q] = cvt_pk_bf16(a[2 * q], a[2 * q + 1]); lw[q] = cvt_pk_bf16(a[2 * q] - bflo(hw[q]), a[2 * q + 1] - bfhi(hw[q])); }
                const bf16x8 ah = __builtin_bit_cast(bf16x8, hw), al = __builtin_bit_cast(bf16x8, lw);
                const bf16x8 bh_0 = *(const bf16x8*)(bh0 + k0), bh_1 = *(const bf16x8*)(bh0 + 16 * DM + k0), bl_0 = *(const bf16x8*)(bl0 + k0), bl_1 = *(const bf16x8*)(bl0 + 16 * DM + k0);
                a0 = MFMA16(ah, bh_0, a0); a0 = MFMA16(ah, bl_0, a0); a0 = MFMA16(al, bh_0, a0);
                a1 = MFMA16(ah, bh_1, a1); a1 = MFMA16(ah, bl_1, a1); a1 = MFMA16(al, bh_1, a1);
            }
            ss += __shfl_xor(ss, 16); ss += __shfl_xor(ss, 32);
            const float rstd = rsqrtf(ss * (1.f / DM) + NORM_EPS);
            if (l4 == 0) rsd[wave * 16 + l15] = rstd;
            const float br0 = p.b_router[l15], br1 = p.b_router[16 + l15];
#pragma unroll
            for (int r = 0; r < 4; ++r) {
                const float rs = __shfl(rstd, l4 * 4 + r);
                lg[(wave * 16 + l4 * 4 + r) * 33 + l15] = a0[r] * rs + br0;
                lg[(wave * 16 + l4 * 4 + r) * 33 + 16 + l15] = a1[r] * rs + br1;
            }
        }
        __syncthreads();
        if (tid < 64) {
            float v[32];
#pragma unroll
            for (int e = 0; e < 32; ++e) v[e] = lg[tid * 33 + e];
            float tv[4]; int ti[4];
#pragma unroll
            for (int k = 0; k < 4; ++k) {
                float best = -3.0e38f; int bi = 0;
#pragma unroll
                for (int e = 0; e < 32; ++e) { const bool take = v[e] > best; best = take ? v[e] : best; bi = take ? e : bi; }
                tv[k] = best; ti[k] = bi;
#pragma unroll
                for (int e = 0; e < 32; ++e) v[e] = (e == bi) ? -3.0e38f : v[e];
            }
            const float e1 = __expf(tv[1] - tv[0]), e2 = __expf(tv[2] - tv[0]), e3 = __expf(tv[3] - tv[0]); const float inv = 1.f / (1.f + e1 + e2 + e3);
            const float w4[4] = {inv, e1 * inv, e2 * inv, e3 * inv};
#pragma unroll
            for (int k = 0; k < 4; ++k) { const int lp = atomicAdd((int*)&lcnt[ti[k]], 1); sel[tid * 4 + k] = ti[k] | (lp << 8); selw[tid * 4 + k] = w4[k]; }
        }
        __syncthreads();
        if (tid < 32) lcnt[32 + tid] = (int)__hip_atomic_fetch_add(cnt + tid * 16, (unsigned)lcnt[tid], __ATOMIC_RELAXED, __HIP_MEMORY_SCOPE_AGENT);
        __syncthreads();
        if (tid < 256) {
            const int s = sel[tid], e = s & 255, pos = lcnt[32 + e] + (s >> 8), tok = tok0 + (tid >> 2);
            list[e * NTOK + pos] = tok; wlist[e * NTOK + pos] = selw[tid];
            tinfo[(size_t)tok * 8 + (tid & 3) * 2] = e; tinfo[(size_t)tok * 8 + (tid & 3) * 2 + 1] = pos;
        }
#pragma unroll 1
        for (int tt = 0; tt < 8; ++tt) {
            const int tl = wave * 8 + tt; const float rs = rsd[tl];
            const float* xr = p.out + (size_t)(tok0 + tl) * DM;
#pragma unroll
            for (int i = 0; i < 8; ++i) {
                const f32x4 xv = *(const f32x4*)(xr + (i * 64 + lane) * 4), g = *(const f32x4*)(p.norm2_g + (i * 64 + lane) * 4);
                const float rs2 = rs * H8_SCALE;
                *(unsigned*)(h2 + (size_t)(tok0 + tl) * DM + (i * 64 + lane) * 4) = cvt4_fp8(xv[0] * rs2 * g[0], xv[1] * rs2 * g[1], xv[2] * rs2 * g[2], xv[3] * rs2 * g[3]);
            }
        }
        __syncthreads();
    }
}

DI void moe_table(const Params& p, LAS char* lds) {
    LAS int* ts = (LAS int*)(lds + 64); LAS int* cn = (LAS int*)(lds + 256);
    const int tid = threadIdx.x;
    if (tid < 64) {
        const int e = tid & 31;
        const int c = (int)__hip_atomic_load((unsigned*)(p.ws + WS_CTL) + CW_CNT + e * 16, __ATOMIC_RELAXED, __HIP_MEMORY_SCOPE_AGENT);
        const int tl = (c + 255) >> 8; int incl = tl;
#pragma unroll
        for (int o = 1; o < 32; o <<= 1) { const int t = __shfl_up(incl, o); if ((tid & 31) >= o) incl += t; }
        if (tid < 32) { ts[e + 1] = incl; cn[e] = c; if (e == 0) ts[0] = 0; }
    }
    __syncthreads();
}
DI bool moe_unit(const LAS int* ts, int u, int NTN, int& e, int& mt, int& nt, int& tile0) {
    if (u >= __builtin_amdgcn_readfirstlane(ts[32]) * NTN) return false;
    int ee = 0;
    for (int k = 1; k < 32; ++k) ee = (u >= __builtin_amdgcn_readfirstlane(ts[k]) * NTN) ? k : ee;
    const int t0 = __builtin_amdgcn_readfirstlane(ts[ee]), t1 = __builtin_amdgcn_readfirstlane(ts[ee + 1]);
    const int l = u - t0 * NTN, nte = t1 - t0;
    if (NTN == 8) { const int g = l / (2 * nte), r = l - g * 2 * nte; nt = 2 * g + (r & 1); mt = r >> 1; }
    else { nt = l / nte; mt = l - nt * nte; }
    e = ee; tile0 = t0; return true;
}
DI int moe_uidx(int i) {
    if (gridDim.x != 256) return (int)blockIdx.x + i * (int)gridDim.x;
    const int c = blockIdx.x, x = c & 7, s = c >> 3;
    return 256 * i + 8 * (x + 8 * (s >> 3)) + (s & 7);
}
DI void p7_gateup(const Params& p, LAS char* lds) {
    moe_table(p, lds);
    const LAS int* ts = (const LAS int*)(lds + 64); const LAS int* cn = (const LAS int*)(lds + 256);
    const int tid = threadIdx.x; const int* list = (const int*)(p.ws + WS_LIST);
    const bf16_t* h2 = (const bf16_t*)(p.ws + WS_H); const unsigned char* wgu = p.ws + WS_WGU;
    int e, mt, nt, t0; bool have = moe_unit(ts, moe_uidx(0), 16, e, mt, nt, t0), pre = false;
    if (have && tid < 256) { const int pos = mt * 256 + tid; ((LAS int*)(lds + 1024))[tid] = pos < cn[e] ? list[e * NTOK + pos] : 0; }
    __syncthreads();
    for (int i = 0; have; ++i) {
        LAS int* rowidx = (LAS int*)(lds + 1024 + (i & 1) * 1024); LAS int* rowidx2 = (LAS int*)(lds + 1024 + ((i + 1) & 1) * 1024);
        int e2, mt2, nt2, t02; const bool have2 = moe_unit(ts, moe_uidx(i + 1), 16, e2, mt2, nt2, t02);
        if (have2 && tid < 256) { const int pos = mt2 * 256 + tid; rowidx2[tid] = pos < cn[e2] ? list[e2 * NTOK + pos] : 0; }
        EpiGateUp ep{p.ws + WS_ACT, p.b_gu + (size_t)e * 4096, (t0 + mt) * 256, nt};
        auto next = [&]() { if (have2) gemm_issue<true, true>(h2, DM / 2, 0, rowidx2, (const bf16_t*)(wgu + ((size_t)e2 * 4096 + nt2 * 256) * DM), DM / 2, lds + LDS_MISC); };
        gemm_tile<true, true>(h2, DM / 2, 0, rowidx, (const bf16_t*)(wgu + ((size_t)e * 4096 + nt * 256) * DM), DM / 2, lds + LDS_MISC, ep, pre, next);
        pre = have2; have = have2; e = e2; mt = mt2; nt = nt2; t0 = t02;
    }
}
DI void p8_down(const Params& p, LAS char* lds) {
    moe_table(p, lds);
    const LAS int* ts = (const LAS int*)(lds + 64);
    const bf16_t* act = (const bf16_t*)(p.ws + WS_ACT); const unsigned char* wd = p.ws + WS_WD;
    int e, mt, nt, t0; bool have = moe_unit(ts, moe_uidx(0), 8, e, mt, nt, t0), pre = false;
    for (int i = 0; have; ++i) {
        int e2, mt2, nt2, t02; const bool have2 = moe_unit(ts, moe_uidx(i + 1), 8, e2, mt2, nt2, t02);
        const int slot0 = (t0 + mt) * 256;
        EpiDown ep{p.ws + WS_YS, p.b_down + (size_t)e * 2048, (const float*)(p.ws + WS_WLIST) + (size_t)e * NTOK + mt * 256, slot0, nt};
        auto next = [&]() { if (have2) gemm_issue<false, true>(act, DM / 2, (t02 + mt2) * 256, (const LAS int*)nullptr, (const bf16_t*)(wd + ((size_t)e2 * 2048 + nt2 * 256) * DM), DM / 2, lds + LDS_MISC); };
        gemm_tile<false, true>(act, DM / 2, slot0, (const LAS int*)nullptr, (const bf16_t*)(wd + ((size_t)e * 2048 + nt * 256) * DM), DM / 2, lds + LDS_MISC, ep, pre, next);
        pre = have2; have = have2; e = e2; mt = mt2; nt = nt2; t0 = t02;
    }
}
DI void p9_combine(const Params& p, LAS char* lds) {
    moe_table(p, lds);
    const LAS int* ts = (const LAS int*)(lds + 64);
    const int tid = threadIdx.x, lane = tid & 63, wave = tid >> 6;
    const int* tinfo = (const int*)(p.ws + WS_TINFO); const unsigned char* ys = p.ws + WS_YS;
    constexpr float iy = 1.f / Y8_SCALE;
    for (int tok = blockIdx.x * 8 + wave; tok < NTOK; tok += gridDim.x * 8) {
        int slot[4];
#pragma unroll
        for (int k = 0; k < 4; ++k) { const int e = tinfo[(size_t)tok * 8 + k * 2], pos = tinfo[(size_t)tok * 8 + k * 2 + 1]; slot[k] = ts[e] * 256 + pos; }
#pragma unroll
        for (int i = 0; i < 4; ++i) {
            const int cA = i * 512 + lane * 4, cB = cA + 256;
            f32x4 a0 = {0.f, 0.f, 0.f, 0.f}, a1 = {0.f, 0.f, 0.f, 0.f};
#pragma unroll
            for (int k = 0; k < 4; ++k) { const unsigned wa = *(const unsigned*)(ys + (size_t)slot[k] * DM + cA), wb = *(const unsigned*)(ys + (size_t)slot[k] * DM + cB);
                const f32x2 q0 = __builtin_amdgcn_cvt_pk_f32_fp8((int)wa, false), q1 = __builtin_amdgcn_cvt_pk_f32_fp8((int)wa, true);
                const f32x2 q2 = __builtin_amdgcn_cvt_pk_f32_fp8((int)wb, false), q3 = __builtin_amdgcn_cvt_pk_f32_fp8((int)wb, true);
                a0[0] += q0[0]; a0[1] += q0[1]; a0[2] += q1[0]; a0[3] += q1[1]; a1[0] += q2[0]; a1[1] += q2[1]; a1[2] += q3[0]; a1[3] += q3[1]; }
            float* o = p.out + (size_t)tok * DM;
            const f32x4 x0 = *(const f32x4*)(o + cA), x1 = *(const f32x4*)(o + cB);
            *(f32x4*)(o + cA) = x0 + a0 * iy; *(f32x4*)(o + cB) = x1 + a1 * iy;
        }
    }
}

__global__ void __launch_bounds__(512, 2) mega(Params p) {
    extern __shared__ __attribute__((aligned(16))) unsigned char lds_raw[];
    LAS char* lds = (LAS char*)lds_raw;
    const int tid = threadIdx.x;
    if (tid < 16) ((LAS unsigned*)lds)[tid] = 0u;
    __syncthreads();
    XcdBarrier bar; bar.bar = (unsigned*)(p.ws + WS_CTL); bar.x = 0; bar.st = (volatile LAS unsigned*)lds;
    const int lo = p.ph_lo, hi = p.ph_hi;
    if (hi - lo > 1) bar = xcd_barrier_post((unsigned*)(p.ws + WS_CTL), (volatile LAS unsigned*)lds);
#ifdef MK_ONLY
#define IN(k) ((k) == MK_ONLY && lo <= (k) && (k) < hi)
#else
#define IN(k) (lo <= (k) && (k) < hi)
#endif
#define SEAM(k) do { if (IN(k) && IN((k) + 1)) xcd_barrier(bar); } while (0)
#ifndef MK_DUP
#define MK_DUP (-1)
#endif
#define REP(k) for (int rep_ = 0; rep_ < ((k) == MK_DUP ? 2 : 1); ++rep_)
    if (IN(0)) REP(0) { p0_prologue(p, lds); } SEAM(0);
    if (IN(1)) REP(1) { p1_inproj(p, lds); } SEAM(1);
    if (IN(2)) REP(2) {
        for (int pr = blockIdx.x; pr < 2048; pr += gridDim.x) gdn_prep_pair(p, lds + LDS_MISC, pr);
        p2_qknorm(p);
    } SEAM(2);
    if (IN(3)) REP(3) { p3_mixers(p, lds, rep_); } SEAM(3);
    if (IN(4)) REP(4) { p4_branches(p, lds); } SEAM(4);
    if (IN(5)) REP(5) { p5_outproj(p, lds); } SEAM(5);
    if (IN(6)) { p6_router(p, lds); } SEAM(6);
    if (IN(7)) REP(7) { p7_gateup(p, lds); } SEAM(7);
    if (IN(8)) REP(8) { p8_down(p, lds); } SEAM(8);
    if (IN(9)) { p9_combine(p, lds); }
#undef IN
#undef SEAM
}

#ifndef MK_N_LAUNCHES
#define MK_N_LAUNCHES 1
#endif
extern "C" void kernel_launch(void* const* d_in, const int* in_sizes, int n_in, void* d_out, int out_size, void* d_ws, size_t ws_size, hipStream_t stream) {
    static int grid = 0;
    if (grid == 0) {
        if (n_in != 26 || out_size != NTOK * DM || ws_size < WS_END) { fprintf(stderr, "kernel_launch: unexpected shapes (n_in %d out %d ws %zu, need ws >= %zu)\n", n_in, out_size, ws_size, (size_t)WS_END); grid = -1; return; }
        int dev = 0, cus = 0, per_cu = 0;
        (void)hipGetDevice(&dev); (void)hipDeviceGetAttribute(&cus, hipDeviceAttributeMultiprocessorCount, dev);
        if (hipFuncSetAttribute((const void*)mega, hipFuncAttributeMaxDynamicSharedMemorySize, LDS_BYTES) != hipSuccess) { fprintf(stderr, "kernel_launch: hipFuncSetAttribute(%d) failed\n", LDS_BYTES); grid = -1; return; }
        (void)hipOccupancyMaxActiveBlocksPerMultiprocessor(&per_cu, (const void*)mega, 512, LDS_BYTES);
        (void)hipGetLastError();
        if (per_cu < 1) fprintf(stderr, "kernel_launch: occupancy query says %d blocks per CU\n", per_cu);
        grid = cus;
    }
    if (grid < 0) return;
    (void)hipMemsetAsync((char*)d_ws + WS_CTL, 0, CTL_ZERO_BYTES, stream);
    Params p{};
    p.x = (const float*)d_in[0]; p.positions = (const int*)d_in[1]; p.norm1_g = (const float*)d_in[2]; p.w_in = (const float*)d_in[3]; p.b_gate = (const float*)d_in[4];
    p.conv_w = (const float*)d_in[5]; p.a_log = (const float*)d_in[6]; p.dt_bias = (const float*)d_in[7]; p.gdn_norm_g = (const float*)d_in[8]; p.q_norm_g = (const float*)d_in[9];
    p.k_norm_g = (const float*)d_in[10]; p.lq1 = (const float*)d_in[11]; p.lk1 = (const float*)d_in[12]; p.lq2 = (const float*)d_in[13]; p.lk2 = (const float*)d_in[14];
    p.subln_g = (const float*)d_in[15]; p.w_a = (const float*)d_in[16]; p.w_b = (const float*)d_in[17]; p.w_out = (const float*)d_in[18]; p.norm2_g = (const float*)d_in[19];
    p.w_router = (const float*)d_in[20]; p.b_router = (const float*)d_in[21]; p.w_gu = (const float*)d_in[22]; p.b_gu = (const float*)d_in[23]; p.w_down = (const float*)d_in[24];
    p.b_down = (const float*)d_in[25]; p.out = (float*)d_out; p.ws = (unsigned char*)d_ws;
    if (MK_N_LAUNCHES == 1) { p.ph_lo = 0; p.ph_hi = 10; hipLaunchKernelGGL(mega, dim3(grid), dim3(512), LDS_BYTES, stream, p); }
    else for (int ph = 0; ph < 10; ++ph) { p.ph_lo = ph; p.ph_hi = ph + 1; hipLaunchKernelGGL(mega, dim3(grid), dim3(512), LDS_BYTES, stream, p); }
    const hipError_t le = hipPeekAtLastError();
    if (le != hipSuccess) fprintf(stderr, "kernel_launch: launch failed: %s\n", hipGetErrorName(le));
}
```

```cpp
#include <hip/hip_runtime.h>
#include <stdint.h>
#include <stdio.h>

#define DI __device__ __forceinline__
#define LAS __attribute__((address_space(3)))

typedef unsigned short bf16_t;
typedef short bf16x8 __attribute__((ext_vector_type(8)));
typedef short s16x4 __attribute__((ext_vector_type(4)));
typedef float f32x2 __attribute__((ext_vector_type(2)));
typedef float f32x4 __attribute__((ext_vector_type(4)));
typedef float f32x16 __attribute__((ext_vector_type(16)));
typedef unsigned u32x2 __attribute__((ext_vector_type(2)));
typedef unsigned u32x4 __attribute__((ext_vector_type(4)));

constexpr int NTOK = 16384, DM = 2048, SEQ = 4096, NBATCH = 4;
constexpr int IN_COLS = 18464;
constexpr int PROJ_LD = 18432;
constexpr int PC_QKV = 0, PC_Z = 6144, PC_QB = 8192, PC_KB = 10240, PC_VB = 12288, PC_GATE = 14336;
constexpr int NEXP = 32, TOPK = 4;
constexpr float NORM_EPS = 1e-6f;
constexpr int MAX_SLOTS = 73728;

constexpr size_t MiB = (size_t)1 << 20;
constexpr size_t WS_CTL = 0;
constexpr size_t CTL_ZERO_BYTES = 64 * 1024;
constexpr size_t WS_H = 1 * MiB;
constexpr size_t WS_WIN = 65 * MiB;
constexpr size_t WS_WA = 137 * MiB, WS_WB = 145 * MiB, WS_WO = 153 * MiB;
constexpr size_t WS_WS = 161 * MiB;
constexpr size_t WS_BA = 162 * MiB;
constexpr size_t WS_WGU = 164 * MiB;
constexpr size_t WS_WD = 676 * MiB;
constexpr size_t WS_PROJ = 932 * MiB;
constexpr size_t WS_NEGW = 1508 * MiB;
constexpr size_t WS_QG = 1572 * MiB;
constexpr size_t WS_KDT = 1636 * MiB;
constexpr size_t WS_UT = 1700 * MiB;
constexpr size_t WS_QK = 1764 * MiB;
constexpr size_t WS_GL = 1796 * MiB;
constexpr size_t WS_QN = 1797 * MiB;
constexpr size_t WS_KN = 1861 * MiB;
constexpr size_t WS_OA = 1925 * MiB;
constexpr size_t WS_OB = 1989 * MiB;
constexpr size_t WS_TMP = 2053 * MiB;
constexpr size_t WS_MRG = 2181 * MiB;
constexpr size_t WS_LIST = 2245 * MiB;
constexpr size_t WS_WLIST = 2247 * MiB;
constexpr size_t WS_TINFO = 2249 * MiB;
constexpr size_t WS_ACT = 2250 * MiB;
constexpr size_t WS_YS = 2538 * MiB;
constexpr size_t WS_H8 = 2826 * MiB;
constexpr size_t WS_WIN8 = 2858 * MiB;
constexpr size_t WS_GVBT = 2866 * MiB, WS_GKBGT = 2930 * MiB;
constexpr size_t WS_VBUF = 2994 * MiB;
constexpr size_t WS_END = 3058 * MiB;

#define XB_TMO      128
#define XB_XCNT(j)  (256  + 64 * (j))
#define XB_XSUB(j)  (1280 + 64 * (j))
#define XB_XGEN(j)  (2304 + 64 * (j))
#define XB_TOP      3328
#define XB_TOPGEN   3392
#define XCD_BAR_WORDS 3456
#define XB_SPIN_CAP (1u << 19)
constexpr int CW_QUEUE = 4096;
constexpr int CW_CNT = 8192;

typedef __bf16 bf16v2_t __attribute__((ext_vector_type(2)));
DI unsigned cvt_pk_bf16(float lo, float hi) { f32x2 v = {lo, hi}; bf16v2_t r = __builtin_convertvector(v, bf16v2_t); return __builtin_bit_cast(unsigned, r); }
DI float bf2f(unsigned short v) { return __uint_as_float(((unsigned)v) << 16); }
DI float bflo(unsigned w) { return __uint_as_float(w << 16); }
DI float bfhi(unsigned w) { return __uint_as_float(w & 0xffff0000u); }
DI float sigmoidf_(float x) { return __builtin_amdgcn_rcpf(1.f + __expf(-x)); }
DI float siluf_(float x) { return x * __builtin_amdgcn_rcpf(1.f + __expf(-x)); }
DI unsigned cvt4_fp8(float a, float b, float c, float d) { int w = __builtin_amdgcn_cvt_pk_fp8_f32(a, b, 0, false); w = __builtin_amdgcn_cvt_pk_fp8_f32(c, d, w, true); return (unsigned)w; }
constexpr float Y8_SCALE = 16.f;
constexpr float W8_SCALE = 64.f, H8_SCALE = 2.f, A8_SCALE = 4.f;
#define MFMA16(a, b, c) __builtin_amdgcn_mfma_f32_16x16x32_bf16((a), (b), (c), 0, 0, 0)
#define MFMA32(a, b, c) __builtin_amdgcn_mfma_f32_32x32x16_bf16((a), (b), (c), 0, 0, 0)
#define WAIT_V(n) asm volatile("s_waitcnt vmcnt(" #n ")" ::: "memory")
#define WAIT_L(n) asm volatile("s_waitcnt lgkmcnt(" #n ")" ::: "memory")
#define BAR() __builtin_amdgcn_s_barrier()
#define SCHED() __builtin_amdgcn_sched_barrier(0)
#define LDS_BAR() do { asm volatile("s_waitcnt lgkmcnt(0)" ::: "memory"); __builtin_amdgcn_s_barrier(); asm volatile("" ::: "memory"); } while (0)

DI unsigned xb_ld(unsigned* p)              { return __hip_atomic_load(p, __ATOMIC_RELAXED, __HIP_MEMORY_SCOPE_AGENT); }
DI unsigned xb_add(unsigned* p, unsigned v) { return __hip_atomic_fetch_add(p, v, __ATOMIC_RELAXED, __HIP_MEMORY_SCOPE_AGENT); }
DI unsigned xb_xcc_id() { return (unsigned)__builtin_amdgcn_s_getreg((3 << 11) | 20) & 0xFu; }
#define XB_SPIN(cond, bar) do { unsigned _sp = 0; while (cond) { __builtin_amdgcn_s_sleep(1); \
    if ((++_sp & 255u) == 0u) { if (xb_ld(&(bar)[XB_TMO])) break; if (_sp > XB_SPIN_CAP) { atomicAdd(&(bar)[XB_TMO], 1u); break; } } } } while (0)
struct XcdBarrier { unsigned* bar; unsigned x; volatile LAS unsigned* st; };
DI XcdBarrier xcd_barrier_post(unsigned* bar, volatile LAS unsigned* st) {
    XcdBarrier b; b.bar = bar; b.x = xb_xcc_id(); b.st = st;
    if (threadIdx.x == 0) (void)xb_add(&bar[XB_XCNT(b.x)], 1u);
    return b;
}
DI void xcd_barrier_complete(unsigned* bar, unsigned x, unsigned& nloc, unsigned& nx) {
    const unsigned G = gridDim.x * gridDim.y * gridDim.z;
    unsigned sum, cnt, mine, sp = 0u;
    for (;;) {
        sum = 0u; cnt = 0u; mine = 0u;
#pragma unroll
        for (unsigned j = 0; j < 16; ++j) { const unsigned c = xb_ld(&bar[XB_XCNT(j)]); sum += c; cnt += (c > 0u) ? 1u : 0u; mine = (j == x) ? c : mine; }
        if (sum == G) break;
        __builtin_amdgcn_s_sleep(1);
        if ((++sp & 255u) == 0u) { if (xb_ld(&bar[XB_TMO])) break; if (sp > XB_SPIN_CAP) { atomicAdd(&bar[XB_TMO], 1u); break; } }
    }
    nloc = mine > 0u ? mine : 1u; nx = cnt > 0u ? cnt : 1u;
}
DI void xcd_barrier(const XcdBarrier& b) {
    asm volatile("s_waitcnt vmcnt(0)" ::: "memory");
    __syncthreads();
    if (threadIdx.x == 0) {
        unsigned* bar = b.bar;
        __builtin_amdgcn_s_waitcnt(0);
        unsigned nloc = b.st[0], nx = b.st[1];
        if (nloc == 0u) { xcd_barrier_complete(bar, b.x, nloc, nx); b.st[0] = nloc; b.st[1] = nx; }
        const unsigned old = xb_add(&bar[XB_XSUB(b.x)], 1u);
        const unsigned gen = old / nloc;
        if (old + 1u == (gen + 1u) * nloc) {
            __builtin_amdgcn_fence(__ATOMIC_RELEASE, "agent");
            asm volatile("s_waitcnt vmcnt(0)" ::: "memory");
            const unsigned og = xb_add(&bar[XB_TOP], 1u);
            const unsigned tg = og / nx;
            if (og + 1u == (tg + 1u) * nx) xb_add(&bar[XB_TOPGEN], 1u);
            else XB_SPIN(xb_ld(&bar[XB_TOPGEN]) == tg, bar);
            __builtin_amdgcn_fence(__ATOMIC_ACQUIRE, "agent");
            xb_add(&bar[XB_XGEN(b.x)], 1u);
            asm volatile("s_waitcnt vmcnt(0)" ::: "memory");
        } else {
            XB_SPIN(xb_ld(&bar[XB_XGEN(b.x)]) == gen, bar);
            __builtin_amdgcn_fence(__ATOMIC_ACQUIRE, "agent");
            asm volatile("s_waitcnt vmcnt(0)" ::: "memory");
        }
    }
    __syncthreads();
}

struct Params {
    const float* x; const int* positions; const float* norm1_g; const float* w_in; const float* b_gate; const float* conv_w;
    const float* a_log; const float* dt_bias; const float* gdn_norm_g; const float* q_norm_g; const float* k_norm_g;
    const float* lq1; const float* lk1; const float* lq2; const float* lk2; const float* subln_g;
    const float* w_a; const float* w_b; const float* w_out; const float* norm2_g; const float* w_router; const float* b_router;
    const float* w_gu; const float* b_gu; const float* w_down; const float* b_down;
    float* out; unsigned char* ws;
    int ph_lo, ph_hi;
};

constexpr int LDS_MISC = 3072;
constexpr int LDS_BYTES = 160 * 1024 - 1024;

struct CvtTile { const float* src; int ld; unsigned char* dst; int ldd; int f8; };
constexpr int CVT_NT = 2304 + 768 + 16384 + 8192;

DI CvtTile cvt_tile_of(const Params& p, int t) {
    CvtTile c;
    if (t < 2304) {
        const int kb = t / 144, nb = t % 144, n1 = nb * 128, sc = n1 < 8192 ? n1 : n1 + 32;
        c.src = p.w_in + (size_t)kb * 128 * IN_COLS + sc; c.ld = IN_COLS;
        if (n1 >= PC_GATE) { c.dst = p.ws + WS_WIN8 + (size_t)(n1 - PC_GATE) * 2048 + kb * 128; c.ldd = 2048; c.f8 = 1; }
        else if (n1 >= PC_Z && n1 < PC_QB) { c.dst = p.ws + WS_WIN8 + (size_t)(4096 + n1 - PC_Z) * 2048 + kb * 128; c.ldd = 2048; c.f8 = 1; }
        else { c.dst = p.ws + WS_WIN + ((size_t)n1 * 2048 + kb * 128) * 2; c.ldd = 4096; c.f8 = 0; }
    } else if (t < 3072) {
        const int m = (t - 2304) >> 8, r = (t - 2304) & 255, kb = r >> 4, nb = r & 15;
        const float* s = m == 0 ? p.w_a : (m == 1 ? p.w_b : p.w_out);
        const size_t d = m == 0 ? WS_WA : (m == 1 ? WS_WB : WS_WO);
        c.src = s + (size_t)kb * 128 * 2048 + nb * 128; c.ld = 2048;
        c.dst = p.ws + d + ((size_t)nb * 128 * 2048 + kb * 128) * 2; c.ldd = 4096; c.f8 = 0;
    } else if (t < 3072 + 16384) {
        const int r = t - 3072, e = r >> 9, r2 = r & 511, kb = r2 >> 5, nb = r2 & 31;
        const int drow = nb < 16 ? nb * 256 : (nb - 16) * 256 + 128;
        c.src = p.w_gu + (size_t)e * 2048 * 4096 + (size_t)kb * 128 * 4096 + nb * 128; c.ld = 4096;
        c.dst = p.ws + WS_WGU + ((size_t)e * 4096 + drow) * 2048 + kb * 128; c.ldd = 2048; c.f8 = 1;
    } else {
        const int r = t - 19456, e = r >> 8, r2 = r & 255, kb = r2 >> 4, nb = r2 & 15;
        c.src = p.w_down + (size_t)e * 2048 * 2048 + (size_t)kb * 128 * 2048 + nb * 128; c.ld = 2048;
        c.dst = p.ws + WS_WD + ((size_t)e * 2048 + nb * 128) * 2048 + kb * 128; c.ldd = 2048; c.f8 = 1;
    }
    return c;
}

DI void cvt_store(const CvtTile& cur, const LAS float* tile, int tid) {
    const int n = tid & 127, kseg = (tid >> 7) * 32;
    if (cur.f8) {
        u32x4 w[2];
#pragma unroll
        for (int g = 0; g < 8; ++g) {
            float e[4];
#pragma unroll
            for (int j = 0; j < 4; ++j) e[j] = tile[(kseg + g * 4 + j) * 132 + n] * W8_SCALE;
            w[g >> 2][g & 3] = cvt4_fp8(e[0], e[1], e[2], e[3]);
        }
        *(u32x4*)(cur.dst + (size_t)n * cur.ldd + kseg) = w[0]; *(u32x4*)(cur.dst + (size_t)n * cur.ldd + kseg + 16) = w[1];
    } else {
#pragma unroll
        for (int g = 0; g < 4; ++g) {
            float e[8];
#pragma unroll
            for (int j = 0; j < 8; ++j) e[j] = tile[(kseg + g * 8 + j) * 132 + n];
            u32x4 w = {cvt_pk_bf16(e[0], e[1]), cvt_pk_bf16(e[2], e[3]), cvt_pk_bf16(e[4], e[5]), cvt_pk_bf16(e[6], e[7])};
            *(u32x4*)(cur.dst + (size_t)n * cur.ldd + (kseg + g * 8) * 2) = w;
        }
    }
}
template <int NT>
DI void cvt_tiles(const Params& p, LAS char* lds, int t0, int step) {
    int tid_ = threadIdx.x; asm volatile("" : "+v"(tid_));
    const int tid = tid_;
    LAS float* tile = (LAS float*)(lds + LDS_MISC);
    f32x4 v[4][8]; CvtTile c[4];
#define CV_LOAD(s_, t) do { const int sl_ = (s_); c[sl_] = cvt_tile_of(p, t); _Pragma("unroll") for (int i_ = 0; i_ < 8; ++i_) { const int idx = tid + 512 * i_; \
        const float* a_ = c[sl_].src + (size_t)(idx >> 5) * c[sl_].ld + (idx & 31) * 4; asm volatile("global_load_dwordx4 %0, %1, off nt" : "=v"(v[sl_][i_]) : "v"(a_) : "memory"); } } while (0)
#define CV_BAR() do { asm volatile("s_waitcnt lgkmcnt(0)" ::: "memory"); __builtin_amdgcn_s_barrier(); asm volatile("" ::: "memory"); } while (0)
#pragma unroll
    for (int i = 0; i < 4; ++i) if (i < NT) CV_LOAD(i, t0 + i * step);
#pragma unroll
    for (int i = 0; i < NT; ++i) {
        const int younger = (NT - 1 - i) < 3 ? (NT - 1 - i) : 3;
        if (younger == 3) asm volatile("s_waitcnt vmcnt(24)" ::: "memory");
        else if (younger == 2) asm volatile("s_waitcnt vmcnt(16)" ::: "memory");
        else if (younger == 1) asm volatile("s_waitcnt vmcnt(8)" ::: "memory");
        else asm volatile("s_waitcnt vmcnt(0)" ::: "memory");
#pragma unroll
        for (int q = 0; q < 8; ++q) { const int idx = tid + 512 * q; *(LAS f32x4*)(tile + (idx >> 5) * 132 + (idx & 31) * 4) = v[i & 3][q]; }
        CV_BAR();
        const CvtTile cur = c[i & 3];
        if (i + 4 < NT) CV_LOAD(i & 3, t0 + (i + 4) * step);
        cvt_store(cur, tile, tid);
        CV_BAR();
    }
#undef CV_LOAD
#undef CV_BAR
}

DI void p0_prologue(const Params& p, LAS char* lds) {
    const int tid = threadIdx.x, lane = tid & 63, wave = tid >> 6;
    {
        bf16_t* h = (bf16_t*)(p.ws + WS_H);
        for (int row = blockIdx.x * 8 + wave; row < NTOK; row += gridDim.x * 8) {
            const float* xr = p.x + (size_t)row * DM;
            f32x4 v[8]; float ss = 0.f;
#pragma unroll
            for (int i = 0; i < 8; ++i) { v[i] = *(const f32x4*)(xr + (i * 64 + lane) * 4); ss += v[i][0] * v[i][0] + v[i][1] * v[i][1] + v[i][2] * v[i][2] + v[i][3] * v[i][3]; }
#pragma unroll
            for (int o = 32; o >= 1; o >>= 1) ss += __shfl_xor(ss, o);
            const float rs = rsqrtf(ss * (1.f / DM) + NORM_EPS);
#pragma unroll
            for (int i = 0; i < 8; ++i) {
                const f32x4 g = *(const f32x4*)(p.norm1_g + (i * 64 + lane) * 4);
                u32x2 w; w[0] = cvt_pk_bf16(v[i][0] * rs * g[0], v[i][1] * rs * g[1]); w[1] = cvt_pk_bf16(v[i][2] * rs * g[2], v[i][3] * rs * g[3]);
                *(u32x2*)(h + (size_t)row * DM + (i * 64 + lane) * 4) = w;
                const float rs2 = rs * H8_SCALE;
                *(unsigned*)(p.ws + WS_H8 + (size_t)row * DM + (i * 64 + lane) * 4) = cvt4_fp8(v[i][0] * rs2 * g[0], v[i][1] * rs2 * g[1], v[i][2] * rs2 * g[2], v[i][3] * rs2 * g[3]);
            }
        }
    }
    {
        bf16_t* wsl = (bf16_t*)(p.ws + WS_WS); bf16_t* rhi = wsl + 32 * 2048; bf16_t* rlo = rhi + 32 * 2048;
        for (int idx = blockIdx.x * 512 + tid; idx < 32 * 2048; idx += gridDim.x * 512) {
            const int n = idx >> 11, k = idx & 2047;
            const float a = p.w_in[(size_t)k * IN_COLS + 8192 + n];
            wsl[idx] = (bf16_t)(cvt_pk_bf16(a, 0.f) & 0xffff);
            const float r = p.w_router[k * 32 + n];
            const unsigned hi = cvt_pk_bf16(r, 0.f) & 0xffff; const float rem = r - bflo(hi);
            rhi[idx] = (bf16_t)hi; rlo[idx] = (bf16_t)(cvt_pk_bf16(rem, 0.f) & 0xffff);
        }
    }
    if (gridDim.x == 256) cvt_tiles<12>(p, lds, blockIdx.x, 256);
    else for (int t = blockIdx.x; t < 3072; t += gridDim.x) cvt_tiles<1>(p, lds, t, 0);
    __syncthreads();
}

constexpr int G_HT = 128 * 64;
DI int lds_byte(int r, int c) { const int st = (r >> 4) * 2 + (c >> 5), rr = r & 15, cc = c & 31, ob = rr * 64 + cc * 2; return st * 1024 + (ob ^ (((ob >> 9) & 1) << 5)); }
DI int perm32(int rho) { const int n = rho >> 4, i = rho & 15; return 8 * (i >> 2) + 4 * n + (i & 3); }
DI void stage_rc(int b, int& R, int& C) { const int st = b / 1024, sb = b % 1024, swz = sb ^ (((sb >> 9) & 1) << 5); R = (st >> 1) * 16 + swz / 64; C = (st & 1) * 32 + (swz % 64) / 2; }

typedef int i32x8 __attribute__((ext_vector_type(8)));
typedef int i32x4 __attribute__((ext_vector_type(4)));
DI i32x8 cat8(bf16x8 a, bf16x8 b) { const i32x4 x = __builtin_bit_cast(i32x4, a), y = __builtin_bit_cast(i32x4, b); return __builtin_shufflevector(x, y, 0, 1, 2, 3, 4, 5, 6, 7); }
DI void mfma_f8(f32x4& acc, i32x8 a, i32x8 b, int one8) {
    asm volatile("s_nop 1\n\tv_mfma_scale_f32_16x16x128_f8f6f4 %0, %1, %2, %0, %3, %3 op_sel_hi:[0,0,0]" : "+v"(acc) : "v"(a), "v"(b), "v"(one8));
}
template <bool GATHER, bool PERM>
DI void gemm_issue(const bf16_t* A, int lda, int brow, const LAS int* rowidx, const bf16_t* Bt, int K, LAS char* stage) {
    LAS bf16_t* shm = (LAS bf16_t*)stage;
    int tid = threadIdx.x; asm volatile("" : "+v"(tid));
    const int wv = __builtin_amdgcn_readfirstlane(tid >> 6);
    int R0, C0; stage_rc(tid * 16, R0, C0);
    const __amdgpu_buffer_rsrc_t rsA = __builtin_amdgcn_make_buffer_rsrc((void*)A, 0, 0x7fffffff, 0x00020000);
    const __amdgpu_buffer_rsrc_t rsB = __builtin_amdgcn_make_buffer_rsrc((void*)Bt, 0, 0x7fffffff, 0x00020000);
    const int Rb = PERM ? ((R0 & ~31) + perm32(R0 & 31)) : R0;
    const unsigned bgb = ((unsigned)Rb * (unsigned)K + C0) * 2u;
#define GI_A(b, h, kt) do { _Pragma("unroll") for (int _i = 0; _i < 2; ++_i) { const int r_ = (h) * 128 + _i * 64 + R0; \
        const unsigned o_ = ((GATHER ? (unsigned)rowidx[r_] : (unsigned)(brow + r_)) * (unsigned)lda + C0) * 2u; \
        __builtin_amdgcn_raw_ptr_buffer_load_lds(rsA, (LAS unsigned*)((LAS char*)(shm + ((b) * 2 + (h)) * G_HT) + wv * 1024 + _i * 8192), 16, o_, (kt) * 128, 0, 0); } } while (0)
#define GI_B(b, h, kt) do { _Pragma("unroll") for (int _i = 0; _i < 2; ++_i) \
        __builtin_amdgcn_raw_ptr_buffer_load_lds(rsB, (LAS unsigned*)((LAS char*)(shm + (4 + (b) * 2 + (h)) * G_HT) + wv * 1024 + _i * 8192), 16, bgb, (((h) * 128 + _i * 64) * K + (kt) * 64) * 2, 0, 0); } while (0)
    GI_B(0, 0, 0); GI_A(0, 0, 0); GI_B(0, 1, 0); GI_A(0, 1, 0); GI_B(1, 0, 1); GI_A(1, 0, 1); GI_B(1, 1, 1);
#undef GI_A
#undef GI_B
}
struct NoNext { DI void operator()() const {} };

template <bool GATHER, bool FP8, bool ZERO, class Epi, class Next>
DI void gemm_tile_acc(const bf16_t* A, int lda, int brow, const LAS int* rowidx, const bf16_t* Bt, int K, LAS char* stage, const Epi& epi, bool pre, const Next& next, f32x4 (&acc)[2][2][4][2]) {
    LAS bf16_t* shm = (LAS bf16_t*)stage;
#define SA(b, h) (shm + ((b) * 2 + (h)) * G_HT)
#define SB(b, h) (shm + (4 + (b) * 2 + (h)) * G_HT)
    int tid = threadIdx.x;
    const int wv = __builtin_amdgcn_readfirstlane(tid >> 6);
    int R0, C0; stage_rc(tid * 16, R0, C0);
    unsigned agb[2][2];
    if (GATHER) {
#pragma unroll
        for (int h = 0; h < 2; ++h)
#pragma unroll
            for (int i = 0; i < 2; ++i) agb[h][i] = ((unsigned)rowidx[h * 128 + i * 64 + R0] * (unsigned)lda + C0) * 2u;
    } else {
#pragma unroll
        for (int h = 0; h < 2; ++h)
#pragma unroll
            for (int i = 0; i < 2; ++i) agb[h][i] = ((unsigned)(brow + h * 128 + i * 64 + R0) * (unsigned)lda + C0) * 2u;
    }
    const int Rb = Epi::PERM ? ((R0 & ~31) + perm32(R0 & 31)) : R0;
    const unsigned bgb = ((unsigned)Rb * (unsigned)K + C0) * 2u;
    const __amdgpu_buffer_rsrc_t rsA = __builtin_amdgcn_make_buffer_rsrc((void*)A, 0, 0x7fffffff, 0x00020000);
    const __amdgpu_buffer_rsrc_t rsB = __builtin_amdgcn_make_buffer_rsrc((void*)Bt, 0, 0x7fffffff, 0x00020000);
#define STAGE_A(P, h, kt) do { _Pragma("unroll") for (int _i = 0; _i < 2; ++_i) \
        __builtin_amdgcn_raw_ptr_buffer_load_lds(rsA, (LAS unsigned*)((LAS char*)(P) + wv * 1024 + _i * 8192), 16, agb[h][_i], (kt) * 128, 0, 0); } while (0)
#define STAGE_B(P, h, kt) do { _Pragma("unroll") for (int _i = 0; _i < 2; ++_i) \
        __builtin_amdgcn_raw_ptr_buffer_load_lds(rsB, (LAS unsigned*)((LAS char*)(P) + wv * 1024 + _i * 8192), 16, bgb, (((h) * 128 + _i * 64) * K + (kt) * 64) * 2, 0, 0); } while (0)
#define LDA(dst, b, h) _Pragma("unroll") for (int m = 0; m < 4; ++m) _Pragma("unroll") for (int k = 0; k < 2; ++k) \
        dst[m][k] = *(const LAS bf16x8*)((LAS char*)SA(b, h) + lds_byte(wr * 64 + m * 16 + fr, k * 32 + fq * 8))
#define LDB(dst, b, h) _Pragma("unroll") for (int n = 0; n < 2; ++n) _Pragma("unroll") for (int k = 0; k < 2; ++k) \
        dst[n][k] = *(const LAS bf16x8*)((LAS char*)SB(b, h) + lds_byte(wc * 32 + n * 16 + fr, k * 32 + fq * 8))
#define MMA(ai, bj, At_, Bt_) do { __builtin_amdgcn_s_setprio(1); \
        if (!FP8) { _Pragma("unroll") for (int m = 0; m < 4; ++m) _Pragma("unroll") for (int n = 0; n < 2; ++n) _Pragma("unroll") for (int k = 0; k < 2; ++k) \
            acc[ai][bj][m][n] = MFMA16(Bt_[n][k], At_[m][k], acc[ai][bj][m][n]); } \
        else { _Pragma("unroll") for (int m = 0; m < 4; ++m) _Pragma("unroll") for (int n = 0; n < 2; ++n) \
            mfma_f8(acc[ai][bj][m][n], cat8(Bt_[n][0], Bt_[n][1]), cat8(At_[m][0], At_[m][1]), one8); } \
        __builtin_amdgcn_s_setprio(0); } while (0)

    int wid = tid >> 6, lane = tid & 63, wr = wid >> 2, wc = wid & 3, fr = lane & 15, fq = lane >> 4;
    if (ZERO) {
#pragma unroll
    for (int a = 0; a < 2; ++a)
#pragma unroll
        for (int b = 0; b < 2; ++b)
#pragma unroll
            for (int m = 0; m < 4; ++m)
#pragma unroll
                for (int n = 0; n < 2; ++n) acc[a][b][m][n] = (f32x4){0.f, 0.f, 0.f, 0.f};
    }
    bf16x8 At[4][2], B0[2][2], B1[2][2];
    const int one8 = 0x7f7f7f7f;
    const int nt = K / 64;
    if (!pre) {
        WAIT_V(0);
        STAGE_B(SB(0, 0), 0, 0); STAGE_A(SA(0, 0), 0, 0);
        STAGE_B(SB(0, 1), 1, 0); STAGE_A(SA(0, 1), 1, 0);
        if (wr == 1) BAR();
        WAIT_V(4); BAR();
        STAGE_B(SB(1, 0), 0, 1); STAGE_A(SA(1, 0), 0, 1); STAGE_B(SB(1, 1), 1, 1);
        WAIT_V(6); BAR();
    } else {
        if (wr == 1) BAR();
        WAIT_V(0); BAR();
        BAR();
    }
    for (int t = 0; t < nt - 2; t += 2) {
        LDB(B0, 0, 0); SCHED(); LDA(At, 0, 0); STAGE_A(SA(1, 1), 1, t + 1);
        WAIT_L(8); BAR(); WAIT_L(0); MMA(0, 0, At, B0); BAR(); SCHED();
        LDB(B1, 0, 1); STAGE_B(SB(0, 0), 0, t + 2);
        BAR(); WAIT_L(0); MMA(0, 1, At, B1); BAR();
        LDA(At, 0, 1); STAGE_A(SA(0, 0), 0, t + 2);
        BAR(); WAIT_L(0); MMA(1, 0, At, B0); BAR(); SCHED();
        STAGE_B(SB(0, 1), 1, t + 2);
        WAIT_V(6); BAR(); MMA(1, 1, At, B1); BAR();
        LDB(B0, 1, 0); SCHED(); LDA(At, 1, 0); STAGE_A(SA(0, 1), 1, t + 2);
        WAIT_L(8); BAR(); WAIT_L(0); MMA(0, 0, At, B0); BAR(); SCHED();
        LDB(B1, 1, 1); STAGE_B(SB(1, 0), 0, t + 3);
        BAR(); WAIT_L(0); MMA(0, 1, At, B1); BAR();
        LDA(At, 1, 1); STAGE_A(SA(1, 0), 0, t + 3);
        BAR(); WAIT_L(0); MMA(1, 0, At, B0); BAR(); SCHED();
        STAGE_B(SB(1, 1), 1, t + 3);
        WAIT_V(6); BAR(); MMA(1, 1, At, B1); BAR();
    }
    { LDB(B0, 0, 0); WAIT_V(0); LDA(At, 0, 0); STAGE_A(SA(1, 1), 1, nt - 1);
      BAR(); WAIT_L(0); MMA(0, 0, At, B0); BAR();
      LDB(B1, 0, 1); BAR(); WAIT_L(0); MMA(0, 1, At, B1); BAR();
      LDA(At, 0, 1); WAIT_V(4); BAR(); WAIT_L(0); MMA(1, 0, At, B0); MMA(1, 1, At, B1); BAR(); }
    { LDB(B0, 1, 0); LDA(At, 1, 0); WAIT_V(2); BAR(); WAIT_L(0); MMA(0, 0, At, B0); BAR();
      LDB(B1, 1, 1); WAIT_V(0); BAR(); WAIT_L(0); MMA(0, 1, At, B1); BAR();
      LDA(At, 1, 1); BAR(); WAIT_L(0); MMA(1, 0, At, B0); MMA(1, 1, At, B1); BAR(); }
    if (wr == 0) BAR();
    if (FP8) asm volatile("s_nop 15\n\ts_nop 15" ::: "memory");
    int tz = threadIdx.x; asm volatile("" : "+v"(tz)); wid = tz >> 6; lane = tz & 63; wr = wid >> 2; wc = wid & 3; fr = lane & 15; fq = lane >> 4;
    next();
    epi(acc, wr, wc, fr, fq);
#undef SA
#undef SB
#undef STAGE_A
#undef STAGE_B
#undef LDA
#undef LDB
#undef MMA
}
template <class Epi, class Mid, class Next>
DI void gemm_tile_dual(const bf16_t* A, const bf16_t* A2, int lda, int brow, const bf16_t* Bt, const bf16_t* Bt2, int K, LAS char* stage, const Epi& epi, const Mid& mid, bool pre, const Next& next) {
    constexpr bool GATHER = false, FP8 = false, ZERO = true; const LAS int* rowidx = nullptr; (void)rowidx;
    f32x4 acc[2][2][4][2];
    LAS bf16_t* shm = (LAS bf16_t*)stage;
#define SA(b, h) (shm + ((b) * 2 + (h)) * G_HT)
#define SB(b, h) (shm + (4 + (b) * 2 + (h)) * G_HT)
    int tid = threadIdx.x;
    const int wv = __builtin_amdgcn_readfirstlane(tid >> 6);
    int R0, C0; stage_rc(tid * 16, R0, C0);
    unsigned agb[2][2];
    if (GATHER) {
#pragma unroll
        for (int h = 0; h < 2; ++h)
#pragma unroll
            for (int i = 0; i < 2; ++i) agb[h][i] = ((unsigned)rowidx[h * 128 + i * 64 + R0] * (unsigned)lda + C0) * 2u;
    } else {
#pragma unroll
        for (int h = 0; h < 2; ++h)
#pragma unroll
            for (int i = 0; i < 2; ++i) agb[h][i] = ((unsigned)(brow + h * 128 + i * 64 + R0) * (unsigned)lda + C0) * 2u;
    }
    const int Rb = Epi::PERM ? ((R0 & ~31) + perm32(R0 & 31)) : R0;
    const unsigned bgb = ((unsigned)Rb * (unsigned)K + C0) * 2u;
    const __amdgpu_buffer_rsrc_t rsA = __builtin_amdgcn_make_buffer_rsrc((void*)A, 0, 0x7fffffff, 0x00020000);
    const __amdgpu_buffer_rsrc_t rsB = __builtin_amdgcn_make_buffer_rsrc((void*)Bt, 0, 0x7fffffff, 0x00020000);
    const __amdgpu_buffer_rsrc_t rsA2 = __builtin_amdgcn_make_buffer_rsrc((void*)A2, 0, 0x7fffffff, 0x00020000);
    const __amdgpu_buffer_rsrc_t rsB2 = __builtin_amdgcn_make_buffer_rsrc((void*)Bt2, 0, 0x7fffffff, 0x00020000);
    const int nt1 = K / 64;
#define STAGE_A(P, h, kt) do { const int kt_ = (kt); _Pragma("unroll") for (int _i = 0; _i < 2; ++_i) { \
        if (kt_ < nt1) __builtin_amdgcn_raw_ptr_buffer_load_lds(rsA, (LAS unsigned*)((LAS char*)(P) + wv * 1024 + _i * 8192), 16, agb[h][_i], kt_ * 128, 0, 0); \
        else __builtin_amdgcn_raw_ptr_buffer_load_lds(rsA2, (LAS unsigned*)((LAS char*)(P) + wv * 1024 + _i * 8192), 16, agb[h][_i], (kt_ - nt1) * 128, 0, 0); } } while (0)
#define STAGE_B(P, h, kt) do { const int kt_ = (kt); _Pragma("unroll") for (int _i = 0; _i < 2; ++_i) { \
        if (kt_ < nt1) __builtin_amdgcn_raw_ptr_buffer_load_lds(rsB, (LAS unsigned*)((LAS char*)(P) + wv * 1024 + _i * 8192), 16, bgb, (((h) * 128 + _i * 64) * K + kt_ * 64) * 2, 0, 0); \
        else __builtin_amdgcn_raw_ptr_buffer_load_lds(rsB2, (LAS unsigned*)((LAS char*)(P) + wv * 1024 + _i * 8192), 16, bgb, (((h) * 128 + _i * 64) * K + (kt_ - nt1) * 64) * 2, 0, 0); } } while (0)
#define LDA(dst, b, h) _Pragma("unroll") for (int m = 0; m < 4; ++m) _Pragma("unroll") for (int k = 0; k < 2; ++k) \
        dst[m][k] = *(const LAS bf16x8*)((LAS char*)SA(b, h) + lds_byte(wr * 64 + m * 16 + fr, k * 32 + fq * 8))
#define LDB(dst, b, h) _Pragma("unroll") for (int n = 0; n < 2; ++n) _Pragma("unroll") for (int k = 0; k < 2; ++k) \
        dst[n][k] = *(const LAS bf16x8*)((LAS char*)SB(b, h) + lds_byte(wc * 32 + n * 16 + fr, k * 32 + fq * 8))
#define MMA(ai, bj, At_, Bt_) do { __builtin_amdgcn_s_setprio(1); \
        if (!FP8) { _Pragma("unroll") for (int m = 0; m < 4; ++m) _Pragma("unroll") for (int n = 0; n < 2; ++n) _Pragma("unroll") for (int k = 0; k < 2; ++k) \
            acc[ai][bj][m][n] = MFMA16(Bt_[n][k], At_[m][k], acc[ai][bj][m][n]); } \
        else { _Pragma("unroll") for (int m = 0; m < 4; ++m) _Pragma("unroll") for (int n = 0; n < 2; ++n) \
            mfma_f8(acc[ai][bj][m][n], cat8(Bt_[n][0], Bt_[n][1]), cat8(At_[m][0], At_[m][1]), one8); } \
        __builtin_amdgcn_s_setprio(0); } while (0)

    int wid = tid >> 6, lane = tid & 63, wr = wid >> 2, wc = wid & 3, fr = lane & 15, fq = lane >> 4;
    if (ZERO) {
#pragma unroll
    for (int a = 0; a < 2; ++a)
#pragma unroll
        for (int b = 0; b < 2; ++b)
#pragma unroll
            for (int m = 0; m < 4; ++m)
#pragma unroll
                for (int n = 0; n < 2; ++n) acc[a][b][m][n] = (f32x4){0.f, 0.f, 0.f, 0.f};
    }
    bf16x8 At[4][2], B0[2][2], B1[2][2];
    const int one8 = 0x7f7f7f7f;
    const int nt = 2 * nt1;
    if (!pre) {
        WAIT_V(0);
        STAGE_B(SB(0, 0), 0, 0); STAGE_A(SA(0, 0), 0, 0);
        STAGE_B(SB(0, 1), 1, 0); STAGE_A(SA(0, 1), 1, 0);
        if (wr == 1) BAR();
        WAIT_V(4); BAR();
        STAGE_B(SB(1, 0), 0, 1); STAGE_A(SA(1, 0), 0, 1); STAGE_B(SB(1, 1), 1, 1);
        WAIT_V(6); BAR();
    } else {
        if (wr == 1) BAR();
        WAIT_V(0); BAR();
        BAR();
    }
    for (int t = 0; t < nt - 2; t += 2) {
        if (t == nt1) {
            int t2 = threadIdx.x; asm volatile("" : "+v"(t2));
            mid(acc, (t2 >> 6) >> 2, (t2 >> 6) & 3, (t2 & 63) & 15, (t2 & 63) >> 4);
        }
        LDB(B0, 0, 0); SCHED(); LDA(At, 0, 0); STAGE_A(SA(1, 1), 1, t + 1);
        WAIT_L(8); BAR(); WAIT_L(0); MMA(0, 0, At, B0); BAR(); SCHED();
        LDB(B1, 0, 1); STAGE_B(SB(0, 0), 0, t + 2);
        BAR(); WAIT_L(0); MMA(0, 1, At, B1); BAR();
        LDA(At, 0, 1); STAGE_A(SA(0, 0), 0, t + 2);
        BAR(); WAIT_L(0); MMA(1, 0, At, B0); BAR(); SCHED();
        STAGE_B(SB(0, 1), 1, t + 2);
        WAIT_V(6); BAR(); MMA(1, 1, At, B1); BAR();
        LDB(B0, 1, 0); SCHED(); LDA(At, 1, 0); STAGE_A(SA(0, 1), 1, t + 2);
        WAIT_L(8); BAR(); WAIT_L(0); MMA(0, 0, At, B0); BAR(); SCHED();
        LDB(B1, 1, 1); STAGE_B(SB(1, 0), 0, t + 3);
        BAR(); WAIT_L(0); MMA(0, 1, At, B1); BAR();
        LDA(At, 1, 1); STAGE_A(SA(1, 0), 0, t + 3);
        BAR(); WAIT_L(0); MMA(1, 0, At, B0); BAR(); SCHED();
        STAGE_B(SB(1, 1), 1, t + 3);
        WAIT_V(6); BAR(); MMA(1, 1, At, B1); BAR();
    }
    { LDB(B0, 0, 0); WAIT_V(0); LDA(At, 0, 0); STAGE_A(SA(1, 1), 1, nt - 1);
      BAR(); WAIT_L(0); MMA(0, 0, At, B0); BAR();
      LDB(B1, 0, 1); BAR(); WAIT_L(0); MMA(0, 1, At, B1); BAR();
      LDA(At, 0, 1); WAIT_V(4); BAR(); WAIT_L(0); MMA(1, 0, At, B0); MMA(1, 1, At, B1); BAR(); }
    { LDB(B0, 1, 0); LDA(At, 1, 0); WAIT_V(2); BAR(); WAIT_L(0); MMA(0, 0, At, B0); BAR();
      LDB(B1, 1, 1); WAIT_V(0); BAR(); WAIT_L(0); MMA(0, 1, At, B1); BAR();
      LDA(At, 1, 1); BAR(); WAIT_L(0); MMA(1, 0, At, B0); MMA(1, 1, At, B1); BAR(); }
    if (wr == 0) BAR();
    if (FP8) asm volatile("s_nop 15\n\ts_nop 15" ::: "memory");
    int tz = threadIdx.x; asm volatile("" : "+v"(tz)); wid = tz >> 6; lane = tz & 63; wr = wid >> 2; wc = wid & 3; fr = lane & 15; fq = lane >> 4;
    next();
    epi(acc, wr, wc, fr, fq);
#undef SA
#undef SB
#undef STAGE_A
#undef STAGE_B
#undef LDA
#undef LDB
#undef MMA
}
template <bool GATHER, bool FP8, class Epi, class Next>
DI void gemm_tile(const bf16_t* A, int lda, int brow, const LAS int* rowidx, const bf16_t* Bt, int K, LAS char* stage, const Epi& epi, bool pre, const Next& next) {
    f32x4 acc[2][2][4][2];
    gemm_tile_acc<GATHER, FP8, true>(A, lda, brow, rowidx, Bt, K, stage, epi, pre, next, acc);
}

DI bool unit_order(int i, int G, int c, int nM, int nN, int& pm, int& pn) {
    const int nwg = nM * nN; const long L = (long)i * G + c; if (L >= nwg) return false;
    int wgid = (int)L; { const int q = nwg / 8, r = nwg % 8, xcd = wgid % 8, off = wgid / 8; wgid = (xcd < r ? xcd * (q + 1) : r * (q + 1) + (xcd - r) * q) + off; }
    const int nig = 8 * nN, gid = wgid / nig, fm = gid * 8, gsz = (nM - fm) < 8 ? (nM - fm) : 8;
    pm = fm + ((wgid % nig) % gsz); pn = (wgid % nig) / gsz; return true;
}

#define EPI_LOOP(BODY) _Pragma("unroll") for (int ai = 0; ai < 2; ++ai) _Pragma("unroll") for (int m = 0; m < 4; ++m) { const int row = row0 + ai * 128 + m * 16; \
    _Pragma("unroll") for (int bj = 0; bj < 2; ++bj) _Pragma("unroll") for (int n = 0; n < 2; ++n) { const int col = col0 + bj * 128 + n * 16; f32x4 v = acc[ai][bj][m][n]; BODY } }

#define EPI_LOOP8(...) _Pragma("unroll") for (int ai = 0; ai < 2; ++ai) _Pragma("unroll") for (int m = 0; m < 4; ++m) { const int row = row0 + ai * 128 + m * 16; \
    _Pragma("unroll") for (int bj = 0; bj < 2; ++bj) { const int col = col0 + bj * 128; const f32x4 va = acc[ai][bj][m][0], vb = acc[ai][bj][m][1]; \
        float v[8] = {va[0], va[1], va[2], va[3], vb[0], vb[1], vb[2], vb[3]}; __VA_ARGS__ } }
struct EpiProj {
    static constexpr bool PERM = true;
    bf16_t* proj; const float* b_gate; int pm, pn; float sc; int ld, colsub;
    DI void operator()(f32x4 (&acc)[2][2][4][2], int wr, int wc, int fr, int fq) const {
        const int row0 = pm * 256 + wr * 64 + fr, col0 = pn * 256 + wc * 32 + fq * 8;
        const int kind = pn < 24 ? 0 : (pn < 32 ? 1 : (pn < 56 ? 0 : 2));
        EPI_LOOP8(
            v[0] *= sc; v[1] *= sc; v[2] *= sc; v[3] *= sc; v[4] *= sc; v[5] *= sc; v[6] *= sc; v[7] *= sc;
            if (kind == 1) { v[0] = siluf_(v[0]); v[1] = siluf_(v[1]); v[2] = siluf_(v[2]); v[3] = siluf_(v[3]); v[4] = siluf_(v[4]); v[5] = siluf_(v[5]); v[6] = siluf_(v[6]); v[7] = siluf_(v[7]); }
            if (kind == 2) { const f32x4 b0 = *(const f32x4*)(b_gate + (col - PC_GATE)), b1 = *(const f32x4*)(b_gate + (col - PC_GATE) + 4);
                v[0] = sigmoidf_(v[0] + b0[0]); v[1] = sigmoidf_(v[1] + b0[1]); v[2] = sigmoidf_(v[2] + b0[2]); v[3] = sigmoidf_(v[3] + b0[3]);
                v[4] = sigmoidf_(v[4] + b1[0]); v[5] = sigmoidf_(v[5] + b1[1]); v[6] = sigmoidf_(v[6] + b1[2]); v[7] = sigmoidf_(v[7] + b1[3]); }
            u32x4 w = {cvt_pk_bf16(v[0], v[1]), cvt_pk_bf16(v[2], v[3]), cvt_pk_bf16(v[4], v[5]), cvt_pk_bf16(v[6], v[7])};
            *(u32x4*)(proj + (size_t)row * ld + (col - colsub)) = w;
        )
    }
};
struct EpiScaleA {
    static constexpr bool PERM = true;
    const bf16_t* proj; int pm, pn;
    DI void operator()(f32x4 (&acc)[2][2][4][2], int wr, int wc, int fr, int fq) const {
        const int row0 = pm * 256 + wr * 64 + fr, col0 = pn * 256 + wc * 32 + fq * 8;
#pragma unroll
        for (int ai = 0; ai < 2; ++ai)
#pragma unroll
            for (int m = 0; m < 4; ++m) { const int row = row0 + ai * 128 + m * 16;
#pragma unroll
                for (int bj = 0; bj < 2; ++bj) { const int col = col0 + bj * 128;
                    const u32x4 ga = *(const u32x4*)(proj + (size_t)row * PROJ_LD + PC_GATE + col), gb = *(const u32x4*)(proj + (size_t)row * PROJ_LD + PC_GATE + 2048 + col);
                    f32x4 v0 = acc[ai][bj][m][0], v1 = acc[ai][bj][m][1];
                    v0[0] *= bflo(ga[0]) * __builtin_amdgcn_rcpf(fmaxf(bflo(gb[0]), 1e-18f)); v0[1] *= bfhi(ga[0]) * __builtin_amdgcn_rcpf(fmaxf(bfhi(gb[0]), 1e-18f));
                    v0[2] *= bflo(ga[1]) * __builtin_amdgcn_rcpf(fmaxf(bflo(gb[1]), 1e-18f)); v0[3] *= bfhi(ga[1]) * __builtin_amdgcn_rcpf(fmaxf(bfhi(gb[1]), 1e-18f));
                    v1[0] *= bflo(ga[2]) * __builtin_amdgcn_rcpf(fmaxf(bflo(gb[2]), 1e-18f)); v1[1] *= bfhi(ga[2]) * __builtin_amdgcn_rcpf(fmaxf(bfhi(gb[2]), 1e-18f));
                    v1[2] *= bflo(ga[3]) * __builtin_amdgcn_rcpf(fmaxf(bflo(gb[3]), 1e-18f)); v1[3] *= bfhi(ga[3]) * __builtin_amdgcn_rcpf(fmaxf(bfhi(gb[3]), 1e-18f));
                    acc[ai][bj][m][0] = v0; acc[ai][bj][m][1] = v1;
                } }
    }
};
struct EpiBranchB {
    static constexpr bool PERM = true;
    const bf16_t* proj; bf16_t* mrg; int pm, pn;
    DI void operator()(f32x4 (&acc)[2][2][4][2], int wr, int wc, int fr, int fq) const {
        const int row0 = pm * 256 + wr * 64 + fr, col0 = pn * 256 + wc * 32 + fq * 8;
        EPI_LOOP8(
            const u32x4 g = *(const u32x4*)(proj + (size_t)row * PROJ_LD + PC_GATE + 2048 + col);
            v[0] *= bflo(g[0]); v[1] *= bfhi(g[0]); v[2] *= bflo(g[1]); v[3] *= bfhi(g[1]); v[4] *= bflo(g[2]); v[5] *= bfhi(g[2]); v[6] *= bflo(g[3]); v[7] *= bfhi(g[3]);
            u32x4 w = {cvt_pk_bf16(v[0], v[1]), cvt_pk_bf16(v[2], v[3]), cvt_pk_bf16(v[4], v[5]), cvt_pk_bf16(v[6], v[7])};
            *(u32x4*)(mrg + (size_t)row * DM + col) = w;
        )
    }
};
struct EpiOut {
    static constexpr bool PERM = false;
    const float* x; float* out; int pm, pn;
    DI void operator()(f32x4 (&acc)[2][2][4][2], int wr, int wc, int fr, int fq) const {
        const int row0 = pm * 256 + wr * 64 + fr, col0 = pn * 256 + wc * 32 + fq * 4;
        EPI_LOOP(
            const f32x4 t = *(const f32x4*)(x + (size_t)row * DM + col);
            v += t;
            *(f32x4*)(out + (size_t)row * DM + col) = v;
        )
    }
};
struct EpiGateUp {
    static constexpr bool PERM = true;
    unsigned char* act; const float* bias; int slot0, nt;
    DI void operator()(f32x4 (&acc)[2][2][4][2], int wr, int wc, int fr, int fq) const {
        const int row0 = slot0 + wr * 64 + fr, col = nt * 128 + wc * 32 + fq * 8;
        constexpr float isc = 1.f / (W8_SCALE * H8_SCALE);
        const f32x4 bg0 = *(const f32x4*)(bias + col), bg1 = *(const f32x4*)(bias + col + 4), bu0 = *(const f32x4*)(bias + 2048 + col), bu1 = *(const f32x4*)(bias + 2048 + col + 4);
#pragma unroll
        for (int ai = 0; ai < 2; ++ai)
#pragma unroll
            for (int m = 0; m < 4; ++m) {
                const int row = row0 + ai * 128 + m * 16;
                const f32x4 g0 = acc[ai][0][m][0] * isc + bg0, g1 = acc[ai][0][m][1] * isc + bg1, u0 = acc[ai][1][m][0] * isc + bu0, u1 = acc[ai][1][m][1] * isc + bu1;
                float r[8];
#pragma unroll
                for (int j = 0; j < 4; ++j) {
                    const float ga = fminf(g0[j], 7.f), ua = fminf(fmaxf(u0[j], -7.f), 7.f); r[j] = (ua + 1.f) * ga * sigmoidf_(1.702f * ga) * A8_SCALE;
                    const float gb = fminf(g1[j], 7.f), ub = fminf(fmaxf(u1[j], -7.f), 7.f); r[4 + j] = (ub + 1.f) * gb * sigmoidf_(1.702f * gb) * A8_SCALE;
                }
                u32x2 w; w[0] = cvt4_fp8(r[0], r[1], r[2], r[3]); w[1] = cvt4_fp8(r[4], r[5], r[6], r[7]);
                *(u32x2*)(act + (size_t)row * DM + col) = w;
            }
    }
};
struct EpiDown {
    static constexpr bool PERM = true;
    unsigned char* ys; const float* bias; const float* wrow; int slot0, pn;
    DI void operator()(f32x4 (&acc)[2][2][4][2], int wr, int wc, int fr, int fq) const {
        const int r0 = wr * 64 + fr, col0 = pn * 256 + wc * 32 + fq * 8;
        constexpr float isc = 1.f / (W8_SCALE * A8_SCALE);
#pragma unroll
        for (int bj = 0; bj < 2; ++bj) {
            const int col = col0 + bj * 128;
            const f32x4 b0 = *(const f32x4*)(bias + col), b1 = *(const f32x4*)(bias + col + 4);
#pragma unroll
            for (int ai = 0; ai < 2; ++ai)
#pragma unroll
                for (int m = 0; m < 4; ++m) {
                    const int r = r0 + ai * 128 + m * 16; const float w8 = wrow[r] * Y8_SCALE;
                    const f32x4 v0 = (acc[ai][bj][m][0] * isc + b0) * w8, v1 = (acc[ai][bj][m][1] * isc + b1) * w8;
                    u32x2 w = {cvt4_fp8(v0[0], v0[1], v0[2], v0[3]), cvt4_fp8(v1[0], v1[1], v1[2], v1[3])};
                    *(u32x2*)(ys + (size_t)(slot0 + r) * DM + col) = w;
                }
        }
    }
};

DI void p1_inproj(const Params& p, LAS char* lds) {
    const int tid = threadIdx.x, lane = tid & 63, wave = tid >> 6;
    const bf16_t* h = (const bf16_t*)(p.ws + WS_H);
    {
        const bf16_t* wsl = (const bf16_t*)(p.ws + WS_WS); float* ba = (float*)(p.ws + WS_BA);
        const int l15 = lane & 15, l4 = lane >> 4;
        for (int task = blockIdx.x * 8 + wave; task < NTOK / 16; task += gridDim.x * 8) {
            f32x4 a0 = {0.f, 0.f, 0.f, 0.f}, a1 = {0.f, 0.f, 0.f, 0.f};
            const bf16_t* ar = h + (size_t)(task * 16 + l15) * DM + l4 * 8;
            const bf16_t* b0 = wsl + (size_t)l15 * DM + l4 * 8; const bf16_t* b1 = b0 + 16 * DM;
#pragma unroll 8
            for (int k0 = 0; k0 < DM; k0 += 32) {
                const bf16x8 a = *(const bf16x8*)(ar + k0);
                a0 = MFMA16(a, *(const bf16x8*)(b0 + k0), a0); a1 = MFMA16(a, *(const bf16x8*)(b1 + k0), a1);
            }
#pragma unroll
            for (int r = 0; r < 4; ++r) { float* o = ba + (size_t)(task * 16 + l4 * 4 + r) * 32 + l15; o[0] = a0[r]; o[16] = a1[r]; }
        }
    }
    const bf16_t* win = (const bf16_t*)(p.ws + WS_WIN);
    const bf16_t* h8 = (const bf16_t*)(p.ws + WS_H8); const unsigned char* win8 = p.ws + WS_WIN8;
    int pm, pn; bool have = unit_order(0, gridDim.x, blockIdx.x, 64, 72, pm, pn), pre = false;
    for (int i = 0; have; ++i) {
        int pm2, pn2; const bool have2 = unit_order(i + 1, gridDim.x, blockIdx.x, 64, 72, pm2, pn2);
        const bool f8 = pn >= 56 || (pn >= 24 && pn < 32), f82 = pn2 >= 56 || (pn2 >= 24 && pn2 < 32);
        const int r8 = pn >= 56 ? (pn - 56) * 256 : 4096 + (pn - 24) * 256, r82 = pn2 >= 56 ? (pn2 - 56) * 256 : 4096 + (pn2 - 24) * 256;
        const bool isv = pn >= 48 && pn < 56;
        EpiProj e{(bf16_t*)(p.ws + (isv ? WS_VBUF : WS_PROJ)), p.b_gate, pm, pn, f8 ? 1.f / (W8_SCALE * H8_SCALE) : 1.f, isv ? DM : PROJ_LD, isv ? PC_VB : 0};
        auto next = [&]() { if (have2) { if (f82) gemm_issue<false, true>(h8, DM / 2, pm2 * 256, (const LAS int*)nullptr, (const bf16_t*)(win8 + (size_t)r82 * DM), DM / 2, lds + LDS_MISC);
                                         else gemm_issue<false, true>(h, DM, pm2 * 256, (const LAS int*)nullptr, win + (size_t)pn2 * 256 * DM, DM, lds + LDS_MISC); } };
        if (f8) gemm_tile<false, true>(h8, DM / 2, pm * 256, (const LAS int*)nullptr, (const bf16_t*)(win8 + (size_t)r8 * DM), DM / 2, lds + LDS_MISC, e, pre, next);
        else gemm_tile<false, false>(h, DM, pm * 256, (const LAS int*)nullptr, win + (size_t)pn * 256 * DM, DM, lds + LDS_MISC, e, pre, next);
        pre = have2; have = have2; pm = pm2; pn = pn2;
    }
}

DI void p4_branches(const Params& p, LAS char* lds) {
    const bf16_t* oa = (const bf16_t*)(p.ws + WS_OA); const bf16_t* ob = (const bf16_t*)(p.ws + WS_OB);
    const bf16_t* wa = (const bf16_t*)(p.ws + WS_WA); const bf16_t* wb = (const bf16_t*)(p.ws + WS_WB);
    int pm, pn; bool have = unit_order(0, gridDim.x, blockIdx.x, 64, 8, pm, pn), pre = false;
    for (int i = 0; have; ++i) {
        int pm2, pn2; const bool have2 = unit_order(i + 1, gridDim.x, blockIdx.x, 64, 8, pm2, pn2);
        EpiScaleA ea{(const bf16_t*)(p.ws + WS_PROJ), pm, pn};
        EpiBranchB eb{(const bf16_t*)(p.ws + WS_PROJ), (bf16_t*)(p.ws + WS_MRG), pm, pn};
        auto next = [&]() { if (have2) gemm_issue<false, true>(oa, DM, pm2 * 256, (const LAS int*)nullptr, wa + (size_t)pn2 * 256 * DM, DM, lds + LDS_MISC); };
        gemm_tile_dual(oa, ob, DM, pm * 256, wa + (size_t)pn * 256 * DM, wb + (size_t)pn * 256 * DM, DM, lds + LDS_MISC, eb, ea, pre, next);
        pre = have2; have = have2; pm = pm2; pn = pn2;
    }
}
DI void p5_outproj(const Params& p, LAS char* lds) {
    const bf16_t* mg = (const bf16_t*)(p.ws + WS_MRG); const bf16_t* wo = (const bf16_t*)(p.ws + WS_WO);
    int pm, pn; bool have = unit_order(0, gridDim.x, blockIdx.x, 64, 8, pm, pn), pre = false;
    for (int i = 0; have; ++i) {
        int pm2, pn2; const bool have2 = unit_order(i + 1, gridDim.x, blockIdx.x, 64, 8, pm2, pn2);
        EpiOut e{p.x, p.out, pm, pn};
        auto next = [&]() { if (have2) gemm_issue<false, false>(mg, DM, pm2 * 256, (const LAS int*)nullptr, wo + (size_t)pn2 * 256 * DM, DM, lds + LDS_MISC); };
        gemm_tile<false, false>(mg, DM, pm * 256, (const LAS int*)nullptr, wo + (size_t)pn * 256 * DM, DM, lds + LDS_MISC, e, pre, next);
        pre = have2; have = have2; pm = pm2; pn = pn2;
    }
}

constexpr int GP_SC = 0, GP_Q = 1024, GP_K = GP_Q + 17408, GP_VBT = GP_K + 17408, GP_KBGT = GP_VBT + 18432, GP_L = GP_KBGT + 18432, GP_T = GP_L + 17408;
DI bf16x8 ld_frag(const LAS char* p) { return *(const LAS bf16x8*)p; }

DI void gdn_prep_unit(const Params& p, LAS char* st, int u) {
    const int tid = threadIdx.x, lane = tid & 63, wave = tid >> 6, l15 = lane & 15, l4 = lane >> 4;
    const int bh = u >> 6, n = u & 63, b = bh >> 4, hh = bh & 15;
    const int row_base = b * SEQ + n * 64;
    LAS float* sc = (LAS float*)(st + GP_SC);
    const bf16_t* proj = (const bf16_t*)(p.ws + WS_PROJ);
    if (wave == 0) {
        const float* ba = (const float*)(p.ws + WS_BA) + (size_t)(row_base + lane) * 32;
        const float braw = ba[hh], araw = ba[16 + hh] + p.dt_bias[hh];
        const float sp = fmaxf(araw, 0.f) + log1pf(__expf(-fabsf(araw)));
        const float g = -__expf(p.a_log[hh]) * sp;
        float c = g;
#pragma unroll
        for (int o = 1; o < 64; o <<= 1) { const float t = __shfl_up(c, o); if (lane >= o) c += t; }
        const float gl = __shfl(c, 63);
        sc[lane] = c; sc[64 + lane] = sigmoidf_(braw); sc[128 + lane] = __expf(c); sc[192 + lane] = __expf(gl - c);
        if (lane == 0) ((float*)(p.ws + WS_GL))[u] = __expf(gl);
    }
    float o[8][8]; int seg = 0, part = 0, ch0 = 0;
    if (tid < 384) {
        seg = tid / 48; const int rem = tid % 48; part = rem >> 4; ch0 = (rem & 15) * 8;
        const int colb = PC_QKV + part * 2048 + hh * 128 + ch0;
        const bf16_t* src = proj + (size_t)(row_base + seg * 8) * PROJ_LD + colb;
        bf16x8 raw[11];
#pragma unroll
        for (int r = 0; r < 11; ++r) {
            raw[r] = (bf16x8){0, 0, 0, 0, 0, 0, 0, 0};
            if (!(n == 0 && seg == 0 && r < 3)) raw[r] = *(const bf16x8*)(src + (ptrdiff_t)(r - 3) * PROJ_LD);
        }
        float w[4][8];
#pragma unroll
        for (int j = 0; j < 4; ++j) {
            const f32x4 w0 = *(const f32x4*)(p.conv_w + j * 6144 + colb), w1 = *(const f32x4*)(p.conv_w + j * 6144 + colb + 4);
            w[j][0] = w0[0]; w[j][1] = w0[1]; w[j][2] = w0[2]; w[j][3] = w0[3]; w[j][4] = w1[0]; w[j][5] = w1[1]; w[j][6] = w1[2]; w[j][7] = w1[3];
        }
#pragma unroll
        for (int t = 0; t < 8; ++t)
#pragma unroll
            for (int c = 0; c < 8; ++c) {
                float a = 0.f;
#pragma unroll
                for (int j = 0; j < 4; ++j) a += bf2f((unsigned short)raw[t + j][c]) * w[j][c];
                o[t][c] = siluf_(a);
            }
    }
    __syncthreads();
    if (tid < 384) {
        const bf16_t* dummy = nullptr; (void)dummy;
        float rinv[8];
        if (part < 2) {
#pragma unroll
            for (int t = 0; t < 8; ++t) {
                float ss = 0.f;
#pragma unroll
                for (int c = 0; c < 8; ++c) ss += o[t][c] * o[t][c];
                ss += __shfl_xor(ss, 1); ss += __shfl_xor(ss, 2); ss += __shfl_xor(ss, 4); ss += __shfl_xor(ss, 8);
                rinv[t] = rsqrtf(ss + NORM_EPS);
            }
        }
        if (part == 0) {
            bf16_t* qg = (bf16_t*)(p.ws + WS_QG) + (size_t)u * 8192;
#pragma unroll
            for (int t = 0; t < 8; ++t) {
                const int tok = seg * 8 + t; const float s = rinv[t] * 0.08838834764831845f, eg = sc[128 + tok];
                float q[8];
#pragma unroll
                for (int c = 0; c < 8; ++c) q[c] = o[t][c] * s;
                u32x4 w = {cvt_pk_bf16(q[0], q[1]), cvt_pk_bf16(q[2], q[3]), cvt_pk_bf16(q[4], q[5]), cvt_pk_bf16(q[6], q[7])};
                *(LAS u32x4*)(st + GP_Q + tok * 272 + ch0 * 2) = w;
                u32x4 w2 = {cvt_pk_bf16(q[0] * eg, q[1] * eg), cvt_pk_bf16(q[2] * eg, q[3] * eg), cvt_pk_bf16(q[4] * eg, q[5] * eg), cvt_pk_bf16(q[6] * eg, q[7] * eg)};
                *(u32x4*)(qg + tok * 128 + ch0) = w2;
            }
        } else if (part == 1) {
            bf16_t* kdt = (bf16_t*)(p.ws + WS_KDT) + (size_t)u * 8192;
            float be[8], ed[8];
#pragma unroll
            for (int t = 0; t < 8; ++t) { const int tok = seg * 8 + t; be[t] = sc[64 + tok] * sc[128 + tok]; ed[t] = sc[192 + tok]; }
#pragma unroll
            for (int t = 0; t < 8; ++t) {
                const int tok = seg * 8 + t;
#pragma unroll
                for (int c = 0; c < 8; ++c) o[t][c] *= rinv[t];
                u32x4 w = {cvt_pk_bf16(o[t][0], o[t][1]), cvt_pk_bf16(o[t][2], o[t][3]), cvt_pk_bf16(o[t][4], o[t][5]), cvt_pk_bf16(o[t][6], o[t][7])};
                *(LAS u32x4*)(st + GP_K + tok * 272 + ch0 * 2) = w;
            }
#pragma unroll
            for (int c = 0; c < 8; ++c) {
                u32x4 w = {cvt_pk_bf16(o[0][c] * be[0], o[1][c] * be[1]), cvt_pk_bf16(o[2][c] * be[2], o[3][c] * be[3]), cvt_pk_bf16(o[4][c] * be[4], o[5][c] * be[5]), cvt_pk_bf16(o[6][c] * be[6], o[7][c] * be[7])};
                *(LAS u32x4*)(st + GP_KBGT + (ch0 + c) * 144 + seg * 16) = w;
                u32x4 w2 = {cvt_pk_bf16(o[0][c] * ed[0], o[1][c] * ed[1]), cvt_pk_bf16(o[2][c] * ed[2], o[3][c] * ed[3]), cvt_pk_bf16(o[4][c] * ed[4], o[5][c] * ed[5]), cvt_pk_bf16(o[6][c] * ed[6], o[7][c] * ed[7])};
                *(u32x4*)(kdt + (ch0 + c) * 64 + seg * 8) = w2;
            }
        } else {
            float be[8];
#pragma unroll
            for (int t = 0; t < 8; ++t) be[t] = sc[64 + seg * 8 + t];
#pragma unroll
            for (int c = 0; c < 8; ++c) {
                u32x4 w = {cvt_pk_bf16(o[0][c] * be[0], o[1][c] * be[1]), cvt_pk_bf16(o[2][c] * be[2], o[3][c] * be[3]), cvt_pk_bf16(o[4][c] * be[4], o[5][c] * be[5]), cvt_pk_bf16(o[6][c] * be[6], o[7][c] * be[7])};
                *(LAS u32x4*)(st + GP_VBT + (ch0 + c) * 144 + seg * 16) = w;
            }
        }
    }
    __syncthreads();
    {
        const int mi = wave >> 1; bf16_t* qkg = (bf16_t*)(p.ws + WS_QK) + (size_t)u * 4096;
#pragma unroll
        for (int jj = 0; jj < 2; ++jj) {
            const int nj = (wave & 1) * 2 + jj;
            const int i = mi * 16 + l15, j0 = nj * 16 + l4 * 4;
            if (nj > mi) { *(u32x2*)(qkg + i * 64 + j0) = (u32x2){0u, 0u}; continue; }
            f32x4 aK = {0.f, 0.f, 0.f, 0.f}, aQ = {0.f, 0.f, 0.f, 0.f};
#pragma unroll
            for (int ks = 0; ks < 4; ++ks) {
                const int kb = (ks * 32 + l4 * 8) * 2;
                const bf16x8 kfj = ld_frag(st + GP_K + (nj * 16 + l15) * 272 + kb), kfi = ld_frag(st + GP_K + (mi * 16 + l15) * 272 + kb), qfi = ld_frag(st + GP_Q + (mi * 16 + l15) * 272 + kb);
                aK = MFMA16(kfj, kfi, aK); aQ = MFMA16(kfj, qfi, aQ);
            }
            const float gi = sc[i], bi = sc[64 + i]; f32x4 lv; float qv[4];
#pragma unroll
            for (int r = 0; r < 4; ++r) {
                const int j = j0 + r; const float d = gi - sc[j];
                const float dec = (i >= j) ? __expf(d) : 0.f;
                lv[r] = (i > j) ? bi * aK[r] * dec : 0.f; qv[r] = aQ[r] * dec;
            }
            *(LAS f32x4*)(st + GP_L + (i * 68 + j0) * 4) = lv;
            u32x2 w; w[0] = cvt_pk_bf16(qv[0], qv[1]); w[1] = cvt_pk_bf16(qv[2], qv[3]);
            *(u32x2*)(qkg + i * 64 + j0) = w;
        }
    }
    __syncthreads();
    if (wave == 0) {
        int ln = lane, lz = 0; asm volatile("" : "+v"(ln), "+v"(lz));
        const LAS char* Lb = st + GP_L + (lz & ~15);
        float t[64];
#pragma unroll
        for (int i = 0; i < 64; ++i) t[i] = 0.f;
        t[0] = (ln == 0) ? 1.f : 0.f;
        f32x4 row[2][16];
        row[1][0] = *(const LAS f32x4*)(Lb + 1 * 272);
#pragma unroll
        for (int i = 1; i < 64; ++i) {
            if (i + 1 < 64) {
#pragma unroll
                for (int q = 0; q < (i + 4) / 4; ++q) row[(i + 1) & 1][q] = *(const LAS f32x4*)(Lb + (i + 1) * 272 + q * 16);
            }
            f32x2 s0 = {0.f, 0.f}, s1 = {0.f, 0.f};
#pragma unroll
            for (int q = 0; q < (i + 3) / 4; ++q) {
                const f32x4 l = row[i & 1][q];
                s0 += (f32x2){l[0], l[1]} * (f32x2){t[4 * q], t[4 * q + 1]};
                s1 += (f32x2){l[2], l[3]} * (f32x2){t[4 * q + 2], t[4 * q + 3]};
            }
            t[i] = ((ln == i) ? 1.f : 0.f) - ((s0[0] + s0[1]) + (s1[0] + s1[1]));
        }
        LAS bf16_t* T = (LAS bf16_t*)(st + GP_T);
#pragma unroll
        for (int i = 0; i < 64; ++i) T[i * 72 + lane] = (bf16_t)(cvt_pk_bf16(t[i], 0.f) & 0xffffu);
    }
    __syncthreads();
    {
        bf16x8 tf[4][2];
#pragma unroll
        for (int mi = 0; mi < 4; ++mi)
#pragma unroll
            for (int ks = 0; ks < 2; ++ks) tf[mi][ks] = ld_frag(st + GP_T + (mi * 16 + l15) * 144 + (ks * 32 + l4 * 8) * 2);
        bf16x8 vf[2], kf[2];
#pragma unroll
        for (int ks = 0; ks < 2; ++ks) { vf[ks] = ld_frag(st + GP_VBT + (wave * 16 + l15) * 144 + (ks * 32 + l4 * 8) * 2); kf[ks] = ld_frag(st + GP_KBGT + (wave * 16 + l15) * 144 + (ks * 32 + l4 * 8) * 2); }
        bf16_t* ut = (bf16_t*)(p.ws + WS_UT) + (size_t)u * 8192; bf16_t* nw = (bf16_t*)(p.ws + WS_NEGW) + (size_t)u * 8192;
#pragma unroll
        for (int mi = 0; mi < 4; ++mi) {
            f32x4 au = {0.f, 0.f, 0.f, 0.f}, aw = {0.f, 0.f, 0.f, 0.f};
#pragma unroll
            for (int ks = 0; ks < 2; ++ks) { au = MFMA16(tf[mi][ks], vf[ks], au); aw = MFMA16(kf[ks], tf[mi][ks], aw); }
            u32x2 w; w[0] = cvt_pk_bf16(au[0], au[1]); w[1] = cvt_pk_bf16(au[2], au[3]);
            *(u32x2*)(ut + (wave * 16 + l15) * 64 + mi * 16 + l4 * 4) = w;
            u32x2 w2; w2[0] = cvt_pk_bf16(-aw[0], -aw[1]); w2[1] = cvt_pk_bf16(-aw[2], -aw[3]);
            *(u32x2*)(nw + (mi * 16 + l15) * 128 + wave * 16 + l4 * 4) = w2;
        }
    }
    __syncthreads();
}

constexpr int GH_SC = 0, GH_Q = 1024, GH_K = GH_Q + 18432, GH_L = GH_K + 17408, GH_X = GH_L + 17408, GH_T = GH_K, GH_VBT = GH_Q, GH_BYTES = GH_X + 18432;

DI void gdn_prep_pair(const Params& p, LAS char* st0, int pair) {
    int tid_ = threadIdx.x; asm volatile("" : "+v"(tid_));
    const int tid = tid_, lane = tid & 63, wave = __builtin_amdgcn_readfirstlane(tid >> 6), l15 = lane & 15, l4 = lane >> 4;
    const int hs = wave >> 2, hw = wave & 3, htid = tid & 255;
    LAS char* st = st0 + hs * GH_BYTES;
    const int u = pair * 2 + hs;
    const int bh = u >> 6, n = u & 63, b = bh >> 4, hh = bh & 15;
    const int row_base = b * SEQ + n * 64;
    LAS float* sc = (LAS float*)(st + GH_SC);
    const bf16_t* proj = (const bf16_t*)(p.ws + WS_PROJ);
#define GP_LOAD(raw, w, seg, part, ch0) do { const int colb_ = PC_QKV + (part) * 2048 + hh * 128 + (ch0); \
        const bf16_t* src_ = proj + (size_t)(row_base + (seg) * 8) * PROJ_LD + colb_; \
        _Pragma("unroll") for (int r = 0; r < 11; ++r) { raw[r] = (bf16x8){0, 0, 0, 0, 0, 0, 0, 0}; if (!(n == 0 && (seg) == 0 && r < 3)) raw[r] = *(const bf16x8*)(src_ + (ptrdiff_t)(r - 3) * PROJ_LD); } \
        _Pragma("unroll") for (int j = 0; j < 4; ++j) { const f32x4 a_ = *(const f32x4*)(p.conv_w + j * 6144 + colb_), b_ = *(const f32x4*)(p.conv_w + j * 6144 + colb_ + 4); \
            w[j][0] = a_[0]; w[j][1] = a_[1]; w[j][2] = a_[2]; w[j][3] = a_[3]; w[j][4] = b_[0]; w[j][5] = b_[1]; w[j][6] = b_[2]; w[j][7] = b_[3]; } } while (0)
#define GP_CONV(raw, w, o) do { _Pragma("unroll") for (int t = 0; t < 8; ++t) _Pragma("unroll") for (int c = 0; c < 8; ++c) { float a = 0.f; \
            _Pragma("unroll") for (int j = 0; j < 4; ++j) a += bf2f((unsigned short)raw[t + j][c]) * w[j][c]; o[t][c] = siluf_(a); } } while (0)
    const int seg0 = htid >> 5, part0 = (htid >> 4) & 1, ch00 = (htid & 15) * 8;
    bf16x8 raw0[11]; float w0[4][8];
    GP_LOAD(raw0, w0, seg0, part0, ch00);
    if (hw == 0) {
        const float* ba = (const float*)(p.ws + WS_BA) + (size_t)(row_base + lane) * 32;
        const float braw = ba[hh], araw = ba[16 + hh] + p.dt_bias[hh];
        const float sp = fmaxf(araw, 0.f) + log1pf(__expf(-fabsf(araw)));
        const float g = -__expf(p.a_log[hh]) * sp;
        float c = g;
#pragma unroll
        for (int o = 1; o < 64; o <<= 1) { const float t = __shfl_up(c, o); if (lane >= o) c += t; }
        const float gl = __shfl(c, 63);
        sc[lane] = c; sc[64 + lane] = sigmoidf_(braw); sc[128 + lane] = __expf(c); sc[192 + lane] = __expf(gl - c);
        if (lane == 0) ((float*)(p.ws + WS_GL))[u] = __expf(gl);
    }
    LDS_BAR();
    {
        float o[8][8]; GP_CONV(raw0, w0, o);
        float rinv[8];
#pragma unroll
        for (int t = 0; t < 8; ++t) { float ss = 0.f;
#pragma unroll
            for (int c = 0; c < 8; ++c) ss += o[t][c] * o[t][c];
            ss += __shfl_xor(ss, 1); ss += __shfl_xor(ss, 2); ss += __shfl_xor(ss, 4); ss += __shfl_xor(ss, 8); rinv[t] = rsqrtf(ss + NORM_EPS); }
        if (part0 == 0) { bf16_t* qg = (bf16_t*)(p.ws + WS_QG) + (size_t)u * 8192;
#pragma unroll
            for (int t = 0; t < 8; ++t) { const int tok = seg0 * 8 + t; const float s_ = rinv[t] * 0.08838834764831845f, eg = sc[128 + tok]; float q[8];
#pragma unroll
                for (int c = 0; c < 8; ++c) q[c] = o[t][c] * s_;
                u32x4 x1 = {cvt_pk_bf16(q[0], q[1]), cvt_pk_bf16(q[2], q[3]), cvt_pk_bf16(q[4], q[5]), cvt_pk_bf16(q[6], q[7])};
                *(LAS u32x4*)(st + GH_Q + tok * 272 + ch00 * 2) = x1;
                u32x4 x2 = {cvt_pk_bf16(q[0] * eg, q[1] * eg), cvt_pk_bf16(q[2] * eg, q[3] * eg), cvt_pk_bf16(q[4] * eg, q[5] * eg), cvt_pk_bf16(q[6] * eg, q[7] * eg)};
                *(u32x4*)(qg + tok * 128 + ch00) = x2; }
        } else { bf16_t* kdt = (bf16_t*)(p.ws + WS_KDT) + (size_t)u * 8192; float be[8], ed[8];
#pragma unroll
            for (int t = 0; t < 8; ++t) { const int tok = seg0 * 8 + t; be[t] = sc[64 + tok] * sc[128 + tok]; ed[t] = sc[192 + tok]; }
#pragma unroll
            for (int t = 0; t < 8; ++t) { const int tok = seg0 * 8 + t;
#pragma unroll
                for (int c = 0; c < 8; ++c) o[t][c] *= rinv[t];
                u32x4 x1 = {cvt_pk_bf16(o[t][0], o[t][1]), cvt_pk_bf16(o[t][2], o[t][3]), cvt_pk_bf16(o[t][4], o[t][5]), cvt_pk_bf16(o[t][6], o[t][7])};
                *(LAS u32x4*)(st + GH_K + tok * 272 + ch00 * 2) = x1; }
#pragma unroll
            for (int c = 0; c < 8; ++c) {
                u32x4 x1 = {cvt_pk_bf16(o[0][c] * be[0], o[1][c] * be[1]), cvt_pk_bf16(o[2][c] * be[2], o[3][c] * be[3]), cvt_pk_bf16(o[4][c] * be[4], o[5][c] * be[5]), cvt_pk_bf16(o[6][c] * be[6], o[7][c] * be[7])};
                *(LAS u32x4*)(st + GH_X + (ch00 + c) * 144 + seg0 * 16) = x1;
                u32x4 x2 = {cvt_pk_bf16(o[0][c] * ed[0], o[1][c] * ed[1]), cvt_pk_bf16(o[2][c] * ed[2], o[3][c] * ed[3]), cvt_pk_bf16(o[4][c] * ed[4], o[5][c] * ed[5]), cvt_pk_bf16(o[6][c] * ed[6], o[7][c] * ed[7])};
                *(u32x4*)(kdt + (ch00 + c) * 64 + seg0 * 8) = x2; }
        }
    }
    LDS_BAR();
    {
        bf16_t* qkg = (bf16_t*)(p.ws + WS_QK) + (size_t)u * 4096;
#pragma unroll
        for (int mi = 0; mi < 4; ++mi)
#pragma unroll
            for (int nj = 0; nj < 4; ++nj) {
                if (((mi + nj) & 3) != hw) continue;
                const int i = mi * 16 + l15, j0 = nj * 16 + l4 * 4;
                if (nj > mi) { *(u32x2*)(qkg + i * 64 + j0) = (u32x2){0u, 0u}; continue; }
                f32x4 aK = {0.f, 0.f, 0.f, 0.f}, aQ = {0.f, 0.f, 0.f, 0.f};
#pragma unroll
                for (int ks = 0; ks < 4; ++ks) {
                    const int kb = (ks * 32 + l4 * 8) * 2;
                    const bf16x8 kfj = ld_frag(st + GH_K + (nj * 16 + l15) * 272 + kb), kfi = ld_frag(st + GH_K + (mi * 16 + l15) * 272 + kb), qfi = ld_frag(st + GH_Q + (mi * 16 + l15) * 272 + kb);
                    aK = MFMA16(kfj, kfi, aK); aQ = MFMA16(kfj, qfi, aQ);
                }
                const float gi = sc[i], bi = sc[64 + i]; f32x4 lv; float qv[4];
#pragma unroll
                for (int r = 0; r < 4; ++r) {
                    const int j = j0 + r; const float d = gi - sc[j];
                    const float dec = (i >= j) ? __expf(d) : 0.f;
                    lv[r] = (i > j) ? bi * aK[r] * dec : 0.f; qv[r] = aQ[r] * dec;
                }
                *(LAS f32x4*)(st + GH_L + (i * 68 + j0) * 4) = lv;
                u32x2 w; w[0] = cvt_pk_bf16(qv[0], qv[1]); w[1] = cvt_pk_bf16(qv[2], qv[3]);
                *(u32x2*)(qkg + i * 64 + j0) = w;
            }
    }
    LDS_BAR();
    if (hw == hs) {
        int ln = lane, lz = 0; asm volatile("" : "+v"(ln), "+v"(lz));
        const LAS char* Lb = st + GH_L + (lz & ~15);
        float t[64];
#pragma unroll
        for (int i = 0; i < 64; ++i) t[i] = 0.f;
        t[0] = (ln == 0) ? 1.f : 0.f;
        f32x4 row[2][16];
        row[1][0] = *(const LAS f32x4*)(Lb + 1 * 272);
#pragma unroll
        for (int i = 1; i < 64; ++i) {
            if (i + 1 < 64) {
#pragma unroll
                for (int q = 0; q < (i + 4) / 4; ++q) row[(i + 1) & 1][q] = *(const LAS f32x4*)(Lb + (i + 1) * 272 + q * 16);
            }
            f32x2 s0 = {0.f, 0.f}, s1 = {0.f, 0.f};
#pragma unroll
            for (int q = 0; q < (i + 3) / 4; ++q) {
                const f32x4 l = row[i & 1][q];
                s0 += (f32x2){l[0], l[1]} * (f32x2){t[4 * q], t[4 * q + 1]};
                s1 += (f32x2){l[2], l[3]} * (f32x2){t[4 * q + 2], t[4 * q + 3]};
            }
            t[i] = ((ln == i) ? 1.f : 0.f) - ((s0[0] + s0[1]) + (s1[0] + s1[1]));
        }
        LAS bf16_t* T = (LAS bf16_t*)(st + GH_T);
#pragma unroll
        for (int i = 0; i < 64; ++i) T[i * 72 + lane] = (bf16_t)(cvt_pk_bf16(t[i], 0.f) & 0xffffu);
    } else if (hw >= 2) {
        const int vt = htid - 128, segv = vt >> 4, chv = (vt & 15) * 8;
        bf16x8 rawv[11]; float wv_[4][8];
        GP_LOAD(rawv, wv_, segv, 2, chv);
        float o[8][8]; GP_CONV(rawv, wv_, o);
        float be[8];
#pragma unroll
        for (int t = 0; t < 8; ++t) be[t] = sc[64 + segv * 8 + t];
#pragma unroll
        for (int c = 0; c < 8; ++c) {
            u32x4 x1 = {cvt_pk_bf16(o[0][c] * be[0], o[1][c] * be[1]), cvt_pk_bf16(o[2][c] * be[2], o[3][c] * be[3]), cvt_pk_bf16(o[4][c] * be[4], o[5][c] * be[5]), cvt_pk_bf16(o[6][c] * be[6], o[7][c] * be[7])};
            *(LAS u32x4*)(st + GH_VBT + (chv + c) * 144 + segv * 16) = x1; }
    }
    LDS_BAR();
#undef GP_LOAD
#undef GP_CONV
    {
        bf16x8 tf[4][2];
#pragma unroll
        for (int mi = 0; mi < 4; ++mi)
#pragma unroll
            for (int ks = 0; ks < 2; ++ks) tf[mi][ks] = ld_frag(st + GH_T + (mi * 16 + l15) * 144 + (ks * 32 + l4 * 8) * 2);
        bf16_t* ut = (bf16_t*)(p.ws + WS_UT) + (size_t)u * 8192; bf16_t* nw = (bf16_t*)(p.ws + WS_NEGW) + (size_t)u * 8192;
#pragma unroll
        for (int q = 0; q < 2; ++q) {
            const int nv = hw + 4 * q;
            bf16x8 vf[2], kf[2];
#pragma unroll
            for (int ks = 0; ks < 2; ++ks) { vf[ks] = ld_frag(st + GH_VBT + (nv * 16 + l15) * 144 + (ks * 32 + l4 * 8) * 2); kf[ks] = ld_frag(st + GH_X + (nv * 16 + l15) * 144 + (ks * 32 + l4 * 8) * 2); }
#pragma unroll
            for (int mi = 0; mi < 4; ++mi) {
                f32x4 au = {0.f, 0.f, 0.f, 0.f}, aw = {0.f, 0.f, 0.f, 0.f};
#pragma unroll
                for (int ks = 0; ks < 2; ++ks) { au = MFMA16(tf[mi][ks], vf[ks], au); aw = MFMA16(kf[ks], tf[mi][ks], aw); }
                u32x2 w; w[0] = cvt_pk_bf16(au[0], au[1]); w[1] = cvt_pk_bf16(au[2], au[3]);
                *(u32x2*)(ut + (nv * 16 + l15) * 64 + mi * 16 + l4 * 4) = w;
                u32x2 w2; w2[0] = cvt_pk_bf16(-aw[0], -aw[1]); w2[1] = cvt_pk_bf16(-aw[2], -aw[3]);
                *(u32x2*)(nw + (mi * 16 + l15) * 128 + nv * 16 + l4 * 4) = w2;
            }
        }
    }
    LDS_BAR();
}

__constant__ double c_invf[16] = {1.0, 0.44036660267178046, 0.19392274474868576, 0.08539710028576561, 0.03760603093086393, 0.016560440080994446, 0.007292664737217109,
    0.003211445994752591, 0.001414213562373095, 0.000622772421914596, 0.0002742481756762073, 0.00012076973741146504, 5.318295896944988e-05, 2.341999896140934e-05,
    1.031338537721246e-05, 4.5416704806078695e-06};

DI void p2_qknorm(const Params& p) {
    const int tid = threadIdx.x, lane = tid & 63, wave = tid >> 6, sub = lane & 15, grp = lane >> 4;
    const bf16_t* proj = (const bf16_t*)(p.ws + WS_PROJ);
    bf16_t* qn = (bf16_t*)(p.ws + WS_QN); bf16_t* kn = (bf16_t*)(p.ws + WS_KN);
    float gq[8], gk[8];
#pragma unroll
    for (int e = 0; e < 8; ++e) { gq[e] = p.q_norm_g[sub * 8 + e]; gk[e] = p.k_norm_g[sub * 8 + e]; }
    for (int tok = blockIdx.x * 8 + wave; tok < NTOK; tok += gridDim.x * 8) {
        const int pos = p.positions[tok];
        const double ad = (double)pos * c_invf[sub];
        const double kk = rint(ad * 0.15915494309189535);
        const float r = (float)(ad - kk * 6.283185307179586);
        const float cs = __cosf(r), sn = __sinf(r);
#pragma unroll
        for (int it = 0; it < 8; ++it) {
            const int v = it * 4 + grp; const bool isq = v < 16;
            const bf16x8 raw = *(const bf16x8*)(proj + (size_t)tok * PROJ_LD + (isq ? PC_QB + v * 128 : PC_KB + (v - 16) * 128) + sub * 8);
            float x[8]; float ss = 0.f;
#pragma unroll
            for (int e = 0; e < 8; ++e) { x[e] = bf2f((unsigned short)raw[e]); ss += x[e] * x[e]; }
            ss += __shfl_xor(ss, 1); ss += __shfl_xor(ss, 2); ss += __shfl_xor(ss, 4); ss += __shfl_xor(ss, 8);
            const float rs = rsqrtf(ss * (1.f / 128.f) + NORM_EPS);
#pragma unroll
            for (int e = 0; e < 8; ++e) x[e] = x[e] * rs * (isq ? gq[e] : gk[e]);
            float y[8];
#pragma unroll
            for (int e = 0; e < 8; ++e) {
                const float py = __shfl_xor(x[e], 2);
                const int src = (lane & 48) | (8 * (sub & 1) + e);
                const float c = __shfl(cs, src), s = __shfl(sn, src);
                y[e] = sub < 2 ? x[e] * c - py * s : (sub < 4 ? x[e] * c + py * s : x[e]);
            }
            u32x4 w = {cvt_pk_bf16(y[0], y[1]), cvt_pk_bf16(y[2], y[3]), cvt_pk_bf16(y[4], y[5]), cvt_pk_bf16(y[6], y[7])};
            *(u32x4*)((isq ? qn : kn) + (size_t)tok * DM + (v & 15) * 128 + sub * 8) = w;
        }
    }
}

constexpr int SC_NEGW = 0, SC_QG = 17408, SC_KDT = 34816, SC_QK = 53248, SC_BUF = 62464, SC_OBUF = 2 * SC_BUF;
DI bf16x8 ld_frag2(const LAS char* p) { const s16x4 lo = *(const LAS s16x4*)p, hi = *(const LAS s16x4*)(p + 32); return __builtin_shufflevector(lo, hi, 0, 1, 2, 3, 4, 5, 6, 7); }
DI bf16x8 pack2(const f32x4& a, const f32x4& b) { u32x4 w = {cvt_pk_bf16(a[0], a[1]), cvt_pk_bf16(a[2], a[3]), cvt_pk_bf16(b[0], b[1]), cvt_pk_bf16(b[2], b[3])}; return __builtin_bit_cast(bf16x8, w); }

DI void gdn_scan_unit(const Params& p, LAS char* st, int bh) {
    int tid_ = threadIdx.x; asm volatile("" : "+v"(tid_));
    const int tid = tid_, lane = tid & 63, wave = tid >> 6, l15 = lane & 15, l4 = lane >> 4;
    const int b = bh >> 4, hh = bh & 15;
    const bf16_t* g_negw = (const bf16_t*)(p.ws + WS_NEGW) + (size_t)bh * 64 * 8192;
    const bf16_t* g_qg = (const bf16_t*)(p.ws + WS_QG) + (size_t)bh * 64 * 8192;
    const bf16_t* g_kdt = (const bf16_t*)(p.ws + WS_KDT) + (size_t)bh * 64 * 8192;
    const bf16_t* g_ut = (const bf16_t*)(p.ws + WS_UT) + (size_t)bh * 64 * 8192;
    const bf16_t* g_qk = (const bf16_t*)(p.ws + WS_QK) + (size_t)bh * 64 * 4096;
    const float* g_gl = (const float*)(p.ws + WS_GL) + bh * 64;
    const bf16_t* proj = (const bf16_t*)(p.ws + WS_PROJ);
    bf16_t* oa = (bf16_t*)(p.ws + WS_OA);
    u32x4 sg[7]; u32x2 ur[4], urn[4];
#define SC_LOAD(n_) do { \
        sg[0] = *(const u32x4*)(g_negw + (size_t)(n_) * 8192 + tid * 8); sg[1] = *(const u32x4*)(g_negw + (size_t)(n_) * 8192 + (tid + 512) * 8); \
        sg[2] = *(const u32x4*)(g_qg + (size_t)(n_) * 8192 + tid * 8);   sg[3] = *(const u32x4*)(g_qg + (size_t)(n_) * 8192 + (tid + 512) * 8); \
        sg[4] = *(const u32x4*)(g_kdt + (size_t)(n_) * 8192 + tid * 8);  sg[5] = *(const u32x4*)(g_kdt + (size_t)(n_) * 8192 + (tid + 512) * 8); \
        sg[6] = *(const u32x4*)(g_qk + (size_t)(n_) * 4096 + tid * 8); \
        _Pragma("unroll") for (int mt = 0; mt < 4; ++mt) urn[mt] = *(const u32x2*)(g_ut + (size_t)(n_) * 8192 + (wave * 16 + l15) * 64 + mt * 16 + l4 * 4); } while (0)
#define SC_WRITE(bsel) do { LAS char* bb = st + (bsel) * SC_BUF; \
        *(LAS u32x4*)(bb + SC_NEGW + (tid >> 4) * 272 + (tid & 15) * 16) = sg[0]; *(LAS u32x4*)(bb + SC_NEGW + ((tid + 512) >> 4) * 272 + (tid & 15) * 16) = sg[1]; \
        *(LAS u32x4*)(bb + SC_QG + (tid >> 4) * 272 + (tid & 15) * 16) = sg[2];   *(LAS u32x4*)(bb + SC_QG + ((tid + 512) >> 4) * 272 + (tid & 15) * 16) = sg[3]; \
        *(LAS u32x4*)(bb + SC_KDT + (tid >> 3) * 144 + (tid & 7) * 16) = sg[4];   *(LAS u32x4*)(bb + SC_KDT + ((tid + 512) >> 3) * 144 + (tid & 7) * 16) = sg[5]; \
        *(LAS u32x4*)(bb + SC_QK + (tid >> 3) * 144 + (tid & 7) * 16) = sg[6]; } while (0)
    f32x4 S[8];
#pragma unroll
    for (int t = 0; t < 8; ++t) S[t] = (f32x4){0.f, 0.f, 0.f, 0.f};
    const int etok = tid >> 3, edv = (tid & 7) * 16;
    float gn[16];
#pragma unroll
    for (int e = 0; e < 16; ++e) gn[e] = p.gdn_norm_g[edv + e];
    SC_LOAD(0); SC_WRITE(0);
#pragma unroll
    for (int mt = 0; mt < 4; ++mt) ur[mt] = urn[mt];
    __syncthreads();
    for (int n = 0; n < 64; ++n) {
        LAS char* bb = st + (n & 1) * SC_BUF;
        if (n + 1 < 64) SC_LOAD(n + 1);
        const size_t zrow = (size_t)(b * SEQ + n * 64 + etok);
        const u32x4 z0 = *(const u32x4*)(proj + zrow * PROJ_LD + PC_Z + hh * 128 + edv), z1 = *(const u32x4*)(proj + zrow * PROJ_LD + PC_Z + hh * 128 + edv + 8);
        const float gl = g_gl[n];
        bf16x8 sb[4];
#pragma unroll
        for (int s = 0; s < 4; ++s) sb[s] = pack2(S[2 * s], S[2 * s + 1]);
        f32x4 vn[4], o[4];
#pragma unroll
        for (int mt = 0; mt < 4; ++mt) {
            vn[mt] = (f32x4){bflo(ur[mt][0]), bfhi(ur[mt][0]), bflo(ur[mt][1]), bfhi(ur[mt][1])};
            o[mt] = (f32x4){0.f, 0.f, 0.f, 0.f};
#pragma unroll
            for (int s = 0; s < 4; ++s) {
                vn[mt] = MFMA16(ld_frag2(bb + SC_NEGW + (mt * 16 + l15) * 272 + (s * 32 + l4 * 4) * 2), sb[s], vn[mt]);
                o[mt] = MFMA16(ld_frag2(bb + SC_QG + (mt * 16 + l15) * 272 + (s * 32 + l4 * 4) * 2), sb[s], o[mt]);
            }
        }
        bf16x8 vb[2];
        vb[0] = pack2(vn[0], vn[1]); vb[1] = pack2(vn[2], vn[3]);
#pragma unroll
        for (int mt = 0; mt < 4; ++mt)
#pragma unroll
            for (int s = 0; s < 2; ++s) o[mt] = MFMA16(ld_frag2(bb + SC_QK + (mt * 16 + l15) * 144 + (s * 32 + l4 * 4) * 2), vb[s], o[mt]);
#pragma unroll
        for (int t = 0; t < 8; ++t) {
            S[t] *= gl;
#pragma unroll
            for (int s = 0; s < 2; ++s) S[t] = MFMA16(ld_frag2(bb + SC_KDT + (t * 16 + l15) * 144 + (s * 32 + l4 * 4) * 2), vb[s], S[t]);
        }
        LAS float* ob = (LAS float*)(st + SC_OBUF);
#pragma unroll
        for (int mt = 0; mt < 4; ++mt)
#pragma unroll
            for (int r = 0; r < 4; ++r) ob[(mt * 16 + l4 * 4 + r) * 132 + wave * 16 + l15] = o[mt][r];
        if (n + 1 < 64) { SC_WRITE((n + 1) & 1);
#pragma unroll
            for (int mt = 0; mt < 4; ++mt) ur[mt] = urn[mt]; }
        LDS_BAR();
        {
            float v[16]; float ss = 0.f;
#pragma unroll
            for (int q = 0; q < 4; ++q) { const f32x4 t4 = *(const LAS f32x4*)(ob + etok * 132 + edv + q * 4); v[q * 4] = t4[0]; v[q * 4 + 1] = t4[1]; v[q * 4 + 2] = t4[2]; v[q * 4 + 3] = t4[3]; }
#pragma unroll
            for (int e = 0; e < 16; ++e) ss += v[e] * v[e];
            ss += __shfl_xor(ss, 1); ss += __shfl_xor(ss, 2); ss += __shfl_xor(ss, 4);
            const float rs = rsqrtf(ss * (1.f / 128.f) + NORM_EPS);
            const unsigned zz[8] = {z0[0], z0[1], z0[2], z0[3], z1[0], z1[1], z1[2], z1[3]};
            u32x4 w0, w1;
#pragma unroll
            for (int q = 0; q < 4; ++q) {
                w0[q] = cvt_pk_bf16(v[2 * q] * rs * gn[2 * q] * bflo(zz[q]), v[2 * q + 1] * rs * gn[2 * q + 1] * bfhi(zz[q]));
                w1[q] = cvt_pk_bf16(v[8 + 2 * q] * rs * gn[8 + 2 * q] * bflo(zz[4 + q]), v[9 + 2 * q] * rs * gn[9 + 2 * q] * bfhi(zz[4 + q]));
            }
            bf16_t* dst = oa + zrow * DM + hh * 128 + edv;
            *(u32x4*)dst = w0; *(u32x4*)(dst + 8) = w1;
        }
        LDS_BAR();
    }
#undef SC_LOAD
#undef SC_WRITE
}

constexpr int AT_K1 = 0, AT_K2 = 16384, AT_V = 32768, AT_BUF = 65536, AT_SCR = 2 * AT_BUF;
constexpr float AT_SCALE = 0.088388347648318440f, AT_THR = 8.f;
#define KSWZ(row, colB) ((row) * 256 + ((colB) ^ (((row) & 7) << 4)))
DI int crow(int r, int hi) { return (r & 3) + 8 * (r >> 2) + 4 * hi; }
DI int v_rd_base(int lane) { return ((lane & 3) << 3) | (((lane >> 2) & 3) << 6) | (((lane >> 4) & 1) << 5) | (((lane >> 5) & 1) << 8); }
constexpr int v_rd_off(int d0, int ks, int half) { return d0 * 512 + ks * 8192 + half * 4096; }
template <int OFF> DI s16x4 tr_read(int vb) { s16x4 r; asm volatile("ds_read_b64_tr_b16 %0, %1 offset:%2" : "=&v"(r) : "v"(vb), "i"(OFF) : "memory"); return r; }
template <int D0, int HH> DI void pv_half(f32x16& od, int vb, bf16x8 pa, bf16x8 pb) {
    const s16x4 l0 = tr_read<v_rd_off(D0, 2 * HH, 0)>(vb), h0 = tr_read<v_rd_off(D0, 2 * HH, 1)>(vb), l1 = tr_read<v_rd_off(D0, 2 * HH + 1, 0)>(vb), h1 = tr_read<v_rd_off(D0, 2 * HH + 1, 1)>(vb);
    asm volatile("s_waitcnt lgkmcnt(0)" ::: "memory"); SCHED();
#define PK(L, H) (bf16x8){L[0], L[1], L[2], L[3], H[0], H[1], H[2], H[3]}
    od = MFMA32(pa, PK(l0, h0), od); od = MFMA32(pb, PK(l1, h1), od);
#undef PK
}

struct VFrag { s16x4 l0, h0, l1, h1, l2, h2, l3, h3; };
template <int D0> DI void pv_load(VFrag& f, int vb) {
    f.l0 = tr_read<v_rd_off(D0, 0, 0)>(vb); f.h0 = tr_read<v_rd_off(D0, 0, 1)>(vb); f.l1 = tr_read<v_rd_off(D0, 1, 0)>(vb); f.h1 = tr_read<v_rd_off(D0, 1, 1)>(vb);
    f.l2 = tr_read<v_rd_off(D0, 2, 0)>(vb); f.h2 = tr_read<v_rd_off(D0, 2, 1)>(vb); f.l3 = tr_read<v_rd_off(D0, 3, 0)>(vb); f.h3 = tr_read<v_rd_off(D0, 3, 1)>(vb);
}
DI void pv_mma(f32x16& od, const VFrag& f, bf16x8 pa0, bf16x8 pa1, bf16x8 pa2, bf16x8 pa3) {
#define PK(L, H) (bf16x8){L[0], L[1], L[2], L[3], H[0], H[1], H[2], H[3]}
    od = MFMA32(pa0, PK(f.l0, f.h0), od); od = MFMA32(pa1, PK(f.l1, f.h1), od); od = MFMA32(pa2, PK(f.l2, f.h2), od); od = MFMA32(pa3, PK(f.l3, f.h3), od);
#undef PK
}
struct VFragH { s16x4 l0, h0, l1, h1; };
template <int D0, int HH> DI void pvh_load(VFragH& f, int vb) {
    f.l0 = tr_read<v_rd_off(D0, 2 * HH, 0)>(vb); f.h0 = tr_read<v_rd_off(D0, 2 * HH, 1)>(vb); f.l1 = tr_read<v_rd_off(D0, 2 * HH + 1, 0)>(vb); f.h1 = tr_read<v_rd_off(D0, 2 * HH + 1, 1)>(vb);
}
DI void pvh_mma(f32x16& od, const VFragH& f, bf16x8 pa, bf16x8 pb) {
#define PK(L, H) (bf16x8){L[0], L[1], L[2], L[3], H[0], H[1], H[2], H[3]}
    od = MFMA32(pa, PK(f.l0, f.h0), od); od = MFMA32(pb, PK(f.l1, f.h1), od);
#undef PK
}
#define PV_STEP(D, FCUR, FNXT) do { pv_load<(D) + 1>(FNXT, vb); asm volatile("s_waitcnt lgkmcnt(8)" ::: "memory"); SCHED(); pv_mma(o[D], FCUR, pa0, pa1, pa2, pa3); } while (0)

DI void attn_unit(const Params& p, LAS char* st, int b, int h, int t, float lam) {
    int tid_ = threadIdx.x; asm volatile("" : "+v"(tid_));
    const int tid = tid_, wid = tid >> 6, lane = tid & 63, r32 = lane & 31, hi = lane >> 5;
    const int comp = wid >> 2, wq = wid & 3;
    const bf16_t* qn = (const bf16_t*)(p.ws + WS_QN); const bf16_t* kn = (const bf16_t*)(p.ws + WS_KN); const bf16_t* proj = (const bf16_t*)(p.ws + WS_PROJ);
    LAS float* scr = (LAS float*)(st + AT_SCR) + wid * 64;
    const int NT = 2 * t + 2;
    const int wv = __builtin_amdgcn_readfirstlane(tid >> 6);
    unsigned ksrc, vsrc;
    { const int row = tid >> 4, colB = ((tid & 15) << 4) ^ ((row & 7) << 4); ksrc = ((unsigned)row * DM + h * 256) * 2u + colB; }
    { const int sub = tid >> 5, kk = (sub >> 3) * 8 + ((tid & 31) >> 2), key = (kk & ~0xC) | ((kk & 4) << 1) | ((kk & 8) >> 1), col = (sub & 7) * 32 + ((tid & 3) << 3);
      vsrc = ((unsigned)key * DM + h * 256 + col) * 2u; }
    const __amdgpu_buffer_rsrc_t rsK = __builtin_amdgcn_make_buffer_rsrc((void*)(kn + (size_t)(b * SEQ) * DM), 0, 0x7fffffff, 0x00020000);
    const __amdgpu_buffer_rsrc_t rsV = __builtin_amdgcn_make_buffer_rsrc((void*)((const bf16_t*)(p.ws + WS_VBUF) + (size_t)(b * SEQ) * DM), 0, 0x7fffffff, 0x00020000);
#define AT_DMA(kt, bsel) do { LAS char* bb_ = st + (bsel) * AT_BUF + wv * 1024; \
        _Pragma("unroll") for (int i_ = 0; i_ < 2; ++i_) { const int so_ = ((kt) * 64 + 32 * i_) * DM * 2; \
            __builtin_amdgcn_raw_ptr_buffer_load_lds(rsK, (LAS unsigned*)(bb_ + AT_K1 + 8192 * i_), 16, ksrc, so_, 0, 0); \
            __builtin_amdgcn_raw_ptr_buffer_load_lds(rsK, (LAS unsigned*)(bb_ + AT_K2 + 8192 * i_), 16, ksrc, so_ + 256, 0, 0); } \
        _Pragma("unroll") for (int i_ = 0; i_ < 4; ++i_) \
            __builtin_amdgcn_raw_ptr_buffer_load_lds(rsV, (LAS unsigned*)(bb_ + AT_V + 8192 * i_), 16, vsrc, ((kt) * 64 + 16 * i_) * DM * 2, 0, 0); } while (0)
    bf16x8 qr[8];
    { const bf16_t* qw = qn + (size_t)(b * SEQ + t * 128 + wq * 32 + r32) * DM + h * 256 + comp * 128 + hi * 8;
#pragma unroll
      for (int d0 = 0; d0 < 8; ++d0) qr[d0] = *(const bf16x8*)(qw + d0 * 16); }
    f32x16 o[8];
#pragma unroll
    for (int d = 0; d < 8; ++d)
#pragma unroll
        for (int r = 0; r < 16; ++r) o[d][r] = 0.f;
    float m_reg = -1e30f, l_reg = 0.f;
    constexpr float C = AT_SCALE * 1.4426950408889634f;
    AT_DMA(0, 0);
    for (int j = 0; j < NT; ++j) {
        WAIT_V(0); WAIT_L(0); BAR();
        if (j + 1 < NT) AT_DMA(j + 1, (j + 1) & 1);
        if (j == NT - 1 && wq < 2) continue;
        const LAS char* bb = st + (j & 1) * AT_BUF; const LAS char* Ks = bb + (comp ? AT_K2 : AT_K1);
        f32x16 p0, p1;
#pragma unroll
        for (int r = 0; r < 16; ++r) { p0[r] = 0.f; p1[r] = 0.f; }
        const int vb = (int)(uintptr_t)(bb + AT_V) + v_rd_base(lane);
#define KF(i) (*(const LAS bf16x8*)(Ks + KSWZ(32 * ((i) >> 3) + r32, (((i) & 7) * 16 + hi * 8) * 2)))
#define QK_STEP(i, F) do { if ((i) < 8) p0 = MFMA32(F, qr[(i) & 7], p0); else p1 = MFMA32(F, qr[(i) & 7], p1); if ((i) + 3 < 16) F = KF((i) + 3); } while (0)
        bf16x8 kf0 = KF(0), kf1 = KF(1), kf2 = KF(2);
        __builtin_amdgcn_s_setprio(1);
        QK_STEP(0, kf0); SCHED(); QK_STEP(1, kf1); SCHED(); QK_STEP(2, kf2); SCHED(); QK_STEP(3, kf0); SCHED();
        QK_STEP(4, kf1); SCHED(); QK_STEP(5, kf2); SCHED(); QK_STEP(6, kf0); SCHED(); QK_STEP(7, kf1); SCHED();
        __builtin_amdgcn_s_setprio(0);
        bf16x8 pa0, pa1, pa2, pa3;
#define PK4(P, BASE, OUT) do { unsigned a0 = cvt_pk_bf16(P[BASE + 0], P[BASE + 1]), a1 = cvt_pk_bf16(P[BASE + 2], P[BASE + 3]); \
        unsigned b0_ = cvt_pk_bf16(P[BASE + 4], P[BASE + 5]), b1_ = cvt_pk_bf16(P[BASE + 6], P[BASE + 7]); \
        auto r0 = __builtin_amdgcn_permlane32_swap(a0, b0_, false, false); auto r1 = __builtin_amdgcn_permlane32_swap(a1, b1_, false, false); \
        u32x4 w = {r0[0], r1[0], r0[1], r1[1]}; OUT = __builtin_bit_cast(bf16x8, w); } while (0)
#define SM_HEAD(P, EX, ALPHA, MNC) \
        float pm_ = P[0]; _Pragma("unroll") for (int r = 1; r < 16; ++r) pm_ = fmaxf(pm_, P[r]); \
        { auto rr = __builtin_amdgcn_permlane32_swap(__float_as_uint(pm_), __float_as_uint(pm_), false, false); pm_ = fmaxf(__uint_as_float(rr[0]), __uint_as_float(rr[1])); } \
        const bool EX = !__all(pm_ - m_reg <= AT_THR / AT_SCALE); \
        const float mn_ = EX ? fmaxf(m_reg, pm_) : m_reg; const float ALPHA = EX ? __builtin_amdgcn_exp2f((m_reg - mn_) * C) : 1.f; m_reg = mn_; const float MNC = -mn_ * C;
#define SM_PAIR(P, c, MNC, PS) do { P[2 * (c)] = __builtin_amdgcn_exp2f(fmaf(P[2 * (c)], C, MNC)); P[2 * (c) + 1] = __builtin_amdgcn_exp2f(fmaf(P[2 * (c) + 1], C, MNC)); PS += P[2 * (c)] + P[2 * (c) + 1]; } while (0)
#define SM_RESCALE(ALPHA) do { if (hi == 0) scr[r32] = ALPHA; WAIT_L(0); \
        _Pragma("unroll") for (int r = 0; r < 16; ++r) { const float a_ = scr[crow(r, hi)]; _Pragma("unroll") for (int d = 0; d < 8; ++d) o[d][r] *= a_; } } while (0)
        float ps0 = 0.f;
        QK_STEP(8, kf2); SCHED(); QK_STEP(9, kf0); SCHED();
        bool ex0; float alpha0, mnC0;
        { SM_HEAD(p0, ex0_, alpha0_, mnC0_); ex0 = ex0_; alpha0 = alpha0_; mnC0 = mnC0_; }
        SCHED();
        QK_STEP(10, kf1); SM_PAIR(p0, 0, mnC0, ps0); SM_PAIR(p0, 1, mnC0, ps0); SCHED();
        QK_STEP(11, kf2); SM_PAIR(p0, 2, mnC0, ps0); SM_PAIR(p0, 3, mnC0, ps0); SCHED();
        QK_STEP(12, kf0); SM_PAIR(p0, 4, mnC0, ps0); PK4(p0, 0, pa0); SCHED();
        QK_STEP(13, kf1); SM_PAIR(p0, 5, mnC0, ps0); SM_PAIR(p0, 6, mnC0, ps0); SCHED();
        QK_STEP(14, kf2); SM_PAIR(p0, 7, mnC0, ps0); SCHED();
        QK_STEP(15, kf0); PK4(p0, 8, pa1); SCHED();
#undef KF
#undef QK_STEP
        { auto rr = __builtin_amdgcn_permlane32_swap(__float_as_uint(ps0), __float_as_uint(ps0), false, false); ps0 = __uint_as_float(rr[0]) + __uint_as_float(rr[1]); }
        l_reg = l_reg * alpha0 + ps0;
        __builtin_amdgcn_s_setprio(0);
        if (ex0) SM_RESCALE(alpha0);
        float ps1 = 0.f; bool ex1; float alpha1, mnC1;
        { SM_HEAD(p1, ex1_, alpha1_, mnC1_); ex1 = ex1_; alpha1 = alpha1_; mnC1 = mnC1_; }
        VFragH fa, fb;
        WAIT_L(0); pvh_load<0, 0>(fa, vb);
#define PVH_STEP(HH, D, FCUR, FNXT, PA, PB, ...) do { pvh_load<(D) + 1, HH>(FNXT, vb); asm volatile("s_waitcnt lgkmcnt(4)" ::: "memory"); SCHED(); pvh_mma(o[D], FCUR, PA, PB); __VA_ARGS__; SCHED(); } while (0)
        PVH_STEP(0, 0, fa, fb, pa0, pa1, SM_PAIR(p1, 0, mnC1, ps1)); PVH_STEP(0, 1, fb, fa, pa0, pa1, SM_PAIR(p1, 1, mnC1, ps1));
        PVH_STEP(0, 2, fa, fb, pa0, pa1, SM_PAIR(p1, 2, mnC1, ps1)); PVH_STEP(0, 3, fb, fa, pa0, pa1, SM_PAIR(p1, 3, mnC1, ps1); PK4(p1, 0, pa2));
        PVH_STEP(0, 4, fa, fb, pa0, pa1, SM_PAIR(p1, 4, mnC1, ps1)); PVH_STEP(0, 5, fb, fa, pa0, pa1, SM_PAIR(p1, 5, mnC1, ps1));
        PVH_STEP(0, 6, fa, fb, pa0, pa1, SM_PAIR(p1, 6, mnC1, ps1));
        asm volatile("s_waitcnt lgkmcnt(0)" ::: "memory"); SCHED(); pvh_mma(o[7], fb, pa0, pa1); SM_PAIR(p1, 7, mnC1, ps1); PK4(p1, 8, pa3); SCHED();
        { auto rr = __builtin_amdgcn_permlane32_swap(__float_as_uint(ps1), __float_as_uint(ps1), false, false); ps1 = __uint_as_float(rr[0]) + __uint_as_float(rr[1]); }
        l_reg = l_reg * alpha1 + ps1;
        __builtin_amdgcn_s_setprio(0);
        if (ex1) SM_RESCALE(alpha1);
        __builtin_amdgcn_s_setprio(1);
        WAIT_L(0); pvh_load<0, 1>(fa, vb);
        PVH_STEP(1, 0, fa, fb, pa2, pa3, (void)0); PVH_STEP(1, 1, fb, fa, pa2, pa3, (void)0); PVH_STEP(1, 2, fa, fb, pa2, pa3, (void)0); PVH_STEP(1, 3, fb, fa, pa2, pa3, (void)0);
        PVH_STEP(1, 4, fa, fb, pa2, pa3, (void)0); PVH_STEP(1, 5, fb, fa, pa2, pa3, (void)0); PVH_STEP(1, 6, fa, fb, pa2, pa3, (void)0);
        asm volatile("s_waitcnt lgkmcnt(0)" ::: "memory"); SCHED(); pvh_mma(o[7], fb, pa2, pa3);
        __builtin_amdgcn_s_setprio(0);
#undef PK4
#undef SM_HEAD
#undef SM_PAIR
#undef SM_RESCALE
#undef PVH_STEP
    }
    WAIT_L(0);
    if (hi == 0) scr[32 + r32] = l_reg;
    WAIT_L(0);
    float rli[16];
#pragma unroll
    for (int r = 0; r < 16; ++r) rli[r] = __builtin_amdgcn_rcpf(scr[32 + crow(r, hi)]);
    __syncthreads();
    LAS float* xch = (LAS float*)st;
    if (comp == 1) {
#pragma unroll
        for (int r = 0; r < 16; ++r) { const float s = rli[r] * lam;
#pragma unroll
            for (int d = 0; d < 8; ++d) xch[(wq * 32 + crow(r, hi)) * 256 + d * 32 + r32] = o[d][r] * s; }
    }
    __syncthreads();
    if (comp == 0) {
        bf16_t* ob = (bf16_t*)(p.ws + WS_OB);
        float sg[8];
#pragma unroll
        for (int d = 0; d < 8; ++d) sg[d] = p.subln_g[d * 32 + r32] * 0.8f;
#pragma unroll
        for (int r = 0; r < 16; ++r) {
            float ss = 0.f;
#pragma unroll
            for (int d = 0; d < 8; ++d) { const float v = o[d][r] * rli[r] - xch[(wq * 32 + crow(r, hi)) * 256 + d * 32 + r32]; o[d][r] = v; ss += v * v; }
            ss += __shfl_xor(ss, 1); ss += __shfl_xor(ss, 2); ss += __shfl_xor(ss, 4); ss += __shfl_xor(ss, 8); ss += __shfl_xor(ss, 16);
            const float rs = rsqrtf(ss * (1.f / 256.f) + NORM_EPS);
            bf16_t* dst = ob + (size_t)(b * SEQ + t * 128 + wq * 32 + crow(r, hi)) * DM + h * 256 + r32;
#pragma unroll
            for (int d = 0; d < 8; ++d) dst[d * 32] = (bf16_t)(cvt_pk_bf16(o[d][r] * rs * sg[d], 0.f) & 0xffffu);
            asm volatile("" ::: "memory");
        }
    }
    __syncthreads();
#undef AT_DMA
}

DI void p3_mixers(const Params& p, LAS char* lds, int rep) {
    const int tid = threadIdx.x;
    LAS char* st = lds + LDS_MISC;
    volatile LAS int* bc = (volatile LAS int*)(lds + 16);
    if (tid < 64) {
        float a = p.lq1[tid] * p.lk1[tid] + p.lq1[tid + 64] * p.lk1[tid + 64], c = p.lq2[tid] * p.lk2[tid] + p.lq2[tid + 64] * p.lk2[tid + 64];
#pragma unroll
        for (int o = 32; o >= 1; o >>= 1) { a += __shfl_xor(a, o); c += __shfl_xor(c, o); }
        if (tid == 0) ((volatile LAS float*)bc)[1] = __expf(a) - __expf(c) + 0.2f;
    }
    __syncthreads();
    const float lam = ((volatile LAS float*)bc)[1];
    unsigned* queue = (unsigned*)(p.ws + WS_CTL) + CW_QUEUE + 1024 * rep;
#define PULL(item_) do { if (tid == 0) bc[0] = (int)__hip_atomic_fetch_add(queue, 1u, __ATOMIC_RELAXED, __HIP_MEMORY_SCOPE_AGENT); __syncthreads(); item_ = bc[0]; __syncthreads(); } while (0)
    const int xq = blockIdx.x & 7;
    unsigned* queueA = queue + 64 * (1 + xq); unsigned* queueB = queue + 32;
#define PULLA(item_) do { if (tid == 0) bc[0] = (int)__hip_atomic_fetch_add(queueA, 1u, __ATOMIC_RELAXED, __HIP_MEMORY_SCOPE_AGENT); __syncthreads(); item_ = bc[0]; __syncthreads(); } while (0)
#define PULLB(item_) do { if (tid == 0) bc[0] = (int)__hip_atomic_fetch_add(queueB, 1u, __ATOMIC_RELAXED, __HIP_MEMORY_SCOPE_AGENT); __syncthreads(); item_ = bc[0]; __syncthreads(); } while (0)
    int item;
#ifndef MK_NO_CONV
    if (((blockIdx.x >> 3) & 7) < 3) { PULLB(item); while (item < 768) { cvt_tiles<32>(p, lds, 3072 + item * 32, 1); PULLB(item); } }
#endif
    PULLA(item);
#ifndef MK_NO_SCAN
    while (item < 8) { gdn_scan_unit(p, st, xq * 8 + item); PULLA(item); }
#endif
#ifndef MK_NO_ATTN
    while (item < 8 + 128) { const int idx = item - 8, bhh = xq * 4 + (idx >> 5), t = 31 - (idx & 31); attn_unit(p, st, bhh >> 3, bhh & 7, t, lam); PULLA(item); }
#endif
#ifndef MK_NO_CONV
    PULLB(item); while (item < 768) { cvt_tiles<32>(p, lds, 3072 + item * 32, 1); PULLB(item); }
#endif
#undef PULLA
#undef PULLB
#undef PULL
}

DI void p6_router(const Params& p, LAS char* lds) {
    const int tid = threadIdx.x, lane = tid & 63, wave = tid >> 6, l15 = lane & 15, l4 = lane >> 4;
    LAS char* st = lds + LDS_MISC;
    LAS float* lg = (LAS float*)st;
    LAS float* rsd = (LAS float*)(st + 8448);
    LAS int* sel = (LAS int*)(st + 8704);
    LAS float* selw = (LAS float*)(st + 9728);
    LAS int* lcnt = (LAS int*)(st + 10752);
    const bf16_t* rhi = (const bf16_t*)(p.ws + WS_WS) + 32 * 2048; const bf16_t* rlo = rhi + 32 * 2048;
    unsigned char* h2 = p.ws + WS_H;
    unsigned* cnt = (unsigned*)(p.ws + WS_CTL) + CW_CNT;
    int* list = (int*)(p.ws + WS_LIST); float* wlist = (float*)(p.ws + WS_WLIST); int* tinfo = (int*)(p.ws + WS_TINFO);
    for (int grp = blockIdx.x; grp < NTOK / 64; grp += gridDim.x) {
        const int tok0 = grp * 64;
        if (tid < 64) lcnt[tid] = 0;
        if (wave < 4) {
            const float* xr = p.out + (size_t)(tok0 + wave * 16 + l15) * DM + l4 * 8;
            const bf16_t* bh0 = rhi + (size_t)l15 * DM + l4 * 8; const bf16_t* bl0 = rlo + (size_t)l15 * DM + l4 * 8;
            f32x4 a0 = {0.f, 0.f, 0.f, 0.f}, a1 = {0.f, 0.f, 0.f, 0.f}; float ss = 0.f;
#pragma unroll 4
            for (int k0 = 0; k0 < DM; k0 += 32) {
                const f32x4 xa = *(const f32x4*)(xr + k0), xb = *(const f32x4*)(xr + k0 + 4);
                const f32x4 ga = *(const f32x4*)(p.norm2_g + k0 + l4 * 8), gb = *(const f32x4*)(p.norm2_g + k0 + l4 * 8 + 4);
                float a[8] = {xa[0] * ga[0], xa[1] * ga[1], xa[2] * ga[2], xa[3] * ga[3], xb[0] * gb[0], xb[1] * gb[1], xb[2] * gb[2], xb[3] * gb[3]};
                ss += xa[0] * xa[0] + xa[1] * xa[1] + xa[2] * xa[2] + xa[3] * xa[3] + xb[0] * xb[0] + xb[1] * xb[1] + xb[2] * xb[2] + xb[3] * xb[3];
                u32x4 hw, lw;
#pragma unroll
                for (int q = 0; q < 4; ++q) { hw[q] = cvt_pk_bf16(a[2 * q], a[2 * q + 1]); lw[q] = cvt_pk_bf16(a[2 * q] - bflo(hw[q]), a[2 * q + 1] - bfhi(hw[q])); }
                const bf16x8 ah = __builtin_bit_cast(bf16x8, hw), al = __builtin_bit_cast(bf16x8, lw);
                const bf16x8 bh_0 = *(const bf16x8*)(bh0 + k0), bh_1 = *(const bf16x8*)(bh0 + 16 * DM + k0), bl_0 = *(const bf16x8*)(bl0 + k0), bl_1 = *(const bf16x8*)(bl0 + 16 * DM + k0);
                a0 = MFMA16(ah, bh_0, a0); a0 = MFMA16(ah, bl_0, a0); a0 = MFMA16(al, bh_0, a0);
                a1 = MFMA16(ah, bh_1, a1); a1 = MFMA16(ah, bl_1, a1); a1 = MFMA16(al, bh_1, a1);
            }
            ss += __shfl_xor(ss, 16); ss += __shfl_xor(ss, 32);
            const float rstd = rsqrtf(ss * (1.f / DM) + NORM_EPS);
            if (l4 == 0) rsd[wave * 16 + l15] = rstd;
            const float br0 = p.b_router[l15], br1 = p.b_router[16 + l15];
#pragma unroll
            for (int r = 0; r < 4; ++r) {
                const float rs = __shfl(rstd, l4 * 4 + r);
                lg[(wave * 16 + l4 * 4 + r) * 33 + l15] = a0[r] * rs + br0;
                lg[(wave * 16 + l4 * 4 + r) * 33 + 16 + l15] = a1[r] * rs + br1;
            }
        }
        __syncthreads();
        if (tid < 64) {
            float v[32];
#pragma unroll
            for (int e = 0; e < 32; ++e) v[e] = lg[tid * 33 + e];
            float tv[4]; int ti[4];
#pragma unroll
            for (int k = 0; k < 4; ++k) {
                float best = -3.0e38f; int bi = 0;
#pragma unroll
                for (int e = 0; e < 32; ++e) { const bool take = v[e] > best; best = take ? v[e] : best; bi = take ? e : bi; }
                tv[k] = best; ti[k] = bi;
#pragma unroll
                for (int e = 0; e < 32; ++e) v[e] = (e == bi) ? -3.0e38f : v[e];
            }
            const float e1 = __expf(tv[1] - tv[0]), e2 = __expf(tv[2] - tv[0]), e3 = __expf(tv[3] - tv[0]); const float inv = 1.f / (1.f + e1 + e2 + e3);
            const float w4[4] = {inv, e1 * inv, e2 * inv, e3 * inv};
#pragma unroll
            for (int k = 0; k < 4; ++k) { const int lp = atomicAdd((int*)&lcnt[ti[k]], 1); sel[tid * 4 + k] = ti[k] | (lp << 8); selw[tid * 4 + k] = w4[k]; }
        }
        __syncthreads();
        if (tid < 32) lcnt[32 + tid] = (int)__hip_atomic_fetch_add(cnt + tid * 16, (unsigned)lcnt[tid], __ATOMIC_RELAXED, __HIP_MEMORY_SCOPE_AGENT);
        __syncthreads();
        if (tid < 256) {
            const int s = sel[tid], e = s & 255, pos = lcnt[32 + e] + (s >> 8), tok = tok0 + (tid >> 2);
            list[e * NTOK + pos] = tok; wlist[e * NTOK + pos] = selw[tid];
            tinfo[(size_t)tok * 8 + (tid & 3) * 2] = e; tinfo[(size_t)tok * 8 + (tid & 3) * 2 + 1] = pos;
        }
#pragma unroll 1
        for (int tt = 0; tt < 8; ++tt) {
            const int tl = wave * 8 + tt; const float rs = rsd[tl];
            const float* xr = p.out + (size_t)(tok0 + tl) * DM;
#pragma unroll
            for (int i = 0; i < 8; ++i) {
                const f32x4 xv = *(const f32x4*)(xr + (i * 64 + lane) * 4), g = *(const f32x4*)(p.norm2_g + (i * 64 + lane) * 4);
                const float rs2 = rs * H8_SCALE;
                *(unsigned*)(h2 + (size_t)(tok0 + tl) * DM + (i * 64 + lane) * 4) = cvt4_fp8(xv[0] * rs2 * g[0], xv[1] * rs2 * g[1], xv[2] * rs2 * g[2], xv[3] * rs2 * g[3]);
            }
        }
        __syncthreads();
    }
}

DI void moe_table(const Params& p, LAS char* lds) {
    LAS int* ts = (LAS int*)(lds + 64); LAS int* cn = (LAS int*)(lds + 256);
    const int tid = threadIdx.x;
    if (tid < 64) {
        const int e = tid & 31;
        const int c = (int)__hip_atomic_load((unsigned*)(p.ws + WS_CTL) + CW_CNT + e * 16, __ATOMIC_RELAXED, __HIP_MEMORY_SCOPE_AGENT);
        const int tl = (c + 255) >> 8; int incl = tl;
#pragma unroll
        for (int o = 1; o < 32; o <<= 1) { const int t = __shfl_up(incl, o); if ((tid & 31) >= o) incl += t; }
        if (tid < 32) { ts[e + 1] = incl; cn[e] = c; if (e == 0) ts[0] = 0; }
    }
    __syncthreads();
}
DI bool moe_unit(const LAS int* ts, int u, int NTN, int& e, int& mt, int& nt, int& tile0) {
    if (u >= __builtin_amdgcn_readfirstlane(ts[32]) * NTN) return false;
    int ee = 0;
    for (int k = 1; k < 32; ++k) ee = (u >= __builtin_amdgcn_readfirstlane(ts[k]) * NTN) ? k : ee;
    const int t0 = __builtin_amdgcn_readfirstlane(ts[ee]), t1 = __builtin_amdgcn_readfirstlane(ts[ee + 1]);
    const int l = u - t0 * NTN, nte = t1 - t0;
    if (NTN == 8) { const int g = l / (2 * nte), r = l - g * 2 * nte; nt = 2 * g + (r & 1); mt = r >> 1; }
    else { nt = l / nte; mt = l - nt * nte; }
    e = ee; tile0 = t0; return true;
}
DI int moe_uidx(int i) {
    if (gridDim.x != 256) return (int)blockIdx.x + i * (int)gridDim.x;
    const int c = blockIdx.x, x = c & 7, s = c >> 3;
    return 256 * i + 8 * (x + 8 * (s >> 3)) + (s & 7);
}
DI void p7_gateup(const Params& p, LAS char* lds) {
    moe_table(p, lds);
    const LAS int* ts = (const LAS int*)(lds + 64); const LAS int* cn = (const LAS int*)(lds + 256);
    const int tid = threadIdx.x; const int* list = (const int*)(p.ws + WS_LIST);
    const bf16_t* h2 = (const bf16_t*)(p.ws + WS_H); const unsigned char* wgu = p.ws + WS_WGU;
    int e, mt, nt, t0; bool have = moe_unit(ts, moe_uidx(0), 16, e, mt, nt, t0), pre = false;
    if (have && tid < 256) { const int pos = mt * 256 + tid; ((LAS int*)(lds + 1024))[tid] = pos < cn[e] ? list[e * NTOK + pos] : 0; }
    __syncthreads();
    for (int i = 0; have; ++i) {
        LAS int* rowidx = (LAS int*)(lds + 1024 + (i & 1) * 1024); LAS int* rowidx2 = (LAS int*)(lds + 1024 + ((i + 1) & 1) * 1024);
        int e2, mt2, nt2, t02; const bool have2 = moe_unit(ts, moe_uidx(i + 1), 16, e2, mt2, nt2, t02);
        if (have2 && tid < 256) { const int pos = mt2 * 256 + tid; rowidx2[tid] = pos < cn[e2] ? list[e2 * NTOK + pos] : 0; }
        EpiGateUp ep{p.ws + WS_ACT, p.b_gu + (size_t)e * 4096, (t0 + mt) * 256, nt};
        auto next = [&]() { if (have2) gemm_issue<true, true>(h2, DM / 2, 0, rowidx2, (const bf16_t*)(wgu + ((size_t)e2 * 4096 + nt2 * 256) * DM), DM / 2, lds + LDS_MISC); };
        gemm_tile<true, true>(h2, DM / 2, 0, rowidx, (const bf16_t*)(wgu + ((size_t)e * 4096 + nt * 256) * DM), DM / 2, lds + LDS_MISC, ep, pre, next);
        pre = have2; have = have2; e = e2; mt = mt2; nt = nt2; t0 = t02;
    }
}
DI void p8_down(const Params& p, LAS char* lds) {
    moe_table(p, lds);
    const LAS int* ts = (const LAS int*)(lds + 64);
    const bf16_t* act = (const bf16_t*)(p.ws + WS_ACT); const unsigned char* wd = p.ws + WS_WD;
    int e, mt, nt, t0; bool have = moe_unit(ts, moe_uidx(0), 8, e, mt, nt, t0), pre = false;
    for (int i = 0; have; ++i) {
        int e2, mt2, nt2, t02; const bool have2 = moe_unit(ts, moe_uidx(i + 1), 8, e2, mt2, nt2, t02);
        const int slot0 = (t0 + mt) * 256;
        EpiDown ep{p.ws + WS_YS, p.b_down + (size_t)e * 2048, (const float*)(p.ws + WS_WLIST) + (size_t)e * NTOK + mt * 256, slot0, nt};
        auto next = [&]() { if (have2) gemm_issue<false, true>(act, DM / 2, (t02 + mt2) * 256, (const LAS int*)nullptr, (const bf16_t*)(wd + ((size_t)e2 * 2048 + nt2 * 256) * DM), DM / 2, lds + LDS_MISC); };
        gemm_tile<false, true>(act, DM / 2, slot0, (const LAS int*)nullptr, (const bf16_t*)(wd + ((size_t)e * 2048 + nt * 256) * DM), DM / 2, lds + LDS_MISC, ep, pre, next);
        pre = have2; have = have2; e = e2; mt = mt2; nt = nt2; t0 = t02;
    }
}
DI void p9_combine(const Params& p, LAS char* lds) {
    moe_table(p, lds);
    const LAS int* ts = (const LAS int*)(lds + 64);
    const int tid = threadIdx.x, lane = tid & 63, wave = tid >> 6;
    const int* tinfo = (const int*)(p.ws + WS_TINFO); const unsigned char* ys = p.ws + WS_YS;
    constexpr float iy = 1.f / Y8_SCALE;
    for (int tok = blockIdx.x * 8 + wave; tok < NTOK; tok += gridDim.x * 8) {
        int slot[4];
#pragma unroll
        for (int k = 0; k < 4; ++k) { const int e = tinfo[(size_t)tok * 8 + k * 2], pos = tinfo[(size_t)tok * 8 + k * 2 + 1]; slot[k] = ts[e] * 256 + pos; }
#pragma unroll
        for (int i = 0; i < 4; ++i) {
            const int cA = i * 512 + lane * 4, cB = cA + 256;
            f32x4 a0 = {0.f, 0.f, 0.f, 0.f}, a1 = {0.f, 0.f, 0.f, 0.f};
#pragma unroll
            for (int k = 0; k < 4; ++k) { const unsigned wa = *(const unsigned*)(ys + (size_t)slot[k] * DM + cA), wb = *(const unsigned*)(ys + (size_t)slot[k] * DM + cB);
                const f32x2 q0 = __builtin_amdgcn_cvt_pk_f32_fp8((int)wa, false), q1 = __builtin_amdgcn_cvt_pk_f32_fp8((int)wa, true);
                const f32x2 q2 = __builtin_amdgcn_cvt_pk_f32_fp8((int)wb, false), q3 = __builtin_amdgcn_cvt_pk_f32_fp8((int)wb, true);
                a0[0] += q0[0]; a0[1] += q0[1]; a0[2] += q1[0]; a0[3] += q1[1]; a1[0] += q2[0]; a1[1] += q2[1]; a1[2] += q3[0]; a1[3] += q3[1]; }
            float* o = p.out + (size_t)tok * DM;
            const f32x4 x0 = *(const f32x4*)(o + cA), x1 = *(const f32x4*)(o + cB);
            *(f32x4*)(o + cA) = x0 + a0 * iy; *(f32x4*)(o + cB) = x1 + a1 * iy;
        }
    }
}

__global__ void __launch_bounds__(512, 2) mega(Params p) {
    extern __shared__ __attribute__((aligned(16))) unsigned char lds_raw[];
    LAS char* lds = (LAS char*)lds_raw;
    const int tid = threadIdx.x;
    if (tid < 16) ((LAS unsigned*)lds)[tid] = 0u;
    __syncthreads();
    XcdBarrier bar; bar.bar = (unsigned*)(p.ws + WS_CTL); bar.x = 0; bar.st = (volatile LAS unsigned*)lds;
    const int lo = p.ph_lo, hi = p.ph_hi;
    if (hi - lo > 1) bar = xcd_barrier_post((unsigned*)(p.ws + WS_CTL), (volatile LAS unsigned*)lds);
#ifdef MK_ONLY
#define IN(k) ((k) == MK_ONLY && lo <= (k) && (k) < hi)
#else
#define IN(k) (lo <= (k) && (k) < hi)
#endif
#define SEAM(k) do { if (IN(k) && IN((k) + 1)) xcd_barrier(bar); } while (0)
#ifndef MK_DUP
#define MK_DUP (-1)
#endif
#define REP(k) for (int rep_ = 0; rep_ < ((k) == MK_DUP ? 2 : 1); ++rep_)
    if (IN(0)) REP(0) { p0_prologue(p, lds); } SEAM(0);
    if (IN(1)) REP(1) { p1_inproj(p, lds); } SEAM(1);
    if (IN(2)) REP(2) {
        for (int pr = blockIdx.x; pr < 2048; pr += gridDim.x) gdn_prep_pair(p, lds + LDS_MISC, pr);
        p2_qknorm(p);
    } SEAM(2);
    if (IN(3)) REP(3) { p3_mixers(p, lds, rep_); } SEAM(3);
    if (IN(4)) REP(4) { p4_branches(p, lds); } SEAM(4);
    if (IN(5)) REP(5) { p5_outproj(p, lds); } SEAM(5);
    if (IN(6)) { p6_router(p, lds); } SEAM(6);
    if (IN(7)) REP(7) { p7_gateup(p, lds); } SEAM(7);
    if (IN(8)) REP(8) { p8_down(p, lds); } SEAM(8);
    if (IN(9)) { p9_combine(p, lds); }
#undef IN
#undef SEAM
}

#ifndef MK_N_LAUNCHES
#define MK_N_LAUNCHES 1
#endif
extern "C" void kernel_launch(void* const* d_in, const int* in_sizes, int n_in, void* d_out, int out_size, void* d_ws, size_t ws_size, hipStream_t stream) {
    static int grid = 0;
    if (grid == 0) {
        if (n_in != 26 || out_size != NTOK * DM || ws_size < WS_END) { fprintf(stderr, "kernel_launch: unexpected shapes (n_in %d out %d ws %zu, need ws >= %zu)\n", n_in, out_size, ws_size, (size_t)WS_END); grid = -1; return; }
        int dev = 0, cus = 0, per_cu = 0;
        (void)hipGetDevice(&dev); (void)hipDeviceGetAttribute(&cus, hipDeviceAttributeMultiprocessorCount, dev);
        if (hipFuncSetAttribute((const void*)mega, hipFuncAttributeMaxDynamicSharedMemorySize, LDS_BYTES) != hipSuccess) { fprintf(stderr, "kernel_launch: hipFuncSetAttribute(%d) failed\n", LDS_BYTES); grid = -1; return; }
        (void)hipOccupancyMaxActiveBlocksPerMultiprocessor(&per_cu, (const void*)mega, 512, LDS_BYTES);
        (void)hipGetLastError();
        if (per_cu < 1) fprintf(stderr, "kernel_launch: occupancy query says %d blocks per CU\n", per_cu);
        grid = cus;
    }
    if (grid < 0) return;
    (void)hipMemsetAsync((char*)d_ws + WS_CTL, 0, CTL_ZERO_BYTES, stream);
    Params p{};
    p.x = (const float*)d_in[0]; p.positions = (const int*)d_in[1]; p.norm1_g = (const float*)d_in[2]; p.w_in = (const float*)d_in[3]; p.b_gate = (const float*)d_in[4];
    p.conv_w = (const float*)d_in[5]; p.a_log = (const float*)d_in[6]; p.dt_bias = (const float*)d_in[7]; p.gdn_norm_g = (const float*)d_in[8]; p.q_norm_g = (const float*)d_in[9];
    p.k_norm_g = (const float*)d_in[10]; p.lq1 = (const float*)d_in[11]; p.lk1 = (const float*)d_in[12]; p.lq2 = (const float*)d_in[13]; p.lk2 = (const float*)d_in[14];
    p.subln_g = (const float*)d_in[15]; p.w_a = (const float*)d_in[16]; p.w_b = (const float*)d_in[17]; p.w_out = (const float*)d_in[18]; p.norm2_g = (const float*)d_in[19];
    p.w_router = (const float*)d_in[20]; p.b_router = (const float*)d_in[21]; p.w_gu = (const float*)d_in[22]; p.b_gu = (const float*)d_in[23]; p.w_down = (const float*)d_in[24];
    p.b_down = (const float*)d_in[25]; p.out = (float*)d_out; p.ws = (unsigned char*)d_ws;
    if (MK_N_LAUNCHES == 1) { p.ph_lo = 0; p.ph_hi = 10; hipLaunchKernelGGL(mega, dim3(grid), dim3(512), LDS_BYTES, stream, p); }
    else for (int ph = 0; ph < 10; ++ph) { p.ph_lo = ph; p.ph_hi = ph + 1; hipLaunchKernelGGL(mega, dim3(grid), dim3(512), LDS_BYTES, stream, p); }
    const hipError_t le = hipPeekAtLastError();
    if (le != hipSuccess) fprintf(stderr, "kernel_launch: launch failed: %s\n", hipGetErrorName(le));
}
```
